# Optimizing an MI355X kernel written in HIP

```python
import math
import jax, jax.numpy as jnp
from jax import lax
import numpy as np

D_MODEL = 2048
BATCH = 4
SEQ = 4096
DEPTH = 2

HEAD_DIM = 128
N_HEADS = D_MODEL // HEAD_DIM
MOBA_HEADS = N_HEADS // 4
DIFF_HEADS = N_HEADS // 4
NSA_HEADS = N_HEADS - MOBA_HEADS - DIFF_HEADS
MIX_WIDTH = N_HEADS * HEAD_DIM

MOBA_BLOCK = 256
MOBA_TOPK = 3
MOBA_QCHUNK = 32

DIFF_QK_DIM = HEAD_DIM // 2
DIFF_QBLOCK = 128
DIFF_EPS = 1e-5

NSA_KV_HEADS = 2
NSA_GROUP = NSA_HEADS // NSA_KV_HEADS
NSA_CMP_LEN = 32
NSA_CMP_STRIDE = 16
NSA_SEL_BLOCK = 64
NSA_SEL_TOPK = 16
NSA_SEL_QCHUNK = 32
NSA_WINDOW = 512
NSA_WIN_QBLOCK = 128
NSA_BRANCHES = 3
NSA_FORCE = 1e6

REL_BUCKETS = 32
REL_MAX_EXACT = 16
REL_MAX_DIST = 128

PEER_HEADS = 8
PEER_NKEYS = 128
PEER_EXPERTS = PEER_NKEYS * PEER_NKEYS
PEER_KEY_HALF = 128
PEER_TOPK = 16
PEER_TCHUNK = 128

NORM_EPS = 1e-6
NEG_INF = -1e30

IN_SPLITS = (
    MOBA_HEADS * HEAD_DIM, MOBA_HEADS * HEAD_DIM, MOBA_HEADS * HEAD_DIM,
    DIFF_HEADS * HEAD_DIM, DIFF_HEADS * HEAD_DIM, DIFF_HEADS * HEAD_DIM,
    NSA_HEADS * HEAD_DIM,
    NSA_KV_HEADS * HEAD_DIM, NSA_KV_HEADS * HEAD_DIM,
    NSA_KV_HEADS * HEAD_DIM, NSA_KV_HEADS * HEAD_DIM,
    NSA_KV_HEADS * HEAD_DIM, NSA_KV_HEADS * HEAD_DIM,
    NSA_HEADS * NSA_BRANCHES,
)
IN_WIDTH = sum(IN_SPLITS)

kernel_name = 'hybrid_moba_diff_nsa_peer'


def rms_norm(x, g, eps=NORM_EPS):
    xf = x.astype(jnp.float32)
    y = xf * lax.rsqrt(jnp.mean(xf * xf, axis=-1, keepdims=True) + eps)
    return (y * g.astype(jnp.float32)).astype(x.dtype)


def t5_bucket(dist):
    n = jnp.maximum(dist, 0)
    nf = jnp.maximum(n, REL_MAX_EXACT).astype(jnp.float32)
    large = REL_MAX_EXACT + (jnp.log(nf / REL_MAX_EXACT) / math.log(REL_MAX_DIST / REL_MAX_EXACT)
                             * (REL_BUCKETS - REL_MAX_EXACT)).astype(jnp.int32)
    large = jnp.minimum(large, REL_BUCKETS - 1)
    return jnp.where(n < REL_MAX_EXACT, n, large)


def split_heads(t, n):
    B, S, _ = t.shape
    return t.reshape(B, S, n, HEAD_DIM).transpose(0, 2, 1, 3)


def moba_attention(q, k, v, bias_tab):
    B, H, S, D = q.shape
    SP = -(-S // MOBA_BLOCK) * MOBA_BLOCK
    pad = ((0, 0), (0, 0), (0, SP - S), (0, 0))
    q, k, v = jnp.pad(q, pad), jnp.pad(k, pad), jnp.pad(v, pad)
    NB = SP // MOBA_BLOCK
    kb = k.reshape(B, H, NB, MOBA_BLOCK, D)
    vb = v.reshape(B, H, NB, MOBA_BLOCK, D)
    kmean = jnp.mean(kb.astype(jnp.float32), axis=3)
    gate = jnp.einsum('bhsd,bhnd->bhsn', q.astype(jnp.float32), kmean)
    own = jnp.arange(SP) // MOBA_BLOCK
    past = jnp.arange(NB)[None, :] < own[:, None]
    gate = jnp.where(past, gate, NEG_INF)
    topk = min(MOBA_TOPK, NB)
    _, sel = lax.top_k(gate, topk)
    sel_ok = sel < own[None, None, :, None]
    nq = SP // MOBA_QCHUNK

    def to_chunks(t):
        return jnp.moveaxis(t.reshape(B, H, nq, MOBA_QCHUNK, t.shape[-1]), 2, 0)

    bidx = jnp.arange(B).reshape(B, 1, 1, 1)
    hidx = jnp.arange(H).reshape(1, H, 1, 1)
    h5 = jnp.arange(H).reshape(1, H, 1, 1, 1)
    scale = D ** -0.5
    nsel = topk * MOBA_BLOCK

    def chunk(args):
        ci, qi, si, oki = args
        q0 = ci * MOBA_QCHUNK
        qpos = q0 + jnp.arange(MOBA_QCHUNK)
        blk = q0 // MOBA_BLOCK
        kg = kb[bidx, hidx, si]
        vg = vb[bidx, hidx, si]
        kpos = si[..., None] * MOBA_BLOCK + jnp.arange(MOBA_BLOCK)
        dist_p = qpos[:, None, None] - kpos
        s_past = jnp.einsum('bhqd,bhqnjd->bhqnj', qi, kg).astype(jnp.float32) * scale
        s_past = s_past + bias_tab[t5_bucket(dist_p), h5]
        s_past = jnp.where(oki[..., None], s_past, NEG_INF).reshape(B, H, MOBA_QCHUNK, nsel)
        k_own = lax.dynamic_slice_in_dim(k, blk * MOBA_BLOCK, MOBA_BLOCK, axis=2)
        v_own = lax.dynamic_slice_in_dim(v, blk * MOBA_BLOCK, MOBA_BLOCK, axis=2)
        dist_o = qpos[:, None] - (blk * MOBA_BLOCK + jnp.arange(MOBA_BLOCK))[None, :]
        s_own = jnp.einsum('bhqd,bhkd->bhqk', qi, k_own).astype(jnp.float32) * scale
        s_own = jnp.where(dist_o >= 0, s_own + bias_tab.T[:, t5_bucket(dist_o)], NEG_INF)
        p = jax.nn.softmax(jnp.concatenate([s_past, s_own], axis=-1), axis=-1)
        p_past = p[..., :nsel].reshape(B, H, MOBA_QCHUNK, topk, MOBA_BLOCK).astype(v.dtype)
        p_own = p[..., nsel:].astype(v.dtype)
        return (jnp.einsum('bhqnj,bhqnjd->bhqd', p_past, vg)
                + jnp.einsum('bhqk,bhkd->bhqd', p_own, v_own))

    out = lax.map(chunk, (jnp.arange(nq), to_chunks(q), to_chunks(sel), to_chunks(sel_ok)))
    out = jnp.moveaxis(out, 0, 2).reshape(B, H, SP, D)
    return out[:, :, :S]


def diff_attention(q, k, v, lam_params, sub_gain, bias_tab, lam_init):
    B, H, S, D = v.shape
    lp = lam_params.astype(jnp.float32)
    lam = jnp.exp(jnp.sum(lp[0] * lp[1])) - jnp.exp(jnp.sum(lp[2] * lp[3])) + lam_init
    q1, q2 = q[..., :DIFF_QK_DIM], q[..., DIFF_QK_DIM:]
    k1, k2 = k[..., :DIFF_QK_DIM], k[..., DIFF_QK_DIM:]
    scale = DIFF_QK_DIM ** -0.5
    nb = S // DIFF_QBLOCK
    qb1 = jnp.moveaxis(q1.reshape(B, H, nb, DIFF_QBLOCK, DIFF_QK_DIM), 2, 0)
    qb2 = jnp.moveaxis(q2.reshape(B, H, nb, DIFF_QBLOCK, DIFF_QK_DIM), 2, 0)
    kpos = jnp.arange(S)

    def blk(args):
        i, a1, a2 = args
        qpos = i * DIFF_QBLOCK + jnp.arange(DIFF_QBLOCK)
        dist = qpos[:, None] - kpos[None, :]
        bias = bias_tab.T[:, t5_bucket(dist)]
        mask = dist >= 0
        s1 = jnp.einsum('bhqd,bhkd->bhqk', a1, k1).astype(jnp.float32) * scale + bias
        s2 = jnp.einsum('bhqd,bhkd->bhqk', a2, k2).astype(jnp.float32) * scale + bias
        p = (jax.nn.softmax(jnp.where(mask, s1, NEG_INF), axis=-1)
             - lam * jax.nn.softmax(jnp.where(mask, s2, NEG_INF), axis=-1))
        return jnp.einsum('bhqk,bhkd->bhqd', p.astype(v.dtype), v)

    o = lax.map(blk, (jnp.arange(nb), qb1, qb2))
    o = jnp.moveaxis(o, 0, 2).reshape(B, H, S, D)
    return rms_norm(o, sub_gain, DIFF_EPS) * (1.0 - lam_init)


def nsa_attention(q, kc, vc, ks, vs, kw, vw, gates, cmp_pos, cmp_w, bias_tab):
    B, Hn, S, D = q.shape
    G, R = NSA_KV_HEADS, NSA_GROUP
    qg = q.reshape(B, G, R, S, D)
    scale = D ** -0.5
    pos = jnp.arange(S)

    n_cmp = (S - NSA_CMP_LEN) // NSA_CMP_STRIDE + 1
    cmp_start = jnp.arange(n_cmp) * NSA_CMP_STRIDE
    cidx = cmp_start[:, None] + jnp.arange(NSA_CMP_LEN)[None, :]
    k_cmp = jnp.einsum('bgnld,lde->bgne', kc[:, :, cidx] + cmp_pos[0], cmp_w[0])
    v_cmp = jnp.einsum('bgnld,lde->bgne', vc[:, :, cidx] + cmp_pos[1], cmp_w[1])
    cmp_end = cmp_start + NSA_CMP_LEN - 1
    c_ok = cmp_end[None, :] <= pos[:, None]
    s_c = jnp.einsum('bgrsd,bgnd->bgrsn', qg, k_cmp).astype(jnp.float32) * scale
    p_c = jnp.where(c_ok, jax.nn.softmax(jnp.where(c_ok, s_c, NEG_INF), axis=-1), 0.0)
    o_cmp = jnp.einsum('bgrsn,bgnd->bgrsd', p_c.astype(vc.dtype), v_cmp)

    n_sel = S // NSA_SEL_BLOCK
    sel_start = jnp.arange(n_sel) * NSA_SEL_BLOCK
    overlap = ((cmp_start[:, None] <= (sel_start + NSA_SEL_BLOCK - 1)[None, :])
               & (cmp_end[:, None] >= sel_start[None, :])).astype(jnp.float32)
    imp = jnp.einsum('bgrsn,nm->bgsm', p_c, overlap)
    own = pos // NSA_SEL_BLOCK
    jj = jnp.arange(n_sel)[None, :]
    forced = (jj == 0) | (jj == own[:, None]) | (jj == own[:, None] - 1)
    imp = jnp.where(jj <= own[:, None], jnp.where(forced, NSA_FORCE, imp), NEG_INF)
    ksel = min(NSA_SEL_TOPK, n_sel)
    _, sidx = lax.top_k(imp, ksel)
    sok = sidx <= own[None, None, :, None]
    ksb = ks.reshape(B, G, n_sel, NSA_SEL_BLOCK, D)
    vsb = vs.reshape(B, G, n_sel, NSA_SEL_BLOCK, D)
    nq = S // NSA_SEL_QCHUNK
    q_ch = jnp.moveaxis(qg.reshape(B, G, R, nq, NSA_SEL_QCHUNK, D), 3, 0)
    s_ch = jnp.moveaxis(sidx.reshape(B, G, nq, NSA_SEL_QCHUNK, ksel), 2, 0)
    ok_ch = jnp.moveaxis(sok.reshape(B, G, nq, NSA_SEL_QCHUNK, ksel), 2, 0)
    tab_gr = bias_tab.reshape(REL_BUCKETS, G, R)
    bidx = jnp.arange(B).reshape(B, 1, 1, 1)
    gidx = jnp.arange(G).reshape(1, G, 1, 1)
    g6 = jnp.arange(G).reshape(1, G, 1, 1, 1, 1)
    r6 = jnp.arange(R).reshape(1, 1, R, 1, 1, 1)

    def sel_chunk(args):
        ci, qi, si, oki = args
        qpos = ci * NSA_SEL_QCHUNK + jnp.arange(NSA_SEL_QCHUNK)
        kg = ksb[bidx, gidx, si]
        vg = vsb[bidx, gidx, si]
        dist = qpos[:, None, None] - (si[..., None] * NSA_SEL_BLOCK + jnp.arange(NSA_SEL_BLOCK))
        bias = tab_gr[t5_bucket(dist)[:, :, None], g6, r6]
        mask = (oki[..., None] & (dist >= 0))[:, :, None]
        s = jnp.einsum('bgrqd,bgqnjd->bgrqnj', qi, kg).astype(jnp.float32) * scale
        s = jnp.where(mask, s + bias, NEG_INF)
        p = jax.nn.softmax(s.reshape(B, G, R, NSA_SEL_QCHUNK, -1), axis=-1).reshape(s.shape)
        return jnp.einsum('bgrqnj,bgqnjd->bgrqd', p.astype(vg.dtype), vg)

    o_sel = lax.map(sel_chunk, (jnp.arange(nq), q_ch, s_ch, ok_ch))
    o_sel = jnp.moveaxis(o_sel, 0, 3).reshape(B, G, R, S, D)

    band = NSA_WINDOW + NSA_WIN_QBLOCK
    kpad = jnp.pad(kw, ((0, 0), (0, 0), (NSA_WINDOW, 0), (0, 0)))
    vpad = jnp.pad(vw, ((0, 0), (0, 0), (NSA_WINDOW, 0), (0, 0)))
    nwb = S // NSA_WIN_QBLOCK
    qw = jnp.moveaxis(qg.reshape(B, G, R, nwb, NSA_WIN_QBLOCK, D), 3, 0)
    dist_w = jnp.arange(NSA_WIN_QBLOCK)[:, None] - jnp.arange(band)[None, :] + NSA_WINDOW
    bias_w = bias_tab.T[:, t5_bucket(dist_w)].reshape(G, R, NSA_WIN_QBLOCK, band)
    band_ok = (dist_w >= 0) & (dist_w < NSA_WINDOW)

    def win_block(args):
        i, qi = args
        kb_ = lax.dynamic_slice_in_dim(kpad, i * NSA_WIN_QBLOCK, band, axis=2)
        vb_ = lax.dynamic_slice_in_dim(vpad, i * NSA_WIN_QBLOCK, band, axis=2)
        kpos = i * NSA_WIN_QBLOCK - NSA_WINDOW + jnp.arange(band)
        mask = band_ok & (kpos >= 0)[None, :]
        s = jnp.einsum('bgrqd,bgkd->bgrqk', qi, kb_).astype(jnp.float32) * scale
        p = jax.nn.softmax(jnp.where(mask, s + bias_w, NEG_INF), axis=-1)
        return jnp.einsum('bgrqk,bgkd->bgrqd', p.astype(vb_.dtype), vb_)

    o_win = lax.map(win_block, (jnp.arange(nwb), qw))
    o_win = jnp.moveaxis(o_win, 0, 3).reshape(B, G, R, S, D)

    g = jax.nn.sigmoid(gates.astype(jnp.float32)).transpose(0, 2, 1, 3).reshape(B, G, R, S, NSA_BRANCHES)
    g = g.astype(q.dtype)
    o = g[..., 0:1] * o_cmp + g[..., 1:2] * o_sel + g[..., 2:3] * o_win
    return o.reshape(B, Hn, S, D)


def peer_layer(xn, w_q, sub_keys, u_tab, v_tab):
    B, S, D = xn.shape
    N = B * S
    xf = xn.reshape(N, D)
    qry = jnp.einsum('nd,de->ne', xf, w_q).reshape(N, PEER_HEADS, 2, PEER_KEY_HALF)
    sc = jnp.einsum('nhpd,hpkd->nhpk', qry, sub_keys).astype(jnp.float32)
    s1, i1 = lax.top_k(sc[:, :, 0], PEER_TOPK)
    s2, i2 = lax.top_k(sc[:, :, 1], PEER_TOPK)
    cand = (s1[..., :, None] + s2[..., None, :]).reshape(N, PEER_HEADS, PEER_TOPK * PEER_TOPK)
    cidx = (i1[..., :, None] * PEER_NKEYS + i2[..., None, :]).reshape(N, PEER_HEADS, PEER_TOPK * PEER_TOPK)
    top, tpos = lax.top_k(cand, PEER_TOPK)
    eidx = jnp.take_along_axis(cidx, tpos, axis=-1)
    gate = jax.nn.softmax(top, axis=-1)
    nc = N // PEER_TCHUNK

    def tok_chunk(args):
        xc, ec, gc = args
        ug = u_tab[ec]
        h = jnp.einsum('cd,chkd->chk', xc, ug).astype(jnp.float32)
        a = (jax.nn.gelu(h, approximate=False) * gc).astype(xc.dtype)
        vg = v_tab[ec]
        return jnp.einsum('chk,chkd->cd', a, vg)

    out = lax.map(tok_chunk, (xf.reshape(nc, PEER_TCHUNK, D),
                              eidx.reshape(nc, PEER_TCHUNK, PEER_HEADS, PEER_TOPK),
                              gate.reshape(nc, PEER_TCHUNK, PEER_HEADS, PEER_TOPK)))
    return out.reshape(B, S, D)


def setup_inputs(seed: int = 0) -> dict:
    key = jax.random.key(seed)
    ks = jax.random.split(key, 15)
    nrm = jax.random.normal
    f32 = jnp.float32
    return {
        'x': nrm(ks[0], (BATCH, SEQ, D_MODEL), f32),
        'rel_bias': 0.5 * nrm(ks[1], (REL_BUCKETS, N_HEADS), f32),
        'attn_norm': 1.0 + 0.05 * nrm(ks[2], (DEPTH, D_MODEL), f32),
        'w_in': nrm(ks[3], (DEPTH, D_MODEL, IN_WIDTH), f32) * D_MODEL ** -0.5,
        'diff_lambda': 0.1 * nrm(ks[4], (DEPTH, 4, DIFF_QK_DIM), f32),
        'diff_subln': 1.0 + 0.05 * nrm(ks[5], (DEPTH, HEAD_DIM), f32),
        'nsa_cmp_pos': 0.1 * nrm(ks[6], (DEPTH, 2, NSA_CMP_LEN, HEAD_DIM), f32),
        'nsa_cmp_w': nrm(ks[7], (DEPTH, 2, NSA_CMP_LEN, HEAD_DIM, HEAD_DIM), f32) * (NSA_CMP_LEN * HEAD_DIM) ** -0.5,
        'w_out': nrm(ks[8], (DEPTH, MIX_WIDTH, D_MODEL), f32) * MIX_WIDTH ** -0.5,
        'ffn_norm': 1.0 + 0.05 * nrm(ks[9], (DEPTH, D_MODEL), f32),
        'peer_wq': nrm(ks[10], (DEPTH, D_MODEL, PEER_HEADS * 2 * PEER_KEY_HALF), f32) * D_MODEL ** -0.5,
        'peer_subkeys': nrm(ks[11], (DEPTH, PEER_HEADS, 2, PEER_NKEYS, PEER_KEY_HALF), f32) * PEER_KEY_HALF ** -0.5,
        'peer_u': nrm(ks[12], (DEPTH, PEER_EXPERTS, D_MODEL), f32) * D_MODEL ** -0.5,
        'peer_v': nrm(ks[13], (DEPTH, PEER_EXPERTS, D_MODEL), f32) * PEER_HEADS ** -0.5,
        'final_norm': 1.0 + 0.05 * nrm(ks[14], (D_MODEL,), f32),
    }


def reference(x, rel_bias, attn_norm, w_in, diff_lambda, diff_subln, nsa_cmp_pos, nsa_cmp_w,
              w_out, ffn_norm, peer_wq, peer_subkeys, peer_u, peer_v, final_norm):
    B, S, _ = x.shape
    offs = [int(o) for o in np.cumsum(IN_SPLITS)[:-1]]
    bias_moba = rel_bias[:, :MOBA_HEADS]
    bias_diff = rel_bias[:, MOBA_HEADS:MOBA_HEADS + DIFF_HEADS]
    bias_nsa = rel_bias[:, MOBA_HEADS + DIFF_HEADS:]
    for l in range(DEPTH):
        h = rms_norm(x, attn_norm[l])
        proj = jnp.einsum('bsd,de->bse', h, w_in[l])
        (mq, mk, mv, dq, dk, dv, nq, nkc, nvc, nks, nvs, nkw, nvw, ngate) = jnp.split(proj, offs, axis=-1)
        o_moba = moba_attention(split_heads(mq, MOBA_HEADS), split_heads(mk, MOBA_HEADS),
                                split_heads(mv, MOBA_HEADS), bias_moba)
        lam_init = 0.8 - 0.6 * math.exp(-0.3 * l)
        o_diff = diff_attention(split_heads(dq, DIFF_HEADS), split_heads(dk, DIFF_HEADS),
                                split_heads(dv, DIFF_HEADS), diff_lambda[l], diff_subln[l],
                                bias_diff, lam_init)
        o_nsa = nsa_attention(split_heads(nq, NSA_HEADS),
                              split_heads(nkc, NSA_KV_HEADS), split_heads(nvc, NSA_KV_HEADS),
                              split_heads(nks, NSA_KV_HEADS), split_heads(nvs, NSA_KV_HEADS),
                              split_heads(nkw, NSA_KV_HEADS), split_heads(nvw, NSA_KV_HEADS),
                              ngate.reshape(B, S, NSA_HEADS, NSA_BRANCHES),
                              nsa_cmp_pos[l], nsa_cmp_w[l], bias_nsa)
        o = jnp.concatenate([o_moba, o_diff, o_nsa], axis=1)
        o = o.transpose(0, 2, 1, 3).reshape(B, S, MIX_WIDTH)
        x = x + jnp.einsum('bse,ed->bsd', o, w_out[l])
        h2 = rms_norm(x, ffn_norm[l])
        x = x + peer_layer(h2, peer_wq[l], peer_subkeys[l], peer_u[l], peer_v[l])
    return rms_norm(x, final_norm)
```

```cpp
#include <hip/hip_runtime.h>
#include <cstdint>
#include <cstdio>
#include <cstring>

#define LAS __attribute__((address_space(3)))
typedef unsigned short bf16_t;
typedef short bf16x8 __attribute__((ext_vector_type(8)));
typedef short bf16x4 __attribute__((ext_vector_type(4)));
typedef float f32x4 __attribute__((ext_vector_type(4)));
typedef float f32x2 __attribute__((ext_vector_type(2)));
typedef float f32x16 __attribute__((ext_vector_type(16)));
typedef unsigned u32x4 __attribute__((ext_vector_type(4)));
typedef unsigned u32x2 __attribute__((ext_vector_type(2)));
typedef __bf16 bf2_t __attribute__((ext_vector_type(2)));

#define XB_TMO      128
#define XB_XCNT(j)  (256  + 64 * (j))
#define XB_XSUB(j)  (1280 + 64 * (j))
#define XB_XGEN(j)  (2304 + 64 * (j))
#define XB_TOP      3328
#define XB_TOPGEN   3392
#define XCD_BAR_WORDS 3456
#define XB_SPIN_CAP (1u << 18)
#define LAS __attribute__((address_space(3)))

__device__ __forceinline__ unsigned xb_ld(unsigned* p)              { return __hip_atomic_load(p, __ATOMIC_RELAXED, __HIP_MEMORY_SCOPE_AGENT); }
__device__ __forceinline__ unsigned xb_add(unsigned* p, unsigned v) { return __hip_atomic_fetch_add(p, v, __ATOMIC_RELAXED, __HIP_MEMORY_SCOPE_AGENT); }
__device__ __forceinline__ unsigned xb_xcc_id() { return (unsigned)__builtin_amdgcn_s_getreg((3 << 11) | 20) & 0xFu; }
#define XB_SPIN(cond, bar) do { unsigned _sp = 0; while (cond) { __builtin_amdgcn_s_sleep(1); \
    if ((++_sp & 255u) == 0u) { if (xb_ld(&(bar)[XB_TMO])) break; if (_sp > XB_SPIN_CAP) { atomicAdd(&(bar)[XB_TMO], 1u); break; } } } } while (0)

struct XcdBarrier {
    unsigned* bar; unsigned x;
    volatile LAS unsigned* st;
};

__device__ __forceinline__ XcdBarrier xcd_barrier_post(unsigned* bar, volatile LAS unsigned* st) {
    XcdBarrier b; b.bar = bar; b.x = xb_xcc_id(); b.st = st;
    if (threadIdx.x == 0) (void)xb_add(&bar[XB_XCNT(b.x)], 1u);
    return b;
}
__device__ __forceinline__ void xcd_barrier_complete(unsigned* bar, unsigned x, unsigned& nloc, unsigned& nx) {
    const unsigned G = gridDim.x * gridDim.y * gridDim.z;
    unsigned sum, cnt, mine, sp = 0u;
    for (;;) {
        sum = 0u; cnt = 0u; mine = 0u;
#pragma unroll
        for (unsigned j = 0; j < 16; ++j) { const unsigned c = xb_ld(&bar[XB_XCNT(j)]); sum += c; cnt += (c > 0u) ? 1u : 0u; mine = (j == x) ? c : mine; }
        if (sum == G) break;
        __builtin_amdgcn_s_sleep(1);
        if ((++sp & 255u) == 0u) { if (xb_ld(&bar[XB_TMO])) break; if (sp > XB_SPIN_CAP) { atomicAdd(&bar[XB_TMO], 1u); break; } }
    }
    nloc = mine > 0u ? mine : 1u; nx = cnt > 0u ? cnt : 1u;
}

__device__ __forceinline__ void xcd_barrier(const XcdBarrier& b, int tid_in) {
    asm volatile("s_waitcnt vmcnt(0)" ::: "memory");
    __syncthreads();
    if (tid_in == 0) {
        unsigned* bar = b.bar;
        __builtin_amdgcn_s_waitcnt(0);
        unsigned nloc = b.st[0], nx = b.st[1];
        if (nloc == 0u) { xcd_barrier_complete(bar, b.x, nloc, nx); b.st[0] = nloc; b.st[1] = nx; }
        const unsigned old = xb_add(&bar[XB_XSUB(b.x)], 1u);
        const unsigned gen = old / nloc;
        if (old + 1u == (gen + 1u) * nloc) {
            __builtin_amdgcn_fence(__ATOMIC_RELEASE, "agent");
            asm volatile("s_waitcnt vmcnt(0)" ::: "memory");
            const unsigned og = xb_add(&bar[XB_TOP], 1u);
            const unsigned tg = og / nx;
            if (og + 1u == (tg + 1u) * nx) xb_add(&bar[XB_TOPGEN], 1u);
            else XB_SPIN(xb_ld(&bar[XB_TOPGEN]) == tg, bar);
            __builtin_amdgcn_fence(__ATOMIC_ACQUIRE, "agent");
            xb_add(&bar[XB_XGEN(b.x)], 1u);
            asm volatile("s_waitcnt vmcnt(0)" ::: "memory");
        } else {
            XB_SPIN(xb_ld(&bar[XB_XGEN(b.x)]) == gen, bar);
            __builtin_amdgcn_fence(__ATOMIC_ACQUIRE, "agent");
            asm volatile("s_waitcnt vmcnt(0)" ::: "memory");
        }
    }
    __syncthreads();
}
namespace pg8 {
#define PG8_LAS __attribute__((address_space(3)))
typedef unsigned short bf16_t;
typedef short bf16x8 __attribute__((ext_vector_type(8)));
typedef float f32x4 __attribute__((ext_vector_type(4)));
typedef unsigned u32x4 __attribute__((ext_vector_type(4)));
constexpr int BM = 256, BK = 64, HALF = 128, HTB = HALF * BK * 2  , STAGE_BYTES = 8 * HTB, NXCD = 8, WGM = 8;

__host__ __device__ __forceinline__ int lds_byte(int r, int c) { const int st = (r >> 4) * 2 + (c >> 5), rr = r & 15, cc = c & 31, ob = rr * 64 + cc * 2; return st * 1024 + (ob ^ (((ob >> 9) & 1) << 5)); }
__host__ __device__ __forceinline__ void stage_rc(int b, int& R, int& C) { const int st = b / 1024, sb = b % 1024, swz = sb ^ (((sb >> 9) & 1) << 5); R = (st >> 1) * 16 + swz / 64; C = (st & 1) * 32 + (swz % 64) / 2; }
__host__ __device__ __forceinline__ int perm32(int rho) { const int n = rho >> 4, i = rho & 15; return 8 * (i >> 2) + 4 * n + (i & 3); }

struct Unit { int pm, pn; };
struct Gemm { const bf16_t* A; const bf16_t* Bt; int M, N, K; };

struct StaticOrder {
    int nM, nN, nwg, G, c;
    __host__ __device__ void init(int M, int N, int G_, int c_) { nM = M / BM; nN = N / BM; nwg = nM * nN; G = G_; c = c_; }
    __host__ __device__ bool next(int i, Unit& u) const {
        const long L = (long)i * G + c; if (L >= nwg) return false;
        int wgid = (int)L; { const int q = nwg / NXCD, r = nwg % NXCD, xcd = wgid % NXCD, off = wgid / NXCD; wgid = (xcd < r ? xcd * (q + 1) : r * (q + 1) + (xcd - r) * q) + off; }
        const int nig = WGM * nN, gid = wgid / nig, fm = gid * WGM, gsz = (nM - fm) < WGM ? (nM - fm) : WGM;
        u.pm = fm + ((wgid % nig) % gsz); u.pn = (wgid % nig) / gsz; return true;
    }
    __device__ __forceinline__ void a_ready(const Unit&) const {}
    __device__ __forceinline__ void done(const Unit&) const {}
};
struct CountedOrder : StaticOrder {
    const unsigned* ready; unsigned need; unsigned* tmo;
    __device__ __forceinline__ void a_ready(const Unit& u) const {
        if (threadIdx.x < 64) {
            const unsigned long long t0 = __builtin_amdgcn_s_memrealtime(); unsigned polls = 0;
            while ((unsigned)__builtin_amdgcn_readfirstlane(__hip_atomic_load(ready + 64 * u.pm, __ATOMIC_RELAXED, __HIP_MEMORY_SCOPE_AGENT)) < need) {
                if ((++polls & 255u) == 0u && __builtin_amdgcn_readfirstlane(__hip_atomic_load(tmo, __ATOMIC_RELAXED, __HIP_MEMORY_SCOPE_AGENT)) != 0u) break;
                if (__builtin_amdgcn_s_memrealtime() - t0 > 2000000ull) {
                    if (threadIdx.x == 0) { unsigned expect = 0u; __hip_atomic_compare_exchange_strong(tmo + 1, &expect, 0x600u | (unsigned)(u.pm & 0xff), __ATOMIC_RELAXED, __ATOMIC_RELAXED, __HIP_MEMORY_SCOPE_AGENT); __hip_atomic_store(tmo, 1u, __ATOMIC_RELAXED, __HIP_MEMORY_SCOPE_AGENT); }
                    break; }
                __builtin_amdgcn_s_sleep(2); }
            __builtin_amdgcn_fence(__ATOMIC_ACQUIRE, "agent");
            asm volatile("s_waitcnt vmcnt(0)" ::: "memory");
        }
#if !defined(BROKEN_HOOK_NO_BARRIER)
        asm volatile("" ::: "memory"); __builtin_amdgcn_s_barrier(); asm volatile("" ::: "memory");
#endif
    }
};

__device__ __forceinline__ unsigned cvt_pk_bf16(float lo, float hi) { unsigned r; asm volatile("v_cvt_pk_bf16_f32 %0, %1, %2" : "=v"(r) : "v"(lo), "v"(hi)); return r; }
typedef float f32x2 __attribute__((ext_vector_type(2)));
__device__ __forceinline__ f32x2 gelu_pk(f32x2 v) {
    const f32x2 av = __builtin_elementwise_abs(v), d = av * 0.2316418882f + 1.0f;
    f32x2 t; t.x = __builtin_amdgcn_rcpf(d.x); t.y = __builtin_amdgcn_rcpf(d.y);
    f32x2 q = t * 0.5307027145f + (-0.7265760135f); q = q * t + 0.7107068705f; q = q * t + (-0.142248368f); q = q * t + 0.127414796f; q = q * t;
    const f32x2 s = (v * v) * (-0.72134752044f);
    f32x2 e; e.x = __builtin_amdgcn_exp2f(s.x); e.y = __builtin_amdgcn_exp2f(s.y);
    const f32x2 m = v * (q * e), r = v - m;
    f32x2 o; o.x = v.x < 0.f ? m.x : r.x; o.y = v.y < 0.f ? m.y : r.y; return o;
}

struct EpiF32 {
    static constexpr bool PERM = false, AFTER_DRAIN = false;
    float* C; int ldc; const float* bias;
    __device__ __forceinline__ void operator()(const f32x4 (&acc)[2][2][4][2], const Unit& u, int wr, int wc, int fr, int fq) const {
        const int row0 = u.pm * BM + wr * 64 + fr, col0 = u.pn * BM + wc * 32 + 4 * fq;
        f32x4 bv[2][2];
#pragma unroll
        for (int bj = 0; bj < 2; ++bj)
#pragma unroll
            for (int n = 0; n < 2; ++n) bv[bj][n] = bias ? *(const f32x4*)(bias + col0 + bj * HALF + n * 16) : (f32x4){0.f, 0.f, 0.f, 0.f};
#pragma unroll
        for (int ai = 0; ai < 2; ++ai)
#pragma unroll
            for (int m = 0; m < 4; ++m) { float* rowp = C + (size_t)(row0 + ai * HALF + m * 16) * ldc + col0;
#pragma unroll
                for (int bj = 0; bj < 2; ++bj)
#pragma unroll
                    for (int n = 0; n < 2; ++n) *(f32x4*)(rowp + bj * HALF + n * 16) = acc[ai][bj][m][n] + bv[bj][n]; }
    }
};
template <int ACT  > struct EpiBf16 {
    static constexpr bool PERM = true, AFTER_DRAIN = false;
    bf16_t* O; int ldc; const float* bias; int split_cols; size_t split_stride;
    __device__ __forceinline__ void operator()(const f32x4 (&acc)[2][2][4][2], const Unit& u, int wr, int wc, int fr, int fq) const {
        const int row0 = u.pm * BM + wr * 64 + fr; int colt = u.pn * BM; bf16_t* base = O;
        if (split_cols) { const int t = colt / split_cols; base += (size_t)t * split_stride; colt -= t * split_cols; }
        const int col0 = colt + wc * 32 + 8 * fq, bcol0 = u.pn * BM + wc * 32 + 8 * fq;
        f32x4 bv[2][2];
#pragma unroll
        for (int bj = 0; bj < 2; ++bj)
#pragma unroll
            for (int n = 0; n < 2; ++n) bv[bj][n] = bias ? *(const f32x4*)(bias + bcol0 + bj * HALF + 4 * n) : (f32x4){0.f, 0.f, 0.f, 0.f};
#pragma unroll
        for (int ai = 0; ai < 2; ++ai)
#pragma unroll
            for (int m = 0; m < 4; ++m) { bf16_t* rowp = base + (size_t)(row0 + ai * HALF + m * 16) * ldc + col0;
#pragma unroll
                for (int bj = 0; bj < 2; ++bj) { f32x4 v0 = acc[ai][bj][m][0] + bv[bj][0], v1 = acc[ai][bj][m][1] + bv[bj][1];
                    if (ACT == 1) { f32x2 a = gelu_pk((f32x2){v0[0], v0[1]}), b = gelu_pk((f32x2){v0[2], v0[3]}), c = gelu_pk((f32x2){v1[0], v1[1]}), d = gelu_pk((f32x2){v1[2], v1[3]});
                        v0 = (f32x4){a.x, a.y, b.x, b.y}; v1 = (f32x4){c.x, c.y, d.x, d.y}; }
                    if (ACT == 2) {
#pragma unroll
                        for (int j = 0; j < 4; ++j) { v0[j] = 0.5f * v0[j] * (1.0f + erff(v0[j] * 0.70710678f)); v1[j] = 0.5f * v1[j] * (1.0f + erff(v1[j] * 0.70710678f)); } }
                    u32x4 w; w.x = cvt_pk_bf16(v0[0], v0[1]); w.y = cvt_pk_bf16(v0[2], v0[3]); w.z = cvt_pk_bf16(v1[0], v1[1]); w.w = cvt_pk_bf16(v1[2], v1[3]);
                    *(u32x4*)(rowp + bj * HALF) = w; } }
    }
};
struct EpiResF32 {
    static constexpr bool PERM = false, AFTER_DRAIN = false;
    float* C; const float* R; int ldc;
    __device__ __forceinline__ void operator()(const f32x4 (&acc)[2][2][4][2], const Unit& u, int wr, int wc, int fr, int fq) const {
        const int row0 = u.pm * BM + wr * 64 + fr, col0 = u.pn * BM + wc * 32 + 4 * fq;
#pragma unroll
        for (int ai = 0; ai < 2; ++ai)
#pragma unroll
            for (int m = 0; m < 4; ++m) { const size_t off = (size_t)(row0 + ai * HALF + m * 16) * ldc + col0;
#pragma unroll
                for (int bj = 0; bj < 2; ++bj)
#pragma unroll
                    for (int n = 0; n < 2; ++n) { const f32x4 r = *(const f32x4*)(R + off + bj * HALF + n * 16); *(f32x4*)(C + off + bj * HALF + n * 16) = acc[ai][bj][m][n] + r; } }
    }
};
template <class Epi, class Sched, bool STAMP = false>
__device__ __forceinline__ void gemm_phase(PG8_LAS unsigned char* lds, const Gemm g, const Sched& S, const Epi& E, unsigned long long* stamps, int tid_in) {
    const int tid = tid_in, wid = __builtin_amdgcn_readfirstlane(tid >> 6), lane = tid & 63, wr = wid >> 2, wc = wid & 3, fr = lane & 15, fq = lane >> 4;
    const int K = g.K, nt = K / BK;
    int ts_lo = 0, ts_hi = 0, nts = 0; const unsigned long long rt_entry = STAMP ? (unsigned long long)wall_clock64() : 0ull;
#define PG8_STAMP() do { if (STAMP && wid == 0 && nts < 64) { const unsigned long long _c = (unsigned long long)clock64(); \
        ts_lo = (lane == nts) ? (int)(unsigned)_c : ts_lo; ts_hi = (lane == nts) ? (int)(unsigned)(_c >> 32) : ts_hi; ++nts; } } while (0)
    PG8_STAMP();
    unsigned voffA[2], voffB[2];
#pragma unroll
    for (int i = 0; i < 2; ++i) { int R, C; stage_rc(tid * 16 + i * 8192, R, C); const int Rb = Epi::PERM ? ((R & ~31) + perm32(R & 31)) : R;
        voffA[i] = (unsigned)(R * K + C) * 2u; voffB[i] = (unsigned)(Rb * K + C) * 2u; }
    const size_t kstep = (size_t)(BK * 2);
    const size_t hstep = (size_t)HALF * K * 2;
    const size_t tstep = 2 * hstep;
    const unsigned ldsw = (unsigned)wid * 1024u;
    const int aoff = lds_byte(wr * 64 + fr, fq * 8), boff = lds_byte(wc * 32 + fr, fq * 8);
#define PG8_SA(b, h) (((b) * 2 + (h)) * HTB)
#define PG8_SB(b, h) ((4 + (b) * 2 + (h)) * HTB)
#define PG8_STAGE(bufoff, gbase, voff) do { _Pragma("unroll") for (int _i = 0; _i < 2; ++_i) \
        __builtin_amdgcn_global_load_lds((const unsigned*)((const char*)(gbase) + (voff)[_i]), (PG8_LAS unsigned*)(lds + (bufoff) + ldsw + _i * 8192), 16, 0, 0); } while (0)
#define PG8_LDA(dst, b, h) do { _Pragma("unroll") for (int m = 0; m < 4; ++m) _Pragma("unroll") for (int k = 0; k < 2; ++k) dst[m][k] = *(const PG8_LAS bf16x8*)(lds + PG8_SA(b, h) + aoff + m * 2048 + k * 1024); } while (0)
#define PG8_LDB(dst, b, h) do { _Pragma("unroll") for (int n = 0; n < 2; ++n) _Pragma("unroll") for (int k = 0; k < 2; ++k) dst[n][k] = *(const PG8_LAS bf16x8*)(lds + PG8_SB(b, h) + boff + n * 2048 + k * 1024); } while (0)
#define PG8_MMA(ai, bj, At, Bt) do { __builtin_amdgcn_s_setprio(1); _Pragma("unroll") for (int m = 0; m < 4; ++m) _Pragma("unroll") for (int n = 0; n < 2; ++n) _Pragma("unroll") for (int k = 0; k < 2; ++k) \
        acc[ai][bj][m][n] = __builtin_amdgcn_mfma_f32_16x16x32_bf16(Bt[n][k], At[m][k], acc[ai][bj][m][n], 0, 0, 0); __builtin_amdgcn_s_setprio(0); } while (0)
#define PG8_WAIT_V(n) asm volatile("s_waitcnt vmcnt(" #n ")" ::: "memory")
#define PG8_WAIT_L(n) asm volatile("s_waitcnt lgkmcnt(" #n ")" ::: "memory")
#define PG8_BAR __builtin_amdgcn_s_barrier()
#define PG8_SCHED __builtin_amdgcn_sched_barrier(0)
    Unit cur, nxt; int ui = 0;
    if (!S.next(0, cur)) return;
    f32x4 acc[2][2][4][2];
#pragma unroll
    for (int a = 0; a < 2; ++a)
#pragma unroll
        for (int b = 0; b < 2; ++b)
#pragma unroll
            for (int m = 0; m < 4; ++m)
#pragma unroll
                for (int n = 0; n < 2; ++n) acc[a][b][m][n] = (f32x4){0.f, 0.f, 0.f, 0.f};
    bf16x8 At[4][2], B0[2][2], B1[2][2];
    const char* cA = (const char*)g.A + (size_t)cur.pm * tstep; const char* cB = (const char*)g.Bt + (size_t)cur.pn * tstep;
    S.a_ready(cur);
    PG8_STAGE(PG8_SB(0, 0), cB, voffB); PG8_STAGE(PG8_SA(0, 0), cA, voffA); PG8_STAGE(PG8_SB(0, 1), cB + hstep, voffB); PG8_STAGE(PG8_SA(0, 1), cA + hstep, voffA);
    if (wr == 1) PG8_BAR;
    PG8_WAIT_V(4); PG8_BAR;
    PG8_STAGE(PG8_SB(1, 0), cB + kstep, voffB); PG8_STAGE(PG8_SA(1, 0), cA + kstep, voffA); PG8_STAGE(PG8_SB(1, 1), cB + hstep + kstep, voffB);
    PG8_WAIT_V(6); PG8_BAR;
    PG8_STAMP();
    for (;;) {
        const bool has_next = S.next(ui + 1, nxt);
        const char* nA = has_next ? (const char*)g.A + (size_t)nxt.pm * tstep : cA; const char* nB = has_next ? (const char*)g.Bt + (size_t)nxt.pn * tstep : cB;
        for (int t = 0; t < nt; t += 2) {
            const bool last = (t == nt - 2);
            const char* a1 = cA + (size_t)(t + 1) * kstep;
            const char* a2 = last ? nA : cA + (size_t)(t + 2) * kstep; const char* b2 = last ? nB : cB + (size_t)(t + 2) * kstep;
            const char* a3 = a2 + kstep; const char* b3 = b2 + kstep;
            if (last && has_next) S.a_ready(nxt);
            PG8_LDB(B0, 0, 0); PG8_SCHED; PG8_LDA(At, 0, 0); PG8_STAGE(PG8_SA(1, 1), a1 + hstep, voffA);
            PG8_WAIT_L(8); PG8_BAR; PG8_WAIT_L(0); PG8_MMA(0, 0, At, B0); PG8_BAR; PG8_SCHED;
            PG8_LDB(B1, 0, 1); PG8_STAGE(PG8_SB(0, 0), b2, voffB);
            PG8_BAR; PG8_WAIT_L(0); PG8_MMA(0, 1, At, B1); PG8_BAR;
            PG8_LDA(At, 0, 1); PG8_STAGE(PG8_SA(0, 0), a2, voffA);
            PG8_BAR; PG8_WAIT_L(0); PG8_MMA(1, 0, At, B0); PG8_BAR; PG8_SCHED;
            PG8_STAGE(PG8_SB(0, 1), b2 + hstep, voffB);
            PG8_WAIT_V(6); PG8_BAR; PG8_MMA(1, 1, At, B1); PG8_BAR;
            PG8_LDB(B0, 1, 0); PG8_SCHED; PG8_LDA(At, 1, 0); PG8_STAGE(PG8_SA(0, 1), a2 + hstep, voffA);
            PG8_WAIT_L(8); PG8_BAR; PG8_WAIT_L(0); PG8_MMA(0, 0, At, B0); PG8_BAR; PG8_SCHED;
            PG8_LDB(B1, 1, 1); PG8_STAGE(PG8_SB(1, 0), b3, voffB);
            PG8_BAR; PG8_WAIT_L(0); PG8_MMA(0, 1, At, B1); PG8_BAR;
            PG8_LDA(At, 1, 1); PG8_STAGE(PG8_SA(1, 0), a3, voffA);
            PG8_BAR; PG8_WAIT_L(0); PG8_MMA(1, 0, At, B0); PG8_BAR; PG8_SCHED;
            PG8_STAGE(PG8_SB(1, 1), b3 + hstep, voffB);
            PG8_WAIT_V(6); PG8_BAR; PG8_MMA(1, 1, At, B1); PG8_BAR;
        }
        PG8_STAMP();
        if constexpr (!Epi::AFTER_DRAIN) { E(acc, cur, wr, wc, fr, fq); S.done(cur); }
        PG8_STAMP();
        if (!has_next) break;
#pragma unroll
        for (int a = 0; a < 2; ++a)
#pragma unroll
            for (int b = 0; b < 2; ++b)
#pragma unroll
                for (int m = 0; m < 4; ++m)
#pragma unroll
                    for (int n = 0; n < 2; ++n) acc[a][b][m][n] = (f32x4){0.f, 0.f, 0.f, 0.f};
        cur = nxt; cA = nA; cB = nB; ++ui;
    }
    PG8_WAIT_V(0);
    if (wr == 0) PG8_BAR;
    PG8_BAR;
    if constexpr (Epi::AFTER_DRAIN) { E.fused(acc, cur, wr, wc, fr, fq, lds, wid, lane); S.done(cur); }
    PG8_STAMP();
    if (STAMP && wid == 0) { stamps[lane] = lane < nts ? (((unsigned long long)(unsigned)ts_hi << 32) | (unsigned)ts_lo) : 0ull;
        if (lane == 62) stamps[62] = rt_entry; if (lane == 63) stamps[63] = (unsigned long long)wall_clock64(); }
#undef PG8_STAMP
#undef PG8_SA
#undef PG8_SB
#undef PG8_STAGE
#undef PG8_LDA
#undef PG8_LDB
#undef PG8_MMA
#undef PG8_WAIT_V
#undef PG8_WAIT_L
#undef PG8_BAR
#undef PG8_SCHED
}
}

constexpr int T_TOK = 16384, DM = 2048, SEQ = 4096, NBATCH = 4, DEPTH = 2;
constexpr int INW = 5656;
constexpr int N1 = 4352;
constexpr int NV = 1536;
constexpr int C_MQ = 0, C_MK = 512, C_DQ = 1024, C_DK = 1536, C_NQ = 2048, C_KC = 3072, C_VC = 3328, C_KS = 3584, C_KW = 3840, C_GATE = 4096;
constexpr int R_MV = 0, R_DV = 512, R_VS = 1024, R_VW = 1280;
constexpr float LOG2E = 1.4426950408889634f;
constexpr float ATT_C128 = 0.08838834764831845f * LOG2E;
constexpr float ATT_C64 = 0.125f * LOG2E;

__device__ const unsigned char T5B[128] = {0, 1, 2, 3, 4, 5, 6, 7, 8, 9, 10, 11, 12, 13, 14, 15, 16, 16, 16, 17, 17, 18, 18, 18, 19, 19, 19, 20, 20, 20, 20, 21, 21, 21, 21, 22, 22, 22, 22, 22, 23, 23, 23, 23, 23, 23, 24, 24, 24, 24, 24, 24, 25, 25, 25, 25, 25, 25, 25, 26, 26, 26, 26, 26, 26, 26, 26, 27, 27, 27, 27, 27, 27, 27, 27, 27, 27, 28, 28, 28, 28, 28, 28, 28, 28, 28, 28, 29, 29, 29, 29, 29, 29, 29, 29, 29, 29, 29, 29, 30, 30, 30, 30, 30, 30, 30, 30, 30, 30, 30, 30, 30, 30, 31, 31, 31, 31, 31, 31, 31, 31, 31, 31, 31, 31, 31, 31, 31};

constexpr size_t al256(size_t x) { return (x + 255) & ~(size_t)255; }
constexpr size_t WS_CTL = 0;
constexpr size_t CTL_BYTES = 32768;
constexpr size_t WS_BIAS = WS_CTL + CTL_BYTES;
constexpr size_t WS_LAM = WS_BIAS + al256(16 * 132 * 4);
constexpr size_t WS_WT1 = WS_LAM + 256;
constexpr size_t WS_WTV = WS_WT1 + (size_t)DEPTH * N1 * DM * 2;
constexpr size_t WS_WTO = WS_WTV + (size_t)DEPTH * NV * DM * 2;
constexpr size_t WS_WTQ = WS_WTO + (size_t)DEPTH * DM * DM * 2;
constexpr size_t WS_WCT = WS_WTQ + (size_t)DEPTH * DM * DM * 2;
constexpr size_t WS_SKB = WS_WCT + (size_t)DEPTH * 2 * 128 * 4096 * 2;
constexpr size_t WS_UB = WS_SKB + (size_t)DEPTH * 8 * 2 * 128 * 128 * 2;
constexpr size_t WS_VB = WS_UB + (size_t)DEPTH * 16384 * DM * 2;
constexpr size_t WS_HN = WS_VB + (size_t)DEPTH * 16384 * DM * 2;
constexpr size_t WS_PROJ = WS_HN + (size_t)T_TOK * DM * 2;
constexpr size_t WS_VT = WS_PROJ + (size_t)T_TOK * N1 * 2;
constexpr size_t WS_OMIX = WS_VT + (size_t)NV * T_TOK * 2;
constexpr size_t WS_OC = WS_OMIX + (size_t)T_TOK * DM * 2;
constexpr size_t WS_OW = WS_OC + (size_t)T_TOK * 1024 * 2;
constexpr size_t WS_XW = WS_OW + (size_t)T_TOK * 1024 * 2;
constexpr size_t WS_KCMP = WS_XW + (size_t)T_TOK * DM * 4;
constexpr size_t WS_VCMPT = WS_KCMP + (size_t)8 * 256 * 128 * 2;
constexpr size_t WS_KMEAN = WS_VCMPT + (size_t)8 * 128 * 256 * 2;
constexpr size_t WS_SELM = WS_KMEAN + (size_t)16 * 16 * 128 * 2;
constexpr size_t WS_EIDX = WS_SELM + (size_t)8 * 4096 * 8;
constexpr size_t WS_EGATE = WS_EIDX + (size_t)T_TOK * 128 * 4;
constexpr size_t WS_END = WS_EGATE + (size_t)T_TOK * 128 * 4;
static_assert(WS_END <= (size_t)1 << 30, "workspace over 1 GiB");

constexpr int CW_BAR = 0;
constexpr int CW_Q = 4096;
#define CWQ(i) (CW_Q + 64 * (i))

constexpr int LDS_MISC = 162816;
constexpr int LDS_BYTES = LDS_MISC + 1024;

struct Params {
    const float* x; const float* rel_bias; const float* attn_norm; const float* w_in; const float* diff_lambda; const float* diff_subln;
    const float* cmp_pos; const float* cmp_w; const float* w_out; const float* ffn_norm; const float* peer_wq; const float* peer_subkeys;
    const float* peer_u; const float* peer_v; const float* final_norm;
    float* out; unsigned char* ws;
};

__device__ __forceinline__ unsigned cvt_pk_bf16(float lo, float hi) { unsigned r; asm volatile("v_cvt_pk_bf16_f32 %0, %1, %2" : "=v"(r) : "v"(lo), "v"(hi)); return r; }
__device__ __forceinline__ float bf_lo(unsigned u) { return __uint_as_float(u << 16); }
__device__ __forceinline__ float bf_hi(unsigned u) { return __uint_as_float(u & 0xffff0000u); }
__device__ __forceinline__ float wave_sum(float v) {
#pragma unroll
    for (int o = 32; o >= 1; o >>= 1) v += __shfl_xor(v, o);
    return v;
}
__device__ __forceinline__ float xor32f(float v) { return __shfl_xor(v, 32); }

struct Ctx {
    LAS unsigned char* lds;
    int tid, lane, wave, G, bid;
    unsigned* ctl;
};

__device__ __forceinline__ void conv_tile_T(const Ctx& c, const float* src, int ld_src, int k0, int src_col0, int nvalid, bf16_t* dst, int ldd, int n0) {
    LAS float* tile = (LAS float*)c.lds;
    const int tid = c.tid;
    {
        const int r = tid >> 4, c4 = (tid & 15) * 4;
#pragma unroll
        for (int i = 0; i < 2; ++i) {
            const int row = r + 32 * i;
            f32x4 v = {0.f, 0.f, 0.f, 0.f};
            if (c4 < nvalid) v = *(const f32x4*)(src + (size_t)(k0 + row) * ld_src + src_col0 + c4);
            tile[row * 65 + c4 + 0] = v[0]; tile[row * 65 + c4 + 1] = v[1]; tile[row * 65 + c4 + 2] = v[2]; tile[row * 65 + c4 + 3] = v[3];
        }
    }
    __syncthreads();
    {
        const int n = tid >> 3, kc = (tid & 7) * 8;
        float v[8];
#pragma unroll
        for (int j = 0; j < 8; ++j) v[j] = tile[(kc + j) * 65 + n];
        u32x4 w; w.x = cvt_pk_bf16(v[0], v[1]); w.y = cvt_pk_bf16(v[2], v[3]); w.z = cvt_pk_bf16(v[4], v[5]); w.w = cvt_pk_bf16(v[6], v[7]);
        *(u32x4*)(dst + (size_t)(n0 + n) * ldd + k0 + kc) = w;
    }
    __syncthreads();
}

__device__ __forceinline__ int n1_to_src(int n1) {
    if (n1 < 1024) return n1;
    if (n1 < 2048) return n1 + 512;
    if (n1 < 3840) return n1 + 1024;
    if (n1 < 4096) return n1 + 1280;
    return n1 + 1536;
}
__device__ __forceinline__ int nv_to_src(int nv) {
    if (nv < 512) return nv + 1024;
    if (nv < 1024) return nv + 2048;
    if (nv < 1280) return nv + 3840;
    return nv + 4096;
}

constexpr int CONV_STRIPS_A = 65 + 24 + 32 + 32;
constexpr int CONV_JOBS_A = CONV_STRIPS_A * 32;
constexpr int CONV_JOBS_L = CONV_JOBS_A + 4 * 64;

__device__ __forceinline__ void phase_prologue(const Ctx& c, const Params& p) {
    unsigned char* ws = p.ws;
    for (int job = c.bid; job < DEPTH * CONV_JOBS_L; job += c.G) {
        const int l = job / CONV_JOBS_L, j = job % CONV_JOBS_L;
        if (j < CONV_JOBS_A) {
            const int strip = j >> 5, kt = j & 31;
            if (strip < 65) {
                const int n1 = strip * 64;
                conv_tile_T(c, p.w_in + (size_t)l * DM * INW, INW, kt * 64, n1_to_src(n1), strip < 64 ? 64 : 24, (bf16_t*)(ws + WS_WT1) + (size_t)l * N1 * DM, DM, n1);
            } else if (strip < 89) {
                const int nv = (strip - 65) * 64;
                conv_tile_T(c, p.w_in + (size_t)l * DM * INW, INW, kt * 64, nv_to_src(nv), 64, (bf16_t*)(ws + WS_WTV) + (size_t)l * NV * DM, DM, nv);
            } else if (strip < 121) {
                const int n = (strip - 89) * 64;
                conv_tile_T(c, p.w_out + (size_t)l * DM * DM, DM, kt * 64, n, 64, (bf16_t*)(ws + WS_WTO) + (size_t)l * DM * DM, DM, n);
            } else {
                const int n = (strip - 121) * 64;
                conv_tile_T(c, p.peer_wq + (size_t)l * DM * DM, DM, kt * 64, n, 64, (bf16_t*)(ws + WS_WTQ) + (size_t)l * DM * DM, DM, n);
            }
        } else {
            const int jj = j - CONV_JOBS_A, strip = jj >> 6, kt = jj & 63;
            const int kv = strip >> 1, n = (strip & 1) * 64;
            conv_tile_T(c, p.cmp_w + ((size_t)l * 2 + kv) * 4096 * 128, 128, kt * 64, n, 64, (bf16_t*)(ws + WS_WCT) + ((size_t)l * 2 + kv) * 128 * 4096, 4096, n);
        }
    }
    const size_t gtid = (size_t)c.bid * 512 + c.tid, gthreads = (size_t)c.G * 512;
    for (size_t i = gtid; i < (size_t)DEPTH * 192 * DM / 8; i += gthreads) {
        const size_t l = i / (192 * DM / 8), r = i % (192 * DM / 8);
        *(u32x4*)((bf16_t*)(ws + WS_WT1) + (l * N1 + 4160) * DM + r * 8) = (u32x4){0u, 0u, 0u, 0u};
    }
    {
        const size_t n8 = (size_t)DEPTH * 16384 * DM / 8;
        const float* su = p.peer_u; const float* sv = p.peer_v; bf16_t* du = (bf16_t*)(ws + WS_UB); bf16_t* dv = (bf16_t*)(ws + WS_VB);
        for (size_t i = gtid; i < n8; i += gthreads) {
            const f32x4 a = *(const f32x4*)(su + i * 8), b = *(const f32x4*)(su + i * 8 + 4);
            u32x4 w; w.x = cvt_pk_bf16(a[0], a[1]); w.y = cvt_pk_bf16(a[2], a[3]); w.z = cvt_pk_bf16(b[0], b[1]); w.w = cvt_pk_bf16(b[2], b[3]);
            *(u32x4*)(du + i * 8) = w;
            const f32x4 a2 = *(const f32x4*)(sv + i * 8), b2 = *(const f32x4*)(sv + i * 8 + 4);
            u32x4 w2; w2.x = cvt_pk_bf16(a2[0], a2[1]); w2.y = cvt_pk_bf16(a2[2], a2[3]); w2.z = cvt_pk_bf16(b2[0], b2[1]); w2.w = cvt_pk_bf16(b2[2], b2[3]);
            *(u32x4*)(dv + i * 8) = w2;
        }
        const size_t m8 = (size_t)DEPTH * 8 * 2 * 128 * 128 / 8;
        const float* ss = p.peer_subkeys; bf16_t* ds = (bf16_t*)(ws + WS_SKB);
        for (size_t i = gtid; i < m8; i += gthreads) {
            const f32x4 a = *(const f32x4*)(ss + i * 8), b = *(const f32x4*)(ss + i * 8 + 4);
            u32x4 w; w.x = cvt_pk_bf16(a[0], a[1]); w.y = cvt_pk_bf16(a[2], a[3]); w.z = cvt_pk_bf16(b[0], b[1]); w.w = cvt_pk_bf16(b[2], b[3]);
            *(u32x4*)(ds + i * 8) = w;
        }
    }
    if (c.bid == 0) {
        float* bt = (float*)(ws + WS_BIAS);
        for (int i = c.tid; i < 16 * 132; i += 512) {
            const int h = i / 132, d = i % 132;
            const int bucket = d < 128 ? (int)T5B[d] : 31;
            bt[i] = p.rel_bias[bucket * 16 + h] * LOG2E;
        }
        if (c.tid < DEPTH) {
            const float* lp = p.diff_lambda + (size_t)c.tid * 4 * 64;
            float s1 = 0.f, s2 = 0.f;
            for (int i = 0; i < 64; ++i) { s1 += lp[i] * lp[64 + i]; s2 += lp[128 + i] * lp[192 + i]; }
            const float lam_init = 0.8f - 0.6f * expf(-0.3f * (float)c.tid);
            ((float*)(ws + WS_LAM))[c.tid] = expf(s1) - expf(s2) + lam_init;
        }
    }
}

__device__ __forceinline__ void phase_rmsnorm_bf16(const Ctx& c, const float* x, const float* gain, bf16_t* out) {
    const int gw = c.bid * 8 + c.wave, nw = c.G * 8, lane = c.lane;
    f32x4 g[8];
#pragma unroll
    for (int i = 0; i < 8; ++i) g[i] = *(const f32x4*)(gain + i * 256 + lane * 4);
    for (int row = gw; row < T_TOK; row += nw) {
        const float* xr = x + (size_t)row * DM;
        f32x4 v[8]; float ss = 0.f;
#pragma unroll
        for (int i = 0; i < 8; ++i) { v[i] = *(const f32x4*)(xr + i * 256 + lane * 4); ss += v[i][0] * v[i][0] + v[i][1] * v[i][1] + v[i][2] * v[i][2] + v[i][3] * v[i][3]; }
        ss = wave_sum(ss);
        const float rstd = rsqrtf(ss * (1.0f / DM) + 1e-6f);
        bf16_t* orow = out + (size_t)row * DM;
#pragma unroll
        for (int i = 0; i < 8; ++i) {
            u32x2 w; w.x = cvt_pk_bf16(v[i][0] * rstd * g[i][0], v[i][1] * rstd * g[i][1]); w.y = cvt_pk_bf16(v[i][2] * rstd * g[i][2], v[i][3] * rstd * g[i][3]);
            *(u32x2*)(orow + i * 256 + lane * 4) = w;
        }
    }
}
__device__ __forceinline__ void phase_rmsnorm_f32(const Ctx& c, const float* x, const float* gain, float* out) {
    const int gw = c.bid * 8 + c.wave, nw = c.G * 8, lane = c.lane;
    f32x4 g[8];
#pragma unroll
    for (int i = 0; i < 8; ++i) g[i] = *(const f32x4*)(gain + i * 256 + lane * 4);
    for (int row = gw; row < T_TOK; row += nw) {
        const float* xr = x + (size_t)row * DM;
        f32x4 v[8]; float ss = 0.f;
#pragma unroll
        for (int i = 0; i < 8; ++i) { v[i] = *(const f32x4*)(xr + i * 256 + lane * 4); ss += v[i][0] * v[i][0] + v[i][1] * v[i][1] + v[i][2] * v[i][2] + v[i][3] * v[i][3]; }
        ss = wave_sum(ss);
        const float rstd = rsqrtf(ss * (1.0f / DM) + 1e-6f);
        float* orow = out + (size_t)row * DM;
#pragma unroll
        for (int i = 0; i < 8; ++i) *(f32x4*)(orow + i * 256 + lane * 4) = v[i] * rstd * g[i];
    }
}
constexpr int A_KP = 272, A_VP = 136;
constexpr int A_KBUF = 64 * A_KP;
constexpr int A_VBUF = 128 * A_VP;
constexpr int A_K0 = 0, A_V0 = 2 * A_KBUF;
constexpr int A_BIAS = 69632;
constexpr int A_TLIST = A_BIAS + 4 * 132 * 4;
constexpr int A_MISCW = A_TLIST + 160 * 4;
constexpr int A_IMP = 73728;
constexpr int A_SELM = A_IMP + 64 * 65 * 4;
constexpr int A_END = A_SELM + 64 * 8;
constexpr int A_Q = 92160;
static_assert(A_MISCW + 256 <= A_IMP && A_END <= A_Q && A_Q + 8 * 8192 <= LDS_MISC, "attention LDS map");

struct TileSrc { const unsigned char* kbase; int kpitch; const unsigned char* vbase; int vpitch; };

struct TileRegs { u32x4 k[2]; u32x4 v[2]; };
__device__ __forceinline__ void tile_load(TileRegs& r, const TileSrc& s, int key0, int tid) {
#pragma unroll
    for (int i = 0; i < 2; ++i) {
        const int ck = tid + 512 * i;
        r.k[i] = *(const u32x4*)(s.kbase + (size_t)(key0 + (ck >> 4)) * s.kpitch + (ck & 15) * 16);
        r.v[i] = *(const u32x4*)(s.vbase + (size_t)(ck >> 3) * s.vpitch + (size_t)key0 * 2 + (ck & 7) * 16);
    }
}
__device__ __forceinline__ void tile_store(const TileRegs& r, LAS unsigned char* lds, int buf, int tid) {
#pragma unroll
    for (int i = 0; i < 2; ++i) {
        const int ck = tid + 512 * i;
        *(LAS u32x4*)(lds + A_K0 + buf * A_KBUF + (ck >> 4) * A_KP + (ck & 15) * 16) = r.k[i];
        LAS unsigned char* vp = lds + A_V0 + buf * A_VBUF + (ck >> 3) * A_VP + (ck & 7) * 16;
        *(LAS u32x2*)(vp) = (u32x2){r.v[i].x, r.v[i].y};
        *(LAS u32x2*)(vp + 8) = (u32x2){r.v[i].z, r.v[i].w};
    }
}

struct SoftState { float m, l; };

template <int NKS, bool USE_BIAS, bool BINS>
__device__ __forceinline__ void attn_tile_core(LAS unsigned char* lds, int buf, int kcol, const LAS unsigned char* qf, f32x16 (&O)[4], SoftState& st, int lane,
                                          float cs, bool far, float bconst, int dq, unsigned W, bool okq, const LAS float* btab, float (&gs)[8], float (&gl)[8]) {
    const int r = lane & 31, h = lane >> 5;
    const LAS unsigned char* Kl = lds + A_K0 + buf * A_KBUF + r * A_KP + kcol + h * 16;
    f32x16 s0, s1;
#pragma unroll
    for (int i = 0; i < 16; ++i) { s0[i] = 0.f; s1[i] = 0.f; }
#pragma unroll
    for (int ks = 0; ks < NKS; ++ks) {
        const bf16x8 k0 = *(const LAS bf16x8*)(Kl + ks * 32);
        const bf16x8 k1 = *(const LAS bf16x8*)(Kl + 32 * A_KP + ks * 32);
        const bf16x8 qv = *(const LAS bf16x8*)(qf + ks * 1024);
        s0 = __builtin_amdgcn_mfma_f32_32x32x16_bf16(k0, qv, s0, 0, 0, 0);
        s1 = __builtin_amdgcn_mfma_f32_32x32x16_bf16(k1, qv, s1, 0, 0, 0);
    }
    const float NEG = -__builtin_inff();
    float tmax = NEG;
    if (far) {
#pragma unroll
        for (int i = 0; i < 16; ++i) {
            s0[i] = okq ? fmaf(s0[i], cs, bconst) : NEG; s1[i] = okq ? fmaf(s1[i], cs, bconst) : NEG;
            tmax = fmaxf(tmax, fmaxf(s0[i], s1[i]));
        }
    } else {
#pragma unroll
        for (int i = 0; i < 16; ++i) {
            const int c0 = (i & 3) + 8 * (i >> 2);
            const int d0 = dq - c0, d1 = dq - c0 - 32;
            float b0 = 0.f, b1 = 0.f;
            if (USE_BIAS) { b0 = btab[min(max(d0, 0), 128)]; b1 = btab[min(max(d1, 0), 128)]; }
            s0[i] = (okq && (unsigned)d0 < W) ? fmaf(s0[i], cs, b0) : NEG;
            s1[i] = (okq && (unsigned)d1 < W) ? fmaf(s1[i], cs, b1) : NEG;
            tmax = fmaxf(tmax, fmaxf(s0[i], s1[i]));
        }
    }
    tmax = fmaxf(tmax, xor32f(tmax));
    const float mn = fmaxf(st.m, tmax);
    const float alpha = __builtin_amdgcn_exp2f(st.m - mn);
    st.m = mn;
    float ps = 0.f;
#pragma unroll
    for (int i = 0; i < 16; ++i) { s0[i] = __builtin_amdgcn_exp2f(s0[i] - mn); s1[i] = __builtin_amdgcn_exp2f(s1[i] - mn); ps += s0[i] + s1[i]; }
    st.l = st.l * alpha + ps;
    if (BINS) {
#pragma unroll
        for (int gq = 0; gq < 4; ++gq) {
            gs[gq] = (s0[4 * gq] + s0[4 * gq + 1]) + (s0[4 * gq + 2] + s0[4 * gq + 3]); gl[gq] = s0[4 * gq + 3];
            gs[4 + gq] = (s1[4 * gq] + s1[4 * gq + 1]) + (s1[4 * gq + 2] + s1[4 * gq + 3]); gl[4 + gq] = s1[4 * gq + 3];
        }
    }
    if (!__all(alpha == 1.0f)) {
#pragma unroll
        for (int db = 0; db < 4; ++db)
#pragma unroll
            for (int i = 0; i < 16; ++i) O[db][i] *= alpha;
    }
    bf16x8 pf[4];
    {
        u32x4 w;
        w.x = cvt_pk_bf16(s0[0], s0[1]); w.y = cvt_pk_bf16(s0[2], s0[3]); w.z = cvt_pk_bf16(s0[4], s0[5]); w.w = cvt_pk_bf16(s0[6], s0[7]); pf[0] = __builtin_bit_cast(bf16x8, w);
        w.x = cvt_pk_bf16(s0[8], s0[9]); w.y = cvt_pk_bf16(s0[10], s0[11]); w.z = cvt_pk_bf16(s0[12], s0[13]); w.w = cvt_pk_bf16(s0[14], s0[15]); pf[1] = __builtin_bit_cast(bf16x8, w);
        w.x = cvt_pk_bf16(s1[0], s1[1]); w.y = cvt_pk_bf16(s1[2], s1[3]); w.z = cvt_pk_bf16(s1[4], s1[5]); w.w = cvt_pk_bf16(s1[6], s1[7]); pf[2] = __builtin_bit_cast(bf16x8, w);
        w.x = cvt_pk_bf16(s1[8], s1[9]); w.y = cvt_pk_bf16(s1[10], s1[11]); w.z = cvt_pk_bf16(s1[12], s1[13]); w.w = cvt_pk_bf16(s1[14], s1[15]); pf[3] = __builtin_bit_cast(bf16x8, w);
    }
    const LAS unsigned char* Vl = lds + A_V0 + buf * A_VBUF + r * A_VP + h * 8;
#pragma unroll
    for (int db = 0; db < 4; ++db)
#pragma unroll
        for (int s = 0; s < 4; ++s) {
            const u32x2 lo = *(const LAS u32x2*)(Vl + db * 32 * A_VP + s * 32);
            const u32x2 hi = *(const LAS u32x2*)(Vl + db * 32 * A_VP + s * 32 + 16);
            const u32x4 w = {lo.x, lo.y, hi.x, hi.y};
            O[db] = __builtin_amdgcn_mfma_f32_32x32x16_bf16(__builtin_bit_cast(bf16x8, w), pf[s], O[db], 0, 0, 0);
        }
}
template <int NKS, bool USE_BIAS>
__device__ __forceinline__ void attn_tile(LAS unsigned char* lds, int buf, int kcol, const LAS unsigned char* qf, f32x16 (&O)[4], SoftState& st, int lane,
                                          float cs, bool far, float bconst, int dq, unsigned W, bool okq, const LAS float* btab) {
    float gs[8], gl[8];
    attn_tile_core<NKS, USE_BIAS, false>(lds, buf, kcol, qf, O, st, lane, cs, far, bconst, dq, W, okq, btab, gs, gl);
}
template <int NKS>
__device__ __forceinline__ void attn_tile_p(LAS unsigned char* lds, int buf, const LAS unsigned char* qf, f32x16 (&O)[4], SoftState& st, int lane, float cs, int dq, float (&gs)[8], float (&gl)[8]) {
    attn_tile_core<NKS, false, true>(lds, buf, 0, qf, O, st, lane, cs, false, 0.f, dq, 0x80000000u, true, nullptr, gs, gl);
}

template <int NKS>
__device__ __forceinline__ void attn_tile_stats(LAS unsigned char* lds, int buf, const LAS unsigned char* qf, SoftState& st, int lane, float cs, int dq) {
    const int r = lane & 31, h = lane >> 5;
    const LAS unsigned char* Kl = lds + A_K0 + buf * A_KBUF + r * A_KP + h * 16;
    f32x16 s0, s1;
#pragma unroll
    for (int i = 0; i < 16; ++i) { s0[i] = 0.f; s1[i] = 0.f; }
#pragma unroll
    for (int ks = 0; ks < NKS; ++ks) {
        const bf16x8 k0 = *(const LAS bf16x8*)(Kl + ks * 32);
        const bf16x8 k1 = *(const LAS bf16x8*)(Kl + 32 * A_KP + ks * 32);
        const bf16x8 qv = *(const LAS bf16x8*)(qf + ks * 1024);
        s0 = __builtin_amdgcn_mfma_f32_32x32x16_bf16(k0, qv, s0, 0, 0, 0);
        s1 = __builtin_amdgcn_mfma_f32_32x32x16_bf16(k1, qv, s1, 0, 0, 0);
    }
    const float NEG = -__builtin_inff();
    float tmax = NEG;
#pragma unroll
    for (int i = 0; i < 16; ++i) {
        const int c0 = (i & 3) + 8 * (i >> 2);
        s0[i] = (dq - c0 >= 0) ? s0[i] * cs : NEG; s1[i] = (dq - c0 - 32 >= 0) ? s1[i] * cs : NEG;
        tmax = fmaxf(tmax, fmaxf(s0[i], s1[i]));
    }
    tmax = fmaxf(tmax, xor32f(tmax));
    const float mn = fmaxf(st.m, tmax);
    const float alpha = __builtin_amdgcn_exp2f(st.m - mn);
    st.m = mn;
    float ps = 0.f;
#pragma unroll
    for (int i = 0; i < 16; ++i) ps += __builtin_amdgcn_exp2f(s0[i] - mn) + __builtin_amdgcn_exp2f(s1[i] - mn);
    st.l = st.l * alpha + ps;
}

template <int NKS>
__device__ __forceinline__ const LAS unsigned char* load_qfrags(const Ctx& c, const bf16_t* qrow0, int pitch_elems) {
    const int lane = c.lane;
    const bf16_t* pq = qrow0 + (size_t)(lane & 31) * pitch_elems + (lane >> 5) * 8;
    LAS unsigned char* dst = c.lds + A_Q + c.wave * 8192 + lane * 16;
#pragma unroll
    for (int ks = 0; ks < NKS; ++ks) *(LAS bf16x8*)(dst + ks * 1024) = *(const bf16x8*)(pq + ks * 16);
    return dst;
}

__device__ __forceinline__ void store_o_bf16(const f32x16 (&O)[4], float scale, bf16_t* orow, int lane) {
    const int h = lane >> 5;
#pragma unroll
    for (int db = 0; db < 4; ++db)
#pragma unroll
        for (int g = 0; g < 4; ++g) {
            u32x2 w; w.x = cvt_pk_bf16(O[db][4 * g] * scale, O[db][4 * g + 1] * scale); w.y = cvt_pk_bf16(O[db][4 * g + 2] * scale, O[db][4 * g + 3] * scale);
            *(u32x2*)(orow + db * 32 + g * 8 + h * 4) = w;
        }
}

__device__ __forceinline__ int next_item(const Ctx& c, int q) {
    volatile LAS int* slot = (volatile LAS int*)(c.lds + LDS_MISC + 64);
    __syncthreads();
    if (c.tid == 0) *slot = (int)__hip_atomic_fetch_add(c.ctl + CWQ(q), 1u, __ATOMIC_RELAXED, __HIP_MEMORY_SCOPE_AGENT);
    __syncthreads();
    return *slot;
}

#define ATTN_LOOP_BEGIN(ntiles, src)                                                          \
    {   TileRegs tr_;                                                                          \
        const volatile LAS int* tl_ = (const volatile LAS int*)(c.lds + A_TLIST);              \
        const int nt_ = (ntiles);                                                              \
        if (nt_ > 0) { tile_load(tr_, (src), tl_[0], c.tid); tile_store(tr_, c.lds, 0, c.tid); } \
        __syncthreads();                                                                       \
        for (int ti_ = 0; ti_ < nt_; ++ti_) {                                                  \
            const int buf_ = ti_ & 1; const int key0 = tl_[ti_];                               \
            if (ti_ + 1 < nt_) tile_load(tr_, (src), tl_[ti_ + 1], c.tid);
#define ATTN_LOOP_END()                                                                        \
            if (ti_ + 1 < nt_) tile_store(tr_, c.lds, buf_ ^ 1, c.tid);                        \
            __syncthreads();                                                                   \
        }                                                                                      \
    }

__device__ __forceinline__ void phase_prep(const Ctx& c, const Params& p, int l) {
    unsigned char* ws = p.ws;
    const bf16_t* PROJ = (const bf16_t*)(ws + WS_PROJ);
    const int gw = c.bid * 8 + c.wave, nw = c.G * 8, lane = c.lane;
    for (int it = gw; it < 512; it += nw) {
        const int bhb = it >> 1, half = it & 1, bh = bhb >> 4, blk = bhb & 15, b = bh >> 2, hh = bh & 3;
        const bf16_t* src = PROJ + (size_t)(b * SEQ + blk * 256) * N1 + C_MK + hh * 128 + half * 64 + lane;
        float s = 0.f;
#pragma unroll 8
        for (int k = 0; k < 256; ++k) s += bf_lo((unsigned)src[(size_t)k * N1]);
        ((bf16_t*)(ws + WS_KMEAN))[(size_t)bhb * 128 + half * 64 + lane] = (bf16_t)(cvt_pk_bf16(s * (1.0f / 256.0f), 0.f) & 0xffffu);
    }
    for (int it = gw; it < 512; it += nw) {
        const int et = it & 3, nt = (it >> 2) & 7, bg = (it >> 5) & 7, kv = it >> 8;
        const int b = bg >> 1, g = bg & 1;
        const int r = lane & 31, h = lane >> 5;
        int n = nt * 32 + r; if (n > 254) n = 254;
        const bf16_t* arow = PROJ + (size_t)(b * SEQ + 16 * n) * N1 + (kv ? C_VC : C_KC) + g * 128;
        const bf16_t* wrow = (const bf16_t*)(ws + WS_WCT) + (((size_t)l * 2 + kv) * 128 + et * 32 + r) * 4096;
        const float* pos = p.cmp_pos + ((size_t)l * 2 + kv) * 4096;
        f32x16 acc;
#pragma unroll
        for (int i = 0; i < 16; ++i) acc[i] = 0.f;
#pragma unroll 4
        for (int ks = 0; ks < 256; ++ks) {
            const int k = ks * 16 + h * 8;
            const int lw = k >> 7, d = k & 127;
            const u32x4 av = *(const u32x4*)(arow + (size_t)lw * N1 + d);
            const f32x4 p0 = *(const f32x4*)(pos + k), p1 = *(const f32x4*)(pos + k + 4);
            u32x4 aw;
            aw.x = cvt_pk_bf16(bf_lo(av.x) + p0[0], bf_hi(av.x) + p0[1]); aw.y = cvt_pk_bf16(bf_lo(av.y) + p0[2], bf_hi(av.y) + p0[3]);
            aw.z = cvt_pk_bf16(bf_lo(av.z) + p1[0], bf_hi(av.z) + p1[1]); aw.w = cvt_pk_bf16(bf_lo(av.w) + p1[2], bf_hi(av.w) + p1[3]);
            const bf16x8 bw = *(const bf16x8*)(wrow + k);
            acc = __builtin_amdgcn_mfma_f32_32x32x16_bf16(__builtin_bit_cast(bf16x8, aw), bw, acc, 0, 0, 0);
        }
        const int e = et * 32 + r;
        if (kv == 0) {
            bf16_t* dst = (bf16_t*)(ws + WS_KCMP) + (size_t)bg * 256 * 128;
#pragma unroll
            for (int i = 0; i < 16; ++i) {
                const int nn = nt * 32 + (i & 3) + 8 * (i >> 2) + 4 * h;
                dst[(size_t)nn * 128 + e] = nn < 255 ? (bf16_t)(cvt_pk_bf16(acc[i], 0.f) & 0xffffu) : (bf16_t)0;
            }
        } else {
            bf16_t* dst = (bf16_t*)(ws + WS_VCMPT) + (size_t)bg * 128 * 256 + (size_t)e * 256;
#pragma unroll
            for (int g4 = 0; g4 < 4; ++g4) {
                const int nn = nt * 32 + 8 * g4 + 4 * h;
                u32x2 w; w.x = cvt_pk_bf16(acc[4 * g4], acc[4 * g4 + 1]); w.y = cvt_pk_bf16(acc[4 * g4 + 2], nn + 3 < 255 ? acc[4 * g4 + 3] : 0.f);
                *(u32x2*)(dst + nn) = w;
            }
        }
    }
}
__device__ __forceinline__ unsigned wave_or(unsigned v) {
#pragma unroll
    for (int o = 32; o >= 1; o >>= 1) v |= (unsigned)__shfl_xor((int)v, o);
    return (unsigned)__builtin_amdgcn_readfirstlane((int)v);
}
__device__ __forceinline__ float sigmoidf_(float x) { return 1.0f / (1.0f + __expf(-x)); }
__device__ __forceinline__ void zero_o(f32x16 (&O)[4]) {
#pragma unroll
    for (int db = 0; db < 4; ++db)
#pragma unroll
        for (int i = 0; i < 16; ++i) O[db][i] = 0.f;
}
__device__ __forceinline__ void load_bias_tab(const Ctx& c, const Params& p, int head0, int nheads) {
    LAS float* bt = (LAS float*)(c.lds + A_BIAS);
    const float* src = (const float*)(p.ws + WS_BIAS) + head0 * 132;
    for (int i = c.tid; i < nheads * 132; i += 512) bt[i] = src[i];
}

__device__ __forceinline__ void item_moba(const Ctx& c, const Params& p, int b, int hh, int own) {
    unsigned char* ws = p.ws;
    const bf16_t* PROJ = (const bf16_t*)(ws + WS_PROJ);
    const int lane = c.lane, r = lane & 31, h = lane >> 5, tok0 = b * SEQ;
    const int qw0 = own * 256 + 32 * c.wave, qpos = qw0 + r;
    volatile LAS unsigned* mw = (volatile LAS unsigned*)(c.lds + A_MISCW);
    volatile LAS int* tl = (volatile LAS int*)(c.lds + A_TLIST);
    if (c.tid == 0) mw[0] = 0u;
    load_bias_tab(c, p, hh, 1);
    const LAS unsigned char* qf = load_qfrags<8>(c, PROJ + (size_t)(tok0 + qw0) * N1 + C_MQ + hh * 128, N1);
    __syncthreads();
    unsigned sel = 0u;
    {
        const bf16_t* km = (const bf16_t*)(ws + WS_KMEAN) + ((size_t)(b * 4 + hh) * 16 + (r < 16 ? r : 15)) * 128 + h * 8;
        f32x16 gsc;
#pragma unroll
        for (int i = 0; i < 16; ++i) gsc[i] = 0.f;
#pragma unroll
        for (int ks = 0; ks < 8; ++ks) gsc = __builtin_amdgcn_mfma_f32_32x32x16_bf16(*(const bf16x8*)(km + ks * 16), *(const LAS bf16x8*)(qf + ks * 1024), gsc, 0, 0, 0);
        const float NEG = -__builtin_inff();
        float v[8];
#pragma unroll
        for (int i = 0; i < 8; ++i) {
            const int blk = (i & 3) + 8 * (i >> 2) + 4 * h;
            v[i] = blk < own ? __uint_as_float((__float_as_uint(gsc[i]) & ~15u) | (unsigned)(15 - blk)) : NEG;
        }
#pragma unroll
        for (int it = 0; it < 3; ++it) {
            float lm = v[0];
#pragma unroll
            for (int i = 1; i < 8; ++i) lm = fmaxf(lm, v[i]);
            const float pm = fmaxf(lm, xor32f(lm));
            if (pm > NEG) sel |= 1u << (15u - (__float_as_uint(pm) & 15u));
#pragma unroll
            for (int i = 0; i < 8; ++i) v[i] = (v[i] == pm) ? NEG : v[i];
        }
    }
    const unsigned wsel = wave_or(sel);
    if (lane == 0 && wsel) __hip_atomic_fetch_or((LAS unsigned*)(c.lds + A_MISCW), wsel, __ATOMIC_RELAXED, __HIP_MEMORY_SCOPE_WORKGROUP);
    __syncthreads();
    const unsigned bsel = mw[0];
    if (c.tid == 0) {
        int n = 0;
        for (int j = 0; j < own; ++j) if ((bsel >> j) & 1u) { for (int t = 0; t < 4; ++t) tl[n++] = j * 256 + t * 64; }
        for (int t = 0; t < 4; ++t) tl[n++] = own * 256 + t * 64;
        mw[1] = (unsigned)n;
    }
    __syncthreads();
    const int ntiles = (int)mw[1];
    TileSrc src;
    src.kbase = (const unsigned char*)(PROJ + (size_t)tok0 * N1 + C_MK + hh * 128); src.kpitch = N1 * 2;
    src.vbase = (const unsigned char*)((const bf16_t*)(ws + WS_VT) + (size_t)(R_MV + hh * 128) * T_TOK + tok0); src.vpitch = T_TOK * 2;
    f32x16 O[4]; zero_o(O);
    SoftState st; st.m = -1e30f; st.l = 0.f;
    const LAS float* bt = (const LAS float*)(c.lds + A_BIAS);
    const float bconst = bt[128];
    ATTN_LOOP_BEGIN(ntiles, src)
        const int blk = key0 >> 8;
        const bool past = blk < own;
        const bool need = past ? (((wsel >> blk) & 1u) != 0u) : (key0 <= qw0 + 31);
        if (need) {
            const bool okq = past ? (((sel >> blk) & 1u) != 0u) : true;
            const bool far = (qw0 - (key0 + 63)) >= 128;
            attn_tile<8, true>(c.lds, buf_, 0, qf, O, st, lane, ATT_C128, far, bconst, qpos - key0 - 4 * h, 0x80000000u, okq, bt);
        }
    ATTN_LOOP_END()
    const float lt = st.l + xor32f(st.l);
    const float inv = lt > 0.f ? 1.0f / lt : 0.f;
#ifdef ABL_MOBA
    store_o_bf16(O, 0.f, (bf16_t*)(ws + WS_OMIX) + (size_t)(tok0 + qpos) * DM + hh * 128, lane);
#else
    store_o_bf16(O, inv, (bf16_t*)(ws + WS_OMIX) + (size_t)(tok0 + qpos) * DM + hh * 128, lane);
#endif
}

__device__ __forceinline__ void item_diff(const Ctx& c, const Params& p, int l, int b, int hh, int qb) {
    unsigned char* ws = p.ws;
    const bf16_t* PROJ = (const bf16_t*)(ws + WS_PROJ);
    const int lane = c.lane, r = lane & 31, h = lane >> 5, tok0 = b * SEQ;
    const int map = c.wave >> 2, sub = c.wave & 3;
    const int qw0 = qb * 128 + 32 * sub, qpos = qw0 + r;
    volatile LAS int* tl = (volatile LAS int*)(c.lds + A_TLIST);
    const int ntiles = 2 * qb + 2;
    for (int i = c.tid; i < ntiles; i += 512) tl[i] = i * 64;
    load_bias_tab(c, p, 4 + hh, 1);
    const LAS unsigned char* qf = load_qfrags<4>(c, PROJ + (size_t)(tok0 + qw0) * N1 + C_DQ + hh * 128 + map * 64, N1);
    TileSrc src;
    src.kbase = (const unsigned char*)(PROJ + (size_t)tok0 * N1 + C_DK + hh * 128); src.kpitch = N1 * 2;
    src.vbase = (const unsigned char*)((const bf16_t*)(ws + WS_VT) + (size_t)(R_DV + hh * 128) * T_TOK + tok0); src.vpitch = T_TOK * 2;
    f32x16 O[4]; zero_o(O);
    SoftState st; st.m = -1e30f; st.l = 0.f;
    const LAS float* bt = (const LAS float*)(c.lds + A_BIAS);
    __syncthreads();
    const float bconst = bt[128];
    ATTN_LOOP_BEGIN(ntiles, src)
        if (key0 <= qw0 + 31) {
            const bool far = (qw0 - (key0 + 63)) >= 128;
            attn_tile<4, true>(c.lds, buf_, map * 128, qf, O, st, lane, ATT_C64, far, bconst, qpos - key0 - 4 * h, 0x80000000u, true, bt);
        }
    ATTN_LOOP_END()
    const float lt = st.l + xor32f(st.l);
    const float inv = lt > 0.f ? 1.0f / lt : 0.f;
    LAS float* ex = (LAS float*)c.lds;
    if (map == 1) {
#pragma unroll
        for (int db = 0; db < 4; ++db)
#pragma unroll
            for (int g = 0; g < 4; ++g)
                *(LAS f32x4*)(ex + (sub * 32 + r) * 132 + db * 32 + g * 8 + h * 4) = (f32x4){O[db][4 * g] * inv, O[db][4 * g + 1] * inv, O[db][4 * g + 2] * inv, O[db][4 * g + 3] * inv};
    }
    __syncthreads();
    if (map == 0) {
        const float lam = ((const float*)(ws + WS_LAM))[l];
        const float lam_init = 0.8f - 0.6f * expf(-0.3f * (float)l);
        float ss = 0.f;
#pragma unroll
        for (int db = 0; db < 4; ++db)
#pragma unroll
            for (int g = 0; g < 4; ++g) {
                const f32x4 o2 = *(const LAS f32x4*)(ex + (sub * 32 + r) * 132 + db * 32 + g * 8 + h * 4);
#pragma unroll
                for (int j = 0; j < 4; ++j) { const float o = O[db][4 * g + j] * inv - lam * o2[j]; O[db][4 * g + j] = o; ss += o * o; }
            }
        ss += xor32f(ss);
#ifdef ABL_DIFF
        const float rr = 0.f;
#else
        const float rr = rsqrtf(ss * (1.0f / 128.0f) + 1e-5f) * (1.0f - lam_init);
#endif
        const float* sg = p.diff_subln + (size_t)l * 128;
        bf16_t* orow = (bf16_t*)(ws + WS_OMIX) + (size_t)(tok0 + qpos) * DM + 512 + hh * 128;
#pragma unroll
        for (int db = 0; db < 4; ++db)
#pragma unroll
            for (int g = 0; g < 4; ++g) {
                const int d = db * 32 + g * 8 + h * 4;
                const f32x4 gg = *(const f32x4*)(sg + d);
                u32x2 w; w.x = cvt_pk_bf16(O[db][4 * g] * rr * gg[0], O[db][4 * g + 1] * rr * gg[1]); w.y = cvt_pk_bf16(O[db][4 * g + 2] * rr * gg[2], O[db][4 * g + 3] * rr * gg[3]);
                *(u32x2*)(orow + d) = w;
            }
    }
}

__device__ __forceinline__ void item_nsa_win(const Ctx& c, const Params& p, int b, int g, int qb) {
    unsigned char* ws = p.ws;
    const bf16_t* PROJ = (const bf16_t*)(ws + WS_PROJ);
    const int lane = c.lane, r = lane & 31, h = lane >> 5, tok0 = b * SEQ;
    const int r4 = c.wave & 3, sub = c.wave >> 2, hn = g * 4 + r4;
    const int qw0 = qb * 64 + 32 * sub, qpos = qw0 + r;
    volatile LAS int* tl = (volatile LAS int*)(c.lds + A_TLIST);
    const int t_lo = qb >= 8 ? qb - 8 : 0, ntiles = qb - t_lo + 1;
    for (int i = c.tid; i < ntiles; i += 512) tl[i] = (t_lo + i) * 64;
    load_bias_tab(c, p, 8 + g * 4, 4);
    const LAS unsigned char* qf = load_qfrags<8>(c, PROJ + (size_t)(tok0 + qw0) * N1 + C_NQ + hn * 128, N1);
    TileSrc src;
    src.kbase = (const unsigned char*)(PROJ + (size_t)tok0 * N1 + C_KW + g * 128); src.kpitch = N1 * 2;
    src.vbase = (const unsigned char*)((const bf16_t*)(ws + WS_VT) + (size_t)(R_VW + g * 128) * T_TOK + tok0); src.vpitch = T_TOK * 2;
    f32x16 O[4]; zero_o(O);
    SoftState st; st.m = -1e30f; st.l = 0.f;
    const LAS float* bt = (const LAS float*)(c.lds + A_BIAS) + r4 * 132;
    __syncthreads();
    const float bconst = bt[128];
    ATTN_LOOP_BEGIN(ntiles, src)
        if (key0 <= qw0 + 31 && key0 + 63 >= qw0 - 511) {
            const bool far = (qw0 - (key0 + 63)) >= 128 && (qw0 + 31 - key0) < 512;
            attn_tile<8, true>(c.lds, buf_, 0, qf, O, st, lane, ATT_C128, far, bconst, qpos - key0 - 4 * h, 512u, true, bt);
        }
    ATTN_LOOP_END()
    const float lt = st.l + xor32f(st.l);
    const float gate = sigmoidf_(bf_lo((unsigned)PROJ[(size_t)(tok0 + qpos) * N1 + C_GATE + hn * 3 + 2]));
#ifdef ABL_WIN
    const float sc = 0.f;
#else
    const float sc = lt > 0.f ? gate / lt : 0.f;
#endif
    store_o_bf16(O, sc, (bf16_t*)(ws + WS_OW) + (size_t)(tok0 + qpos) * 1024 + hn * 128, lane);
}

__device__ __forceinline__ void item_nsa_cmp(const Ctx& c, const Params& p, int b, int g, int qb) {
    unsigned char* ws = p.ws;
    const bf16_t* PROJ = (const bf16_t*)(ws + WS_PROJ);
    const int lane = c.lane, r = lane & 31, h = lane >> 5, tok0 = b * SEQ, bg = b * 2 + g;
    const int r4 = c.wave & 3, sub = c.wave >> 2, hn = g * 4 + r4;
    const int qw0 = qb * 64 + 32 * sub, qpos = qw0 + r, ql = 32 * sub + r;
    volatile LAS int* tl = (volatile LAS int*)(c.lds + A_TLIST);
    LAS float* imp = (LAS float*)(c.lds + A_IMP);
    LAS unsigned* selm = (LAS unsigned*)(c.lds + A_SELM);
    const int nmax_blk = (qb * 64 + 63 - 31) >> 4;
    const int nt = (nmax_blk >> 6) + 1;
    for (int i = c.tid; i < 2 * nt; i += 512) tl[i] = (i % nt) * 64;
    for (int i = c.tid; i < 64 * 65; i += 512) imp[i] = 0.f;
    for (int i = c.tid; i < 128; i += 512) selm[i] = 0u;
    const LAS unsigned char* qf = load_qfrags<8>(c, PROJ + (size_t)(tok0 + qw0) * N1 + C_NQ + hn * 128, N1);
    TileSrc src;
    src.kbase = ws + WS_KCMP + (size_t)bg * 256 * 128 * 2; src.kpitch = 256;
    src.vbase = ws + WS_VCMPT + (size_t)bg * 128 * 256 * 2; src.vpitch = 512;
    const int nmax_q = qpos >= 31 ? (qpos - 31) >> 4 : -1;
    const int nmax_w = (qw0 + 31) >= 31 ? (qw0 + 31 - 31) >> 4 : -1;
    f32x16 O[4]; zero_o(O);
    SoftState st; st.m = -1e30f; st.l = 0.f;
    float inv = 0.f;
    __syncthreads();
    ATTN_LOOP_BEGIN(2 * nt, src)
        if (ti_ == nt) {
            const float lt = st.l + xor32f(st.l);
            inv = lt > 0.f ? 1.0f / lt : 0.f;
            st.l = 0.f;
        }
        if (key0 <= nmax_w) {
            if (ti_ < nt) attn_tile_stats<8>(c.lds, buf_, qf, st, lane, ATT_C128, nmax_q - key0 - 4 * h);
            else {
                float gs[8], gl[8];
                attn_tile_p<8>(c.lds, buf_, qf, O, st, lane, ATT_C128, nmax_q - key0 - 4 * h, gs, gl);
#pragma unroll
                for (int kb = 0; kb < 2; ++kb)
#pragma unroll
                    for (int gq = 0; gq < 4; ++gq) {
                        const int m = (key0 >> 2) + 8 * kb + 2 * gq + h;
                        __hip_atomic_fetch_add(imp + ql * 65 + m, gs[4 * kb + gq] * inv, __ATOMIC_RELAXED, __HIP_MEMORY_SCOPE_WORKGROUP);
                        __hip_atomic_fetch_add(imp + ql * 65 + m + 1, gl[4 * kb + gq] * inv, __ATOMIC_RELAXED, __HIP_MEMORY_SCOPE_WORKGROUP);
                    }
            }
        }
    ATTN_LOOP_END()
    {
        const float gate = sigmoidf_(bf_lo((unsigned)PROJ[(size_t)(tok0 + qpos) * N1 + C_GATE + hn * 3 + 0]));
#ifdef ABL_CMP
        const float cscale = 0.f;
#else
        const float cscale = inv * gate;
#endif
        store_o_bf16(O, cscale, (bf16_t*)(ws + WS_OC) + (size_t)(tok0 + qpos) * 1024 + hn * 128, lane);
    }
    {
        const int own = qb, q = c.tid >> 3, part = c.tid & 7;
        unsigned lo = 0u, hi = 0u;
        if (own + 1 <= 16) {
            if (part == 0) { lo = own >= 31 ? 0xffffffffu : ((2u << own) - 1u); }
        } else {
            if (part == 0) { lo = 1u; const int a = own - 1; if (a < 32) lo |= 1u << a; else hi |= 1u << (a - 32); if (own < 32) lo |= 1u << own; else hi |= 1u << (own - 32); }
            const LAS float* iq = imp + q * 65;
            for (int mm = part * 8; mm < part * 8 + 8; ++mm) {
                if (mm >= 1 && mm <= own - 2) {
                    const float vme = iq[mm];
                    int rank = 0;
                    for (int m2 = 1; m2 <= own - 2; ++m2) { const float v2 = iq[m2]; rank += (v2 > vme || (v2 == vme && m2 < mm)) ? 1 : 0; }
                    if (rank < 13) { if (mm < 32) lo |= 1u << mm; else hi |= 1u << (mm - 32); }
                }
            }
        }
        if (lo) __hip_atomic_fetch_or(selm + q * 2, lo, __ATOMIC_RELAXED, __HIP_MEMORY_SCOPE_WORKGROUP);
        if (hi) __hip_atomic_fetch_or(selm + q * 2 + 1, hi, __ATOMIC_RELAXED, __HIP_MEMORY_SCOPE_WORKGROUP);
        __syncthreads();
        if (c.tid < 64) {
            const volatile LAS unsigned* sv = (const volatile LAS unsigned*)selm;
            u32x2 w; w.x = sv[c.tid * 2]; w.y = sv[c.tid * 2 + 1];
            *(u32x2*)(ws + WS_SELM + ((size_t)bg * SEQ + qb * 64 + c.tid) * 8) = w;
        }
    }
}

__device__ __forceinline__ void item_nsa_sel(const Ctx& c, const Params& p, int b, int g, int qb) {
    unsigned char* ws = p.ws;
    const bf16_t* PROJ = (const bf16_t*)(ws + WS_PROJ);
    const int lane = c.lane, r = lane & 31, h = lane >> 5, tok0 = b * SEQ, bg = b * 2 + g;
    const int r4 = c.wave & 3, sub = c.wave >> 2, hn = g * 4 + r4;
    const int qw0 = qb * 64 + 32 * sub, qpos = qw0 + r;
    volatile LAS unsigned* mw = (volatile LAS unsigned*)(c.lds + A_MISCW);
    volatile LAS int* tl = (volatile LAS int*)(c.lds + A_TLIST);
    if (c.tid == 0) { mw[0] = 0u; mw[1] = 0u; }
    load_bias_tab(c, p, 8 + g * 4, 4);
    const u32x2 mq = *(const u32x2*)(ws + WS_SELM + ((size_t)bg * SEQ + qpos) * 8);
    const unsigned wlo = wave_or(mq.x), whi = wave_or(mq.y);
    const LAS unsigned char* qf = load_qfrags<8>(c, PROJ + (size_t)(tok0 + qw0) * N1 + C_NQ + hn * 128, N1);
    __syncthreads();
    if (lane == 0) {
        if (wlo) __hip_atomic_fetch_or((LAS unsigned*)(c.lds + A_MISCW), wlo, __ATOMIC_RELAXED, __HIP_MEMORY_SCOPE_WORKGROUP);
        if (whi) __hip_atomic_fetch_or((LAS unsigned*)(c.lds + A_MISCW) + 1, whi, __ATOMIC_RELAXED, __HIP_MEMORY_SCOPE_WORKGROUP);
    }
    __syncthreads();
    if (c.tid == 0) {
        const unsigned blo = mw[0], bhi = mw[1];
        int n = 0;
        for (int m = 0; m <= qb; ++m) { const unsigned bit = m < 32 ? (blo >> m) & 1u : (bhi >> (m - 32)) & 1u; if (bit) tl[n++] = m * 64; }
        mw[2] = (unsigned)n;
    }
    __syncthreads();
    const int ntiles = (int)mw[2];
    TileSrc src;
    src.kbase = (const unsigned char*)(PROJ + (size_t)tok0 * N1 + C_KS + g * 128); src.kpitch = N1 * 2;
    src.vbase = (const unsigned char*)((const bf16_t*)(ws + WS_VT) + (size_t)(R_VS + g * 128) * T_TOK + tok0); src.vpitch = T_TOK * 2;
    f32x16 O[4]; zero_o(O);
    SoftState st; st.m = -1e30f; st.l = 0.f;
    const LAS float* bt = (const LAS float*)(c.lds + A_BIAS) + r4 * 132;
    const float bconst = bt[128];
    ATTN_LOOP_BEGIN(ntiles, src)
        const int m = key0 >> 6;
        const bool need = (m < 32 ? (wlo >> m) & 1u : (whi >> (m - 32)) & 1u) != 0u;
        if (need && key0 <= qw0 + 31) {
            const bool okq = (m < 32 ? (mq.x >> m) & 1u : (mq.y >> (m - 32)) & 1u) != 0u;
            const bool far = (qw0 - (key0 + 63)) >= 128;
            attn_tile<8, true>(c.lds, buf_, 0, qf, O, st, lane, ATT_C128, far, bconst, qpos - key0 - 4 * h, 0x80000000u, okq, bt);
        }
    ATTN_LOOP_END()
    const float lt = st.l + xor32f(st.l);
    const float gate = sigmoidf_(bf_lo((unsigned)PROJ[(size_t)(tok0 + qpos) * N1 + C_GATE + hn * 3 + 1]));
#ifdef ABL_SEL
    const float sc = 0.f;
#else
    const float sc = lt > 0.f ? gate / lt : 0.f;
#endif
    const bf16_t* oc = (const bf16_t*)(ws + WS_OC) + (size_t)(tok0 + qpos) * 1024 + hn * 128;
    const bf16_t* ow = (const bf16_t*)(ws + WS_OW) + (size_t)(tok0 + qpos) * 1024 + hn * 128;
    bf16_t* orow = (bf16_t*)(ws + WS_OMIX) + (size_t)(tok0 + qpos) * DM + 1024 + hn * 128;
#pragma unroll
    for (int db = 0; db < 4; ++db)
#pragma unroll
        for (int gq = 0; gq < 4; ++gq) {
            const int d = db * 32 + gq * 8 + h * 4;
            const u32x2 a = *(const u32x2*)(oc + d), bw = *(const u32x2*)(ow + d);
            u32x2 w;
            w.x = cvt_pk_bf16(O[db][4 * gq] * sc + bf_lo(a.x) + bf_lo(bw.x), O[db][4 * gq + 1] * sc + bf_hi(a.x) + bf_hi(bw.x));
            w.y = cvt_pk_bf16(O[db][4 * gq + 2] * sc + bf_lo(a.y) + bf_lo(bw.y), O[db][4 * gq + 3] * sc + bf_hi(a.y) + bf_hi(bw.y));
            *(u32x2*)(orow + d) = w;
        }
}

__device__ __forceinline__ void top16_of_128(f32x16 (&sc)[4], int h, float (&top)[16]) {
    const float NEG = -__builtin_inff();
#pragma unroll
    for (int kb = 0; kb < 4; ++kb)
#pragma unroll
        for (int i = 0; i < 16; ++i) {
            const int key = kb * 32 + (i & 3) + 8 * (i >> 2) + 4 * h;
            sc[kb][i] = __uint_as_float((__float_as_uint(sc[kb][i]) & ~127u) | (unsigned)(127 - key));
        }
#pragma unroll
    for (int it = 0; it < 16; ++it) {
        float lm = NEG;
#pragma unroll
        for (int kb = 0; kb < 4; ++kb)
#pragma unroll
            for (int i = 0; i < 16; ++i) lm = fmaxf(lm, sc[kb][i]);
        const float pm = fmaxf(lm, xor32f(lm));
        top[it] = pm;
#pragma unroll
        for (int kb = 0; kb < 4; ++kb)
#pragma unroll
            for (int i = 0; i < 16; ++i) sc[kb][i] = (sc[kb][i] == pm) ? NEG : sc[kb][i];
    }
}

__device__ __forceinline__ void phase_peer_topk(const Ctx& c, const Params& p, int l) {
    unsigned char* ws = p.ws;
    const bf16_t* QRY = (const bf16_t*)(ws + WS_PROJ);
    const int gw = c.bid * 8 + c.wave, nw = c.G * 8, lane = c.lane, r = lane & 31, h = lane >> 5;
    const float NEG = -__builtin_inff();
    for (int it = gw; it < 2048; it += nw) {
        const int tt = it >> 2, hp = it & 3;
#pragma unroll 1
        for (int hh = 0; hh < 2; ++hh) {
            const int hd = hp * 2 + hh;
            float s1[16], s2[16];
#pragma unroll
            for (int pp = 0; pp < 2; ++pp) {
                const bf16_t* sk = (const bf16_t*)(ws + WS_SKB) + ((((size_t)l * 8 + hd) * 2 + pp) * 128 + r) * 128 + h * 8;
                const bf16_t* qr = QRY + (size_t)(tt * 32 + r) * DM + hd * 256 + pp * 128 + h * 8;
                f32x16 sc[4];
#pragma unroll
                for (int kb = 0; kb < 4; ++kb)
#pragma unroll
                    for (int i = 0; i < 16; ++i) sc[kb][i] = 0.f;
#pragma unroll
                for (int ks = 0; ks < 8; ++ks) {
                    const bf16x8 qv = *(const bf16x8*)(qr + ks * 16);
#pragma unroll
                    for (int kb = 0; kb < 4; ++kb) sc[kb] = __builtin_amdgcn_mfma_f32_32x32x16_bf16(*(const bf16x8*)(sk + (size_t)kb * 32 * 128 + ks * 16), qv, sc[kb], 0, 0, 0);
                }
                if (pp == 0) top16_of_128(sc, h, s1); else top16_of_128(sc, h, s2);
            }
            float cv[50]; int ce[50];
            {
                int n = 0;
#pragma unroll
                for (int a = 0; a < 16; ++a)
#pragma unroll
                    for (int b = 0; b < 16; ++b)
                        if ((a + 1) * (b + 1) <= 16) {
                            const float v = s1[a] + s2[b];
                            cv[n] = __uint_as_float((__float_as_uint(v) & ~63u) | (unsigned)(63 - n));
                            ce[n] = (int)((127u - (__float_as_uint(s1[a]) & 127u)) * 128u + (127u - (__float_as_uint(s2[b]) & 127u)));
                            ++n;
                        }
            }
            float tv[16]; int te[16];
#pragma unroll
            for (int k = 0; k < 16; ++k) {
                float lm = cv[0];
#pragma unroll
                for (int i = 1; i < 50; ++i) lm = fmaxf(lm, cv[i]);
                int e = 0;
#pragma unroll
                for (int i = 0; i < 50; ++i) { const bool hit = cv[i] == lm; e = hit ? ce[i] : e; cv[i] = hit ? NEG : cv[i]; }
                tv[k] = lm; te[k] = e;
            }
            const float tmx = tv[0];
            float wsum = 0.f;
#pragma unroll
            for (int k = 0; k < 16; ++k) { tv[k] = __expf(tv[k] - tmx); wsum += tv[k]; }
            const float winv = 1.0f / wsum;
#pragma unroll
            for (int k = 0; k < 16; ++k) tv[k] *= winv;
            int* ei = (int*)(ws + WS_EIDX) + (size_t)(tt * 32 + r) * 128 + hd * 16 + h * 8;
            float* eg = (float*)(ws + WS_EGATE) + (size_t)(tt * 32 + r) * 128 + hd * 16 + h * 8;
#pragma unroll
            for (int j = 0; j < 8; ++j) { ei[j] = h ? te[8 + j] : te[j]; eg[j] = h ? tv[8 + j] : tv[j]; }
        }
    }
}

__device__ __forceinline__ bf2_t as_bf2(unsigned u) { return __builtin_bit_cast(bf2_t, u); }
__device__ __forceinline__ float dot8(u32x4 a, u32x4 b, float acc) {
    const unsigned a0 = a.x, a1 = a.y, a2 = a.z, a3 = a.w, b0 = b.x, b1 = b.y, b2 = b.z, b3 = b.w;
    acc = __builtin_amdgcn_fdot2_f32_bf16(as_bf2(a0), as_bf2(b0), acc, false);
    acc = __builtin_amdgcn_fdot2_f32_bf16(as_bf2(a1), as_bf2(b1), acc, false);
    acc = __builtin_amdgcn_fdot2_f32_bf16(as_bf2(a2), as_bf2(b2), acc, false);
    acc = __builtin_amdgcn_fdot2_f32_bf16(as_bf2(a3), as_bf2(b3), acc, false);
    return acc;
}
__device__ __forceinline__ void axpy8(float (&acc)[8], float a, u32x4 v) {
    acc[0] = fmaf(a, bf_lo(v.x), acc[0]); acc[1] = fmaf(a, bf_hi(v.x), acc[1]); acc[2] = fmaf(a, bf_lo(v.y), acc[2]); acc[3] = fmaf(a, bf_hi(v.y), acc[3]);
    acc[4] = fmaf(a, bf_lo(v.z), acc[4]); acc[5] = fmaf(a, bf_hi(v.z), acc[5]); acc[6] = fmaf(a, bf_lo(v.w), acc[6]); acc[7] = fmaf(a, bf_hi(v.w), acc[7]);
}
__device__ __forceinline__ void phase_peer_gather(const Ctx& c, const Params& p, int l) {
    unsigned char* ws = p.ws;
    const int gw = c.bid * 8 + c.wave, nw = c.G * 8, lane = c.lane;
    bf16_t* HN = (bf16_t*)(ws + WS_HN);
    float* XW = (float*)(ws + WS_XW);
    const bf16_t* UB = (const bf16_t*)(ws + WS_UB) + (size_t)l * 16384 * DM;
    const bf16_t* VB = (const bf16_t*)(ws + WS_VB) + (size_t)l * 16384 * DM;
    const bool b5 = (lane & 32) != 0, b4 = (lane & 16) != 0, b3 = (lane & 8) != 0;
    for (int t = gw; t < T_TOK; t += nw) {
        u32x4 xh[4];
#pragma unroll
        for (int cc = 0; cc < 4; ++cc) xh[cc] = *(const u32x4*)(HN + (size_t)t * DM + cc * 512 + lane * 8);
        const int e_lo = ((const int*)(ws + WS_EIDX))[(size_t)t * 128 + lane], e_hi = ((const int*)(ws + WS_EIDX))[(size_t)t * 128 + 64 + lane];
        const float g_lo = ((const float*)(ws + WS_EGATE))[(size_t)t * 128 + lane], g_hi = ((const float*)(ws + WS_EGATE))[(size_t)t * 128 + 64 + lane];
        float h_lo = 0.f, h_hi = 0.f;
#pragma unroll 1
        for (int bt = 0; bt < 16; ++bt) {
            const int ev = bt < 8 ? e_lo : e_hi;
            const int b8 = bt & 7;
            u32x4 rw[8][4];
#pragma unroll
            for (int j = 0; j < 8; ++j) {
                const int ek = __builtin_amdgcn_readlane(ev, b8 * 8 + j);
                const bf16_t* row = UB + (size_t)ek * DM + lane * 8;
#pragma unroll
                for (int cc = 0; cc < 4; ++cc) rw[j][cc] = *(const u32x4*)(row + cc * 512);
            }
            float ps[8];
#pragma unroll
            for (int j = 0; j < 8; ++j) { float a = 0.f;
#pragma unroll
                for (int cc = 0; cc < 4; ++cc) a = dot8(xh[cc], rw[j][cc], a);
                ps[j] = a; }
            float q4[4];
#pragma unroll
            for (int i = 0; i < 4; ++i) { const float keep = b5 ? ps[i + 4] : ps[i], give = b5 ? ps[i] : ps[i + 4]; q4[i] = keep + __shfl_xor(give, 32); }
            float q2[2];
#pragma unroll
            for (int i = 0; i < 2; ++i) { const float keep = b4 ? q4[i + 2] : q4[i], give = b4 ? q4[i] : q4[i + 2]; q2[i] = keep + __shfl_xor(give, 16); }
            float q1;
            { const float keep = b3 ? q2[1] : q2[0], give = b3 ? q2[0] : q2[1]; q1 = keep + __shfl_xor(give, 8); }
            q1 += __shfl_xor(q1, 4); q1 += __shfl_xor(q1, 2); q1 += __shfl_xor(q1, 1);
            const float mine = __shfl(q1, 8 * (lane & 7));
            if ((lane >> 3) == b8) { if (bt < 8) h_lo = mine; else h_hi = mine; }
        }
#ifdef ABL_PEER
        const float a_lo = 0.f, a_hi = 0.f;
#else
        const float a_lo = 0.5f * h_lo * (1.0f + erff(h_lo * 0.70710678118f)) * g_lo;
        const float a_hi = 0.5f * h_hi * (1.0f + erff(h_hi * 0.70710678118f)) * g_hi;
#endif
        float acc[4][8];
#pragma unroll
        for (int cc = 0; cc < 4; ++cc)
#pragma unroll
            for (int i = 0; i < 8; ++i) acc[cc][i] = 0.f;
#pragma unroll 1
        for (int bt = 0; bt < 32; ++bt) {
            const int ev = bt < 16 ? e_lo : e_hi;
            const float avv = bt < 16 ? a_lo : a_hi;
            const int b4 = (bt & 15) * 4;
            u32x4 rw[4][4];
#pragma unroll
            for (int j = 0; j < 4; ++j) {
                const int ek = __builtin_amdgcn_readlane(ev, b4 + j);
                const bf16_t* row = VB + (size_t)ek * DM + lane * 8;
#pragma unroll
                for (int cc = 0; cc < 4; ++cc) rw[j][cc] = *(const u32x4*)(row + cc * 512);
            }
#pragma unroll
            for (int j = 0; j < 4; ++j) {
                const float a = __uint_as_float((unsigned)__builtin_amdgcn_readlane((int)__float_as_uint(avv), b4 + j));
#pragma unroll
                for (int cc = 0; cc < 4; ++cc) axpy8(acc[cc], a, rw[j][cc]);
            }
        }
        float* xw = XW + (size_t)t * DM;
        float ss = 0.f;
#pragma unroll
        for (int cc = 0; cc < 4; ++cc) {
            const f32x4 a = *(const f32x4*)(xw + cc * 512 + lane * 8), b = *(const f32x4*)(xw + cc * 512 + lane * 8 + 4);
#pragma unroll
            for (int i = 0; i < 4; ++i) { acc[cc][i] += a[i]; acc[cc][4 + i] += b[i]; }
#pragma unroll
            for (int i = 0; i < 8; ++i) ss += acc[cc][i] * acc[cc][i];
        }
        ss = wave_sum(ss);
        const float rstd = rsqrtf(ss * (1.0f / DM) + 1e-6f);
        if (l + 1 < DEPTH) {
            const float* gn = p.attn_norm + (size_t)(l + 1) * DM;
#pragma unroll
            for (int cc = 0; cc < 4; ++cc) {
                *(f32x4*)(xw + cc * 512 + lane * 8) = (f32x4){acc[cc][0], acc[cc][1], acc[cc][2], acc[cc][3]};
                *(f32x4*)(xw + cc * 512 + lane * 8 + 4) = (f32x4){acc[cc][4], acc[cc][5], acc[cc][6], acc[cc][7]};
                const f32x4 g0 = *(const f32x4*)(gn + cc * 512 + lane * 8), g1 = *(const f32x4*)(gn + cc * 512 + lane * 8 + 4);
                u32x4 w;
                w.x = cvt_pk_bf16(acc[cc][0] * rstd * g0[0], acc[cc][1] * rstd * g0[1]); w.y = cvt_pk_bf16(acc[cc][2] * rstd * g0[2], acc[cc][3] * rstd * g0[3]);
                w.z = cvt_pk_bf16(acc[cc][4] * rstd * g1[0], acc[cc][5] * rstd * g1[1]); w.w = cvt_pk_bf16(acc[cc][6] * rstd * g1[2], acc[cc][7] * rstd * g1[3]);
                *(u32x4*)(HN + (size_t)t * DM + cc * 512 + lane * 8) = w;
            }
        } else {
            const float* gn = p.final_norm;
            float* orow = p.out + (size_t)t * DM;
#pragma unroll
            for (int cc = 0; cc < 4; ++cc) {
                const f32x4 g0 = *(const f32x4*)(gn + cc * 512 + lane * 8), g1 = *(const f32x4*)(gn + cc * 512 + lane * 8 + 4);
                *(f32x4*)(orow + cc * 512 + lane * 8) = (f32x4){acc[cc][0] * rstd * g0[0], acc[cc][1] * rstd * g0[1], acc[cc][2] * rstd * g0[2], acc[cc][3] * rstd * g0[3]};
                *(f32x4*)(orow + cc * 512 + lane * 8 + 4) = (f32x4){acc[cc][4] * rstd * g1[0], acc[cc][5] * rstd * g1[1], acc[cc][6] * rstd * g1[2], acc[cc][7] * rstd * g1[3]};
            }
        }
    }
}
constexpr int LDS_PARAMS = LDS_MISC + 128;
__device__ __forceinline__ Ctx make_ctx(Params& p, int wv) {
    extern __shared__ __attribute__((aligned(16))) unsigned char lds_raw[];
    Ctx c;
    asm volatile("" ::: "memory");
    c.lds = (LAS unsigned char*)lds_raw;
    int ln; asm volatile("v_mbcnt_lo_u32_b32 %0, -1, 0\n\tv_mbcnt_hi_u32_b32 %0, -1, %0" : "=v"(ln));
    int wz = wv; asm volatile("" : "+s"(wz));
    int gz = gridDim.x; asm volatile("" : "+s"(gz));
    int bz = blockIdx.x; asm volatile("" : "+s"(bz));
    c.lane = ln; c.wave = wz; c.tid = (wz << 6) | ln;
    c.G = gz; c.bid = bz;
    {
        const LAS unsigned long long* q = (const LAS unsigned long long*)(c.lds + LDS_PARAMS);
        p.x = (const float*)q[0]; p.rel_bias = (const float*)q[1]; p.attn_norm = (const float*)q[2]; p.w_in = (const float*)q[3]; p.diff_lambda = (const float*)q[4]; p.diff_subln = (const float*)q[5];
        p.cmp_pos = (const float*)q[6]; p.cmp_w = (const float*)q[7]; p.w_out = (const float*)q[8]; p.ffn_norm = (const float*)q[9]; p.peer_wq = (const float*)q[10]; p.peer_subkeys = (const float*)q[11];
        p.peer_u = (const float*)q[12]; p.peer_v = (const float*)q[13]; p.final_norm = (const float*)q[14]; p.out = (float*)q[15]; p.ws = (unsigned char*)q[16];
    }
    c.ctl = (unsigned*)(p.ws + WS_CTL);
    return c;
}
__device__ __forceinline__ void ph_barrier(int wv) {
    Params p; Ctx c = make_ctx(p, wv);
    XcdBarrier bar; bar.bar = c.ctl + CW_BAR; bar.x = xb_xcc_id(); bar.st = (volatile LAS unsigned*)(c.lds + LDS_MISC);
    xcd_barrier(bar, c.tid);
}
__device__ __forceinline__ void ph_prologue(int wv) {
    Params p; Ctx c = make_ctx(p, wv);
    phase_prologue(c, p);
    phase_rmsnorm_bf16(c, p.x, p.attn_norm, (bf16_t*)(p.ws + WS_HN));
}
__device__ __forceinline__ void ph_gemm_in(int wv, int l) {
    Params p; Ctx c = make_ctx(p, wv);
    unsigned char* ws = p.ws;
    {
        pg8::Gemm g{(const bf16_t*)(ws + WS_HN), (const bf16_t*)(ws + WS_WT1) + (size_t)l * N1 * DM, T_TOK, N1, DM};
        pg8::StaticOrder S; S.init(T_TOK, N1, c.G, c.bid);
        pg8::EpiBf16<0> E{(bf16_t*)(ws + WS_PROJ), N1, nullptr, 0, 0};
        pg8::gemm_phase<pg8::EpiBf16<0>, pg8::StaticOrder, false>(c.lds, g, S, E, nullptr, c.tid);
    }
}
__device__ __forceinline__ void ph_gemm_vt(int wv, int l) {
    Params p; Ctx c = make_ctx(p, wv);
    unsigned char* ws = p.ws;
    {
        pg8::Gemm g{(const bf16_t*)(ws + WS_WTV) + (size_t)l * NV * DM, (const bf16_t*)(ws + WS_HN), NV, T_TOK, DM};
        pg8::StaticOrder S; S.init(NV, T_TOK, c.G, c.G - 1 - c.bid);
        pg8::EpiBf16<0> E{(bf16_t*)(ws + WS_VT), T_TOK, nullptr, 0, 0};
        pg8::gemm_phase<pg8::EpiBf16<0>, pg8::StaticOrder, false>(c.lds, g, S, E, nullptr, c.tid);
    }
}
__device__ __forceinline__ void ph_gemm_out(int wv, int l) {
    Params p; Ctx c = make_ctx(p, wv);
    unsigned char* ws = p.ws;
    float* XW = (float*)(ws + WS_XW);
    pg8::Gemm g{(const bf16_t*)(ws + WS_OMIX), (const bf16_t*)(ws + WS_WTO) + (size_t)l * DM * DM, T_TOK, DM, DM};
    pg8::StaticOrder S; S.init(T_TOK, DM, c.G, c.bid);
    pg8::EpiResF32 E{XW, l == 0 ? p.x : (const float*)XW, DM};
    pg8::gemm_phase<pg8::EpiResF32, pg8::StaticOrder, false>(c.lds, g, S, E, nullptr, c.tid);
}
__device__ __forceinline__ void ph_gemm_q(int wv, int l) {
    Params p; Ctx c = make_ctx(p, wv);
    unsigned char* ws = p.ws;
    pg8::Gemm g{(const bf16_t*)(ws + WS_HN), (const bf16_t*)(ws + WS_WTQ) + (size_t)l * DM * DM, T_TOK, DM, DM};
    pg8::StaticOrder S; S.init(T_TOK, DM, c.G, c.bid);
    pg8::EpiBf16<0> E{(bf16_t*)(ws + WS_PROJ), DM, nullptr, 0, 0};
    pg8::gemm_phase<pg8::EpiBf16<0>, pg8::StaticOrder, false>(c.lds, g, S, E, nullptr, c.tid);
}
__device__ __forceinline__ void ph_prep(int wv, int l) { Params p; Ctx c = make_ctx(p, wv); phase_prep(c, p, l); }
__device__ __forceinline__ void ph_diff(int wv, int l) {
    Params p; Ctx c = make_ctx(p, wv);
    for (;;) { const int idx = next_item(c, l * 8 + 0); if (idx >= 512) break; item_diff(c, p, l, (idx & 15) >> 2, idx & 3, 31 - (idx >> 4)); }
}
__device__ __forceinline__ void ph_moba(int wv, int l) {
    Params p; Ctx c = make_ctx(p, wv);
    for (;;) { const int idx = next_item(c, l * 8 + 1); if (idx >= 256) break; item_moba(c, p, (idx & 15) >> 2, idx & 3, 15 - (idx >> 4)); }
}
__device__ __forceinline__ void ph_cmp(int wv, int l) {
    Params p; Ctx c = make_ctx(p, wv);
    for (;;) { const int idx = next_item(c, l * 8 + 2); if (idx >= 512) break; item_nsa_cmp(c, p, (idx & 7) >> 1, idx & 1, 63 - (idx >> 3)); }
}
__device__ __forceinline__ void ph_win(int wv, int l) {
    Params p; Ctx c = make_ctx(p, wv);
    for (;;) { const int idx = next_item(c, l * 8 + 3); if (idx >= 512) break; item_nsa_win(c, p, (idx & 7) >> 1, idx & 1, 63 - (idx >> 3)); }
}
__device__ __forceinline__ void ph_sel(int wv, int l) {
    Params p; Ctx c = make_ctx(p, wv);
    for (;;) { const int idx = next_item(c, l * 8 + 4); if (idx >= 512) break; item_nsa_sel(c, p, (idx & 7) >> 1, idx & 1, 63 - (idx >> 3)); }
}
__device__ __forceinline__ void ph_norm2(int wv, int l) {
    Params p; Ctx c = make_ctx(p, wv);
    phase_rmsnorm_bf16(c, (const float*)(p.ws + WS_XW), p.ffn_norm + (size_t)l * DM, (bf16_t*)(p.ws + WS_HN));
}
__device__ __forceinline__ void ph_topk(int wv, int l) { Params p; Ctx c = make_ctx(p, wv); phase_peer_topk(c, p, l); }
__device__ __forceinline__ void ph_gather(int wv, int l) { Params p; Ctx c = make_ctx(p, wv); phase_peer_gather(c, p, l); }

template <int L>
__device__ __forceinline__ void layer_body(int wv) {
    constexpr int l = L;
    ph_gemm_in(wv, l); ph_gemm_vt(wv, l);
    ph_barrier(wv);
    ph_prep(wv, l);
    ph_barrier(wv);
    ph_diff(wv, l); ph_moba(wv, l); ph_cmp(wv, l); ph_win(wv, l);
    ph_barrier(wv);
    ph_sel(wv, l);
    ph_barrier(wv);
    ph_gemm_out(wv, l);
    ph_barrier(wv);
    ph_norm2(wv, l);
    ph_barrier(wv);
    ph_gemm_q(wv, l);
    ph_barrier(wv);
    ph_topk(wv, l);
    ph_barrier(wv);
    ph_gather(wv, l);
    ph_barrier(wv);
}

__global__ void __launch_bounds__(512, 2) hybrid_fwd(Params pk) {
    extern __shared__ __attribute__((aligned(16))) unsigned char lds_raw[];
    const int wv = __builtin_amdgcn_readfirstlane((int)threadIdx.x >> 6);
    {
        LAS unsigned char* lds = (LAS unsigned char*)lds_raw;
        volatile LAS unsigned* misc = (volatile LAS unsigned*)(lds + LDS_MISC);
        for (int u = threadIdx.x; u < 32; u += 512) misc[u] = 0u;
        if (threadIdx.x == 0) {
            LAS unsigned long long* q = (LAS unsigned long long*)(lds + LDS_PARAMS);
            q[0] = (unsigned long long)pk.x; q[1] = (unsigned long long)pk.rel_bias; q[2] = (unsigned long long)pk.attn_norm; q[3] = (unsigned long long)pk.w_in; q[4] = (unsigned long long)pk.diff_lambda;
            q[5] = (unsigned long long)pk.diff_subln; q[6] = (unsigned long long)pk.cmp_pos; q[7] = (unsigned long long)pk.cmp_w; q[8] = (unsigned long long)pk.w_out; q[9] = (unsigned long long)pk.ffn_norm;
            q[10] = (unsigned long long)pk.peer_wq; q[11] = (unsigned long long)pk.peer_subkeys; q[12] = (unsigned long long)pk.peer_u; q[13] = (unsigned long long)pk.peer_v; q[14] = (unsigned long long)pk.final_norm;
            q[15] = (unsigned long long)pk.out; q[16] = (unsigned long long)pk.ws;
        }
        __syncthreads();
        (void)xcd_barrier_post((unsigned*)(pk.ws + WS_CTL) + CW_BAR, misc);
    }
    ph_prologue(wv);
    ph_barrier(wv);
    layer_body<0>(wv);
    layer_body<1>(wv);
}

extern "C" void kernel_launch(void* const* d_in, const int* in_sizes, int n_in, void* d_out, int out_size, void* d_ws, size_t ws_size, hipStream_t stream) {
    static int grid = 0;
    if (!grid) {
        int dev = 0, cus = 0;
        if (n_in != 15 || out_size != T_TOK * DM || ws_size < WS_END) { fprintf(stderr, "kernel_launch: unexpected shapes (n_in %d, out %d, ws %zu < %zu)\n", n_in, out_size, ws_size, (size_t)WS_END); grid = -1; return; }
        if (hipGetDevice(&dev) != hipSuccess || hipDeviceGetAttribute(&cus, hipDeviceAttributeMultiprocessorCount, dev) != hipSuccess || cus < 8) { grid = -1; return; }
        if (hipFuncSetAttribute((const void*)hybrid_fwd, hipFuncAttributeMaxDynamicSharedMemorySize, LDS_BYTES) != hipSuccess) { fprintf(stderr, "kernel_launch: hipFuncSetAttribute failed\n"); grid = -1; return; }
        grid = cus;
    }
    if (grid < 0) return;
    (void)hipMemsetAsync((char*)d_ws + WS_CTL, 0, CTL_BYTES, stream);
    Params p;
    memset(&p, 0, sizeof(p));
    p.x = (const float*)d_in[0]; p.rel_bias = (const float*)d_in[1]; p.attn_norm = (const float*)d_in[2]; p.w_in = (const float*)d_in[3];
    p.diff_lambda = (const float*)d_in[4]; p.diff_subln = (const float*)d_in[5]; p.cmp_pos = (const float*)d_in[6]; p.cmp_w = (const float*)d_in[7];
    p.w_out = (const float*)d_in[8]; p.ffn_norm = (const float*)d_in[9]; p.peer_wq = (const float*)d_in[10]; p.peer_subkeys = (const float*)d_in[11];
    p.peer_u = (const float*)d_in[12]; p.peer_v = (const float*)d_in[13]; p.final_norm = (const float*)d_in[14];
    p.out = (float*)d_out; p.ws = (unsigned char*)d_ws;
    hipLaunchKernelGGL(hybrid_fwd, dim3(grid), dim3(512), LDS_BYTES, stream, p);
}
```

```cpp
#include <hip/hip_runtime.h>
#include <cstdint>
#include <cstdio>
#include <cstring>

#define LAS __attribute__((address_space(3)))
typedef unsigned short bf16_t;
typedef short bf16x8 __attribute__((ext_vector_type(8)));
typedef short bf16x4 __attribute__((ext_vector_type(4)));
typedef float f32x4 __attribute__((ext_vector_type(4)));
typedef float f32x2 __attribute__((ext_vector_type(2)));
typedef float f32x16 __attribute__((ext_vector_type(16)));
typedef unsigned u32x4 __attribute__((ext_vector_type(4)));
typedef unsigned u32x2 __attribute__((ext_vector_type(2)));
typedef __bf16 bf2_t __attribute__((ext_vector_type(2)));

#define XB_TMO      128
#define XB_XCNT(j)  (256  + 64 * (j))
#define XB_XSUB(j)  (1280 + 64 * (j))
#define XB_XGEN(j)  (2304 + 64 * (j))
#define XB_TOP      3328
#define XB_TOPGEN   3392
#define XCD_BAR_WORDS 3456
#define XB_SPIN_CAP (1u << 18)
#define LAS __attribute__((address_space(3)))

__device__ __forceinline__ unsigned xb_ld(unsigned* p)              { return __hip_atomic_load(p, __ATOMIC_RELAXED, __HIP_MEMORY_SCOPE_AGENT); }
__device__ __forceinline__ unsigned xb_add(unsigned* p, unsigned v) { return __hip_atomic_fetch_add(p, v, __ATOMIC_RELAXED, __HIP_MEMORY_SCOPE_AGENT); }
__device__ __forceinline__ unsigned xb_xcc_id() { return (unsigned)__builtin_amdgcn_s_getreg((3 << 11) | 20) & 0xFu; }
#define XB_SPIN(cond, bar) do { unsigned _sp = 0; while (cond) { __builtin_amdgcn_s_sleep(1); \
    if ((++_sp & 255u) == 0u) { if (xb_ld(&(bar)[XB_TMO])) break; if (_sp > XB_SPIN_CAP) { atomicAdd(&(bar)[XB_TMO], 1u); break; } } } } while (0)

struct XcdBarrier {
    unsigned* bar; unsigned x;
    volatile LAS unsigned* st;
};

__device__ __forceinline__ XcdBarrier xcd_barrier_post(unsigned* bar, volatile LAS unsigned* st) {
    XcdBarrier b; b.bar = bar; b.x = xb_xcc_id(); b.st = st;
    if (threadIdx.x == 0) (void)xb_add(&bar[XB_XCNT(b.x)], 1u);
    return b;
}
__device__ __forceinline__ void xcd_barrier_complete(unsigned* bar, unsigned x, unsigned& nloc, unsigned& nx) {
    const unsigned G = gridDim.x * gridDim.y * gridDim.z;
    unsigned sum, cnt, mine, sp = 0u;
    for (;;) {
        sum = 0u; cnt = 0u; mine = 0u;
#pragma unroll
        for (unsigned j = 0; j < 16; ++j) { const unsigned c = xb_ld(&bar[XB_XCNT(j)]); sum += c; cnt += (c > 0u) ? 1u : 0u; mine = (j == x) ? c : mine; }
        if (sum == G) break;
        __builtin_amdgcn_s_sleep(1);
        if ((++sp & 255u) == 0u) { if (xb_ld(&bar[XB_TMO])) break; if (sp > XB_SPIN_CAP) { atomicAdd(&bar[XB_TMO], 1u); break; } }
    }
    nloc = mine > 0u ? mine : 1u; nx = cnt > 0u ? cnt : 1u;
}

__device__ __forceinline__ void xcd_barrier(const XcdBarrier& b, int tid_in) {
    asm volatile("s_waitcnt vmcnt(0)" ::: "memory");
    __syncthreads();
    if (tid_in == 0) {
        unsigned* bar = b.bar;
        __builtin_amdgcn_s_waitcnt(0);
        unsigned nloc = b.st[0], nx = b.st[1];
        if (nloc == 0u) { xcd_barrier_complete(bar, b.x, nloc, nx); b.st[0] = nloc; b.st[1] = nx; }
        const unsigned old = xb_add(&bar[XB_XSUB(b.x)], 1u);
        const unsigned gen = old / nloc;
        if (old + 1u == (gen + 1u) * nloc) {
            __builtin_amdgcn_fence(__ATOMIC_RELEASE, "agent");
            asm volatile("s_waitcnt vmcnt(0)" ::: "memory");
            const unsigned og = xb_add(&bar[XB_TOP], 1u);
            const unsigned tg = og / nx;
            if (og + 1u == (tg + 1u) * nx) xb_add(&bar[XB_TOPGEN], 1u);
            else XB_SPIN(xb_ld(&bar[XB_TOPGEN]) == tg, bar);
            __builtin_amdgcn_fence(__ATOMIC_ACQUIRE, "agent");
            xb_add(&bar[XB_XGEN(b.x)], 1u);
            asm volatile("s_waitcnt vmcnt(0)" ::: "memory");
        } else {
            XB_SPIN(xb_ld(&bar[XB_XGEN(b.x)]) == gen, bar);
            __builtin_amdgcn_fence(__ATOMIC_ACQUIRE, "agent");
            asm volatile("s_waitcnt vmcnt(0)" ::: "memory");
        }
    }
    __syncthreads();
}
namespace pg8 {
#define PG8_LAS __attribute__((address_space(3)))
typedef unsigned short bf16_t;
typedef short bf16x8 __attribute__((ext_vector_type(8)));
typedef float f32x4 __attribute__((ext_vector_type(4)));
typedef unsigned u32x4 __attribute__((ext_vector_type(4)));
constexpr int BM = 256, BK = 64, HALF = 128, HTB = HALF * BK * 2  , STAGE_BYTES = 8 * HTB, NXCD = 8, WGM = 8;

__host__ __device__ __forceinline__ int lds_byte(int r, int c) { const int st = (r >> 4) * 2 + (c >> 5), rr = r & 15, cc = c & 31, ob = rr * 64 + cc * 2; return st * 1024 + (ob ^ (((ob >> 9) & 1) << 5)); }
__host__ __device__ __forceinline__ void stage_rc(int b, int& R, int& C) { const int st = b / 1024, sb = b % 1024, swz = sb ^ (((sb >> 9) & 1) << 5); R = (st >> 1) * 16 + swz / 64; C = (st & 1) * 32 + (swz % 64) / 2; }
__host__ __device__ __forceinline__ int perm32(int rho) { const int n = rho >> 4, i = rho & 15; return 8 * (i >> 2) + 4 * n + (i & 3); }

struct Unit { int pm, pn; };
struct Gemm { const bf16_t* A; const bf16_t* Bt; int M, N, K; };

struct StaticOrder {
    int nM, nN, nwg, G, c;
    __host__ __device__ void init(int M, int N, int G_, int c_) { nM = M / BM; nN = N / BM; nwg = nM * nN; G = G_; c = c_; }
    __host__ __device__ bool next(int i, Unit& u) const {
        const long L = (long)i * G + c; if (L >= nwg) return false;
        int wgid = (int)L; { const int q = nwg / NXCD, r = nwg % NXCD, xcd = wgid % NXCD, off = wgid / NXCD; wgid = (xcd < r ? xcd * (q + 1) : r * (q + 1) + (xcd - r) * q) + off; }
        const int nig = WGM * nN, gid = wgid / nig, fm = gid * WGM, gsz = (nM - fm) < WGM ? (nM - fm) : WGM;
        u.pm = fm + ((wgid % nig) % gsz); u.pn = (wgid % nig) / gsz; return true;
    }
    __device__ __forceinline__ void a_ready(const Unit&) const {}
    __device__ __forceinline__ void done(const Unit&) const {}
};
struct CountedOrder : StaticOrder {
    const unsigned* ready; unsigned need; unsigned* tmo;
    __device__ __forceinline__ void a_ready(const Unit& u) const {
        if (threadIdx.x < 64) {
            const unsigned long long t0 = __builtin_amdgcn_s_memrealtime(); unsigned polls = 0;
            while ((unsigned)__builtin_amdgcn_readfirstlane(__hip_atomic_load(ready + 64 * u.pm, __ATOMIC_RELAXED, __HIP_MEMORY_SCOPE_AGENT)) < need) {
                if ((++polls & 255u) == 0u && __builtin_amdgcn_readfirstlane(__hip_atomic_load(tmo, __ATOMIC_RELAXED, __HIP_MEMORY_SCOPE_AGENT)) != 0u) break;
                if (__builtin_amdgcn_s_memrealtime() - t0 > 2000000ull) {
                    if (threadIdx.x == 0) { unsigned expect = 0u; __hip_atomic_compare_exchange_strong(tmo + 1, &expect, 0x600u | (unsigned)(u.pm & 0xff), __ATOMIC_RELAXED, __ATOMIC_RELAXED, __HIP_MEMORY_SCOPE_AGENT); __hip_atomic_store(tmo, 1u, __ATOMIC_RELAXED, __HIP_MEMORY_SCOPE_AGENT); }
                    break; }
                __builtin_amdgcn_s_sleep(2); }
            __builtin_amdgcn_fence(__ATOMIC_ACQUIRE, "agent");
            asm volatile("s_waitcnt vmcnt(0)" ::: "memory");
        }
#if !defined(BROKEN_HOOK_NO_BARRIER)
        asm volatile("" ::: "memory"); __builtin_amdgcn_s_barrier(); asm volatile("" ::: "memory");
#endif
    }
};

__device__ __forceinline__ unsigned cvt_pk_bf16(float lo, float hi) { unsigned r; asm volatile("v_cvt_pk_bf16_f32 %0, %1, %2" : "=v"(r) : "v"(lo), "v"(hi)); return r; }
typedef float f32x2 __attribute__((ext_vector_type(2)));
__device__ __forceinline__ f32x2 gelu_pk(f32x2 v) {
    const f32x2 av = __builtin_elementwise_abs(v), d = av * 0.2316418882f + 1.0f;
    f32x2 t; t.x = __builtin_amdgcn_rcpf(d.x); t.y = __builtin_amdgcn_rcpf(d.y);
    f32x2 q = t * 0.5307027145f + (-0.7265760135f); q = q * t + 0.7107068705f; q = q * t + (-0.142248368f); q = q * t + 0.127414796f; q = q * t;
    const f32x2 s = (v * v) * (-0.72134752044f);
    f32x2 e; e.x = __builtin_amdgcn_exp2f(s.x); e.y = __builtin_amdgcn_exp2f(s.y);
    const f32x2 m = v * (q * e), r = v - m;
    f32x2 o; o.x = v.x < 0.f ? m.x : r.x; o.y = v.y < 0.f ? m.y : r.y; return o;
}

struct EpiF32 {
    static constexpr bool PERM = false, AFTER_DRAIN = false;
    float* C; int ldc; const float* bias;
    __device__ __forceinline__ void operator()(const f32x4 (&acc)[2][2][4][2], const Unit& u, int wr, int wc, int fr, int fq) const {
        const int row0 = u.pm * BM + wr * 64 + fr, col0 = u.pn * BM + wc * 32 + 4 * fq;
        f32x4 bv[2][2];
#pragma unroll
        for (int bj = 0; bj < 2; ++bj)
#pragma unroll
            for (int n = 0; n < 2; ++n) bv[bj][n] = bias ? *(const f32x4*)(bias + col0 + bj * HALF + n * 16) : (f32x4){0.f, 0.f, 0.f, 0.f};
#pragma unroll
        for (int ai = 0; ai < 2; ++ai)
#pragma unroll
            for (int m = 0; m < 4; ++m) { float* rowp = C + (size_t)(row0 + ai * HALF + m * 16) * ldc + col0;
#pragma unroll
                for (int bj = 0; bj < 2; ++bj)
#pragma unroll
                    for (int n = 0; n < 2; ++n) *(f32x4*)(rowp + bj * HALF + n * 16) = acc[ai][bj][m][n] + bv[bj][n]; }
    }
};
template <int ACT  > struct EpiBf16 {
    static constexpr bool PERM = true, AFTER_DRAIN = false;
    bf16_t* O; int ldc; const float* bias; int split_cols; size_t split_stride;
    __device__ __forceinline__ void operator()(const f32x4 (&acc)[2][2][4][2], const Unit& u, int wr, int wc, int fr, int fq) const {
        const int row0 = u.pm * BM + wr * 64 + fr; int colt = u.pn * BM; bf16_t* base = O;
        if (split_cols) { const int t = colt / split_cols; base += (size_t)t * split_stride; colt -= t * split_cols; }
        const int col0 = colt + wc * 32 + 8 * fq, bcol0 = u.pn * BM + wc * 32 + 8 * fq;
        f32x4 bv[2][2];
#pragma unroll
        for (int bj = 0; bj < 2; ++bj)
#pragma unroll
            for (int n = 0; n < 2; ++n) bv[bj][n] = bias ? *(const f32x4*)(bias + bcol0 + bj * HALF + 4 * n) : (f32x4){0.f, 0.f, 0.f, 0.f};
#pragma unroll
        for (int ai = 0; ai < 2; ++ai)
#pragma unroll
            for (int m = 0; m < 4; ++m) { bf16_t* rowp = base + (size_t)(row0 + ai * HALF + m * 16) * ldc + col0;
#pragma unroll
                for (int bj = 0; bj < 2; ++bj) { f32x4 v0 = acc[ai][bj][m][0] + bv[bj][0], v1 = acc[ai][bj][m][1] + bv[bj][1];
                    if (ACT == 1) { f32x2 a = gelu_pk((f32x2){v0[0], v0[1]}), b = gelu_pk((f32x2){v0[2], v0[3]}), c = gelu_pk((f32x2){v1[0], v1[1]}), d = gelu_pk((f32x2){v1[2], v1[3]});
                        v0 = (f32x4){a.x, a.y, b.x, b.y}; v1 = (f32x4){c.x, c.y, d.x, d.y}; }
                    if (ACT == 2) {
#pragma unroll
                        for (int j = 0; j < 4; ++j) { v0[j] = 0.5f * v0[j] * (1.0f + erff(v0[j] * 0.70710678f)); v1[j] = 0.5f * v1[j] * (1.0f + erff(v1[j] * 0.70710678f)); } }
                    u32x4 w; w.x = cvt_pk_bf16(v0[0], v0[1]); w.y = cvt_pk_bf16(v0[2], v0[3]); w.z = cvt_pk_bf16(v1[0], v1[1]); w.w = cvt_pk_bf16(v1[2], v1[3]);
                    *(u32x4*)(rowp + bj * HALF) = w; } }
    }
};
struct EpiResF32 {
    static constexpr bool PERM = false, AFTER_DRAIN = false;
    float* C; const float* R; int ldc;
    __device__ __forceinline__ void operator()(const f32x4 (&acc)[2][2][4][2], const Unit& u, int wr, int wc, int fr, int fq) const {
        const int row0 = u.pm * BM + wr * 64 + fr, col0 = u.pn * BM + wc * 32 + 4 * fq;
#pragma unroll
        for (int ai = 0; ai < 2; ++ai)
#pragma unroll
            for (int m = 0; m < 4; ++m) { const size_t off = (size_t)(row0 + ai * HALF + m * 16) * ldc + col0;
#pragma unroll
                for (int bj = 0; bj < 2; ++bj)
#pragma unroll
                    for (int n = 0; n < 2; ++n) { const f32x4 r = *(const f32x4*)(R + off + bj * HALF + n * 16); *(f32x4*)(C + off + bj * HALF + n * 16) = acc[ai][bj][m][n] + r; } }
    }
};
template <class Epi, class Sched, bool STAMP = false>
__device__ __forceinline__ void gemm_phase(PG8_LAS unsigned char* lds, const Gemm g, const Sched& S, const Epi& E, unsigned long long* stamps, int tid_in) {
    const int tid = tid_in, wid = __builtin_amdgcn_readfirstlane(tid >> 6), lane = tid & 63, wr = wid >> 2, wc = wid & 3, fr = lane & 15, fq = lane >> 4;
    const int K = g.K, nt = K / BK;
    int ts_lo = 0, ts_hi = 0, nts = 0; const unsigned long long rt_entry = STAMP ? (unsigned long long)wall_clock64() : 0ull;
#define PG8_STAMP() do { if (STAMP && wid == 0 && nts < 64) { const unsigned long long _c = (unsigned long long)clock64(); \
        ts_lo = (lane == nts) ? (int)(unsigned)_c : ts_lo; ts_hi = (lane == nts) ? (int)(unsigned)(_c >> 32) : ts_hi; ++nts; } } while (0)
    PG8_STAMP();
    unsigned voffA[2], voffB[2];
#pragma unroll
    for (int i = 0; i < 2; ++i) { int R, C; stage_rc(tid * 16 + i * 8192, R, C); const int Rb = Epi::PERM ? ((R & ~31) + perm32(R & 31)) : R;
        voffA[i] = (unsigned)(R * K + C) * 2u; voffB[i] = (unsigned)(Rb * K + C) * 2u; }
    const size_t kstep = (size_t)(BK * 2);
    const size_t hstep = (size_t)HALF * K * 2;
    const size_t tstep = 2 * hstep;
    const unsigned ldsw = (unsigned)wid * 1024u;
    const int aoff = lds_byte(wr * 64 + fr, fq * 8), boff = lds_byte(wc * 32 + fr, fq * 8);
#define PG8_SA(b, h) (((b) * 2 + (h)) * HTB)
#define PG8_SB(b, h) ((4 + (b) * 2 + (h)) * HTB)
#define PG8_STAGE(bufoff, gbase, voff) do { _Pragma("unroll") for (int _i = 0; _i < 2; ++_i) \
        __builtin_amdgcn_global_load_lds((const unsigned*)((const char*)(gbase) + (voff)[_i]), (PG8_LAS unsigned*)(lds + (bufoff) + ldsw + _i * 8192), 16, 0, 0); } while (0)
#define PG8_LDA(dst, b, h) do { _Pragma("unroll") for (int m = 0; m < 4; ++m) _Pragma("unroll") for (int k = 0; k < 2; ++k) dst[m][k] = *(const PG8_LAS bf16x8*)(lds + PG8_SA(b, h) + aoff + m * 2048 + k * 1024); } while (0)
#define PG8_LDB(dst, b, h) do { _Pragma("unroll") for (int n = 0; n < 2; ++n) _Pragma("unroll") for (int k = 0; k < 2; ++k) dst[n][k] = *(const PG8_LAS bf16x8*)(lds + PG8_SB(b, h) + boff + n * 2048 + k * 1024); } while (0)
#define PG8_MMA(ai, bj, At, Bt) do { __builtin_amdgcn_s_setprio(1); _Pragma("unroll") for (int m = 0; m < 4; ++m) _Pragma("unroll") for (int n = 0; n < 2; ++n) _Pragma("unroll") for (int k = 0; k < 2; ++k) \
        acc[ai][bj][m][n] = __builtin_amdgcn_mfma_f32_16x16x32_bf16(Bt[n][k], At[m][k], acc[ai][bj][m][n], 0, 0, 0); __builtin_amdgcn_s_setprio(0); } while (0)
#define PG8_WAIT_V(n) asm volatile("s_waitcnt vmcnt(" #n ")" ::: "memory")
#define PG8_WAIT_L(n) asm volatile("s_waitcnt lgkmcnt(" #n ")" ::: "memory")
#define PG8_BAR __builtin_amdgcn_s_barrier()
#define PG8_SCHED __builtin_amdgcn_sched_barrier(0)
    Unit cur, nxt; int ui = 0;
    if (!S.next(0, cur)) return;
    f32x4 acc[2][2][4][2];
#pragma unroll
    for (int a = 0; a < 2; ++a)
#pragma unroll
        for (int b = 0; b < 2; ++b)
#pragma unroll
            for (int m = 0; m < 4; ++m)
#pragma unroll
                for (int n = 0; n < 2; ++n) acc[a][b][m][n] = (f32x4){0.f, 0.f, 0.f, 0.f};
    bf16x8 At[4][2], B0[2][2], B1[2][2];
    const char* cA = (const char*)g.A + (size_t)cur.pm * tstep; const char* cB = (const char*)g.Bt + (size_t)cur.pn * tstep;
    S.a_ready(cur);
    PG8_STAGE(PG8_SB(0, 0), cB, voffB); PG8_STAGE(PG8_SA(0, 0), cA, voffA); PG8_STAGE(PG8_SB(0, 1), cB + hstep, voffB); PG8_STAGE(PG8_SA(0, 1), cA + hstep, voffA);
    if (wr == 1) PG8_BAR;
    PG8_WAIT_V(4); PG8_BAR;
    PG8_STAGE(PG8_SB(1, 0), cB + kstep, voffB); PG8_STAGE(PG8_SA(1, 0), cA + kstep, voffA); PG8_STAGE(PG8_SB(1, 1), cB + hstep + kstep, voffB);
    PG8_WAIT_V(6); PG8_BAR;
    PG8_STAMP();
    for (;;) {
        const bool has_next = S.next(ui + 1, nxt);
        const char* nA = has_next ? (const char*)g.A + (size_t)nxt.pm * tstep : cA; const char* nB = has_next ? (const char*)g.Bt + (size_t)nxt.pn * tstep : cB;
        for (int t = 0; t < nt; t += 2) {
            const bool last = (t == nt - 2);
            const char* a1 = cA + (size_t)(t + 1) * kstep;
            const char* a2 = last ? nA : cA + (size_t)(t + 2) * kstep; const char* b2 = last ? nB : cB + (size_t)(t + 2) * kstep;
            const char* a3 = a2 + kstep; const char* b3 = b2 + kstep;
            if (last && has_next) S.a_ready(nxt);
            PG8_LDB(B0, 0, 0); PG8_SCHED; PG8_LDA(At, 0, 0); PG8_STAGE(PG8_SA(1, 1), a1 + hstep, voffA);
            PG8_WAIT_L(8); PG8_BAR; PG8_WAIT_L(0); PG8_MMA(0, 0, At, B0); PG8_BAR; PG8_SCHED;
            PG8_LDB(B1, 0, 1); PG8_STAGE(PG8_SB(0, 0), b2, voffB);
            PG8_BAR; PG8_WAIT_L(0); PG8_MMA(0, 1, At, B1); PG8_BAR;
            PG8_LDA(At, 0, 1); PG8_STAGE(PG8_SA(0, 0), a2, voffA);
            PG8_BAR; PG8_WAIT_L(0); PG8_MMA(1, 0, At, B0); PG8_BAR; PG8_SCHED;
            PG8_STAGE(PG8_SB(0, 1), b2 + hstep, voffB);
            PG8_WAIT_V(6); PG8_BAR; PG8_MMA(1, 1, At, B1); PG8_BAR;
            PG8_LDB(B0, 1, 0); PG8_SCHED; PG8_LDA(At, 1, 0); PG8_STAGE(PG8_SA(0, 1), a2 + hstep, voffA);
            PG8_WAIT_L(8); PG8_BAR; PG8_WAIT_L(0); PG8_MMA(0, 0, At, B0); PG8_BAR; PG8_SCHED;
            PG8_LDB(B1, 1, 1); PG8_STAGE(PG8_SB(1, 0), b3, voffB);
            PG8_BAR; PG8_WAIT_L(0); PG8_MMA(0, 1, At, B1); PG8_BAR;
            PG8_LDA(At, 1, 1); PG8_STAGE(PG8_SA(1, 0), a3, voffA);
            PG8_BAR; PG8_WAIT_L(0); PG8_MMA(1, 0, At, B0); PG8_BAR; PG8_SCHED;
            PG8_STAGE(PG8_SB(1, 1), b3 + hstep, voffB);
            PG8_WAIT_V(6); PG8_BAR; PG8_MMA(1, 1, At, B1); PG8_BAR;
        }
        PG8_STAMP();
        if constexpr (!Epi::AFTER_DRAIN) { E(acc, cur, wr, wc, fr, fq); S.done(cur); }
        PG8_STAMP();
        if (!has_next) break;
#pragma unroll
        for (int a = 0; a < 2; ++a)
#pragma unroll
            for (int b = 0; b < 2; ++b)
#pragma unroll
                for (int m = 0; m < 4; ++m)
#pragma unroll
                    for (int n = 0; n < 2; ++n) acc[a][b][m][n] = (f32x4){0.f, 0.f, 0.f, 0.f};
        cur = nxt; cA = nA; cB = nB; ++ui;
    }
    PG8_WAIT_V(0);
    if (wr == 0) PG8_BAR;
    PG8_BAR;
    if constexpr (Epi::AFTER_DRAIN) { E.fused(acc, cur, wr, wc, fr, fq, lds, wid, lane); S.done(cur); }
    PG8_STAMP();
    if (STAMP && wid == 0) { stamps[lane] = lane < nts ? (((unsigned long long)(unsigned)ts_hi << 32) | (unsigned)ts_lo) : 0ull;
        if (lane == 62) stamps[62] = rt_entry; if (lane == 63) stamps[63] = (unsigned long long)wall_clock64(); }
#undef PG8_STAMP
#undef PG8_SA
#undef PG8_SB
#undef PG8_STAGE
#undef PG8_LDA
#undef PG8_LDB
#undef PG8_MMA
#undef PG8_WAIT_V
#undef PG8_WAIT_L
#undef PG8_BAR
#undef PG8_SCHED
}
}

constexpr int T_TOK = 16384, DM = 2048, SEQ = 4096, NBATCH = 4, DEPTH = 2;
constexpr int INW = 5656;
constexpr int N1 = 4352;
constexpr int NV = 1536;
constexpr int C_MQ = 0, C_MK = 512, C_DQ = 1024, C_DK = 1536, C_NQ = 2048, C_KC = 3072, C_VC = 3328, C_KS = 3584, C_KW = 3840, C_GATE = 4096;
constexpr int R_MV = 0, R_DV = 512, R_VS = 1024, R_VW = 1280;
constexpr float LOG2E = 1.4426950408889634f;
constexpr float ATT_C128 = 0.08838834764831845f * LOG2E;
constexpr float ATT_C64 = 0.125f * LOG2E;

__device__ const unsigned char T5B[128] = {0, 1, 2, 3, 4, 5, 6, 7, 8, 9, 10, 11, 12, 13, 14, 15, 16, 16, 16, 17, 17, 18, 18, 18, 19, 19, 19, 20, 20, 20, 20, 21, 21, 21, 21, 22, 22, 22, 22, 22, 23, 23, 23, 23, 23, 23, 24, 24, 24, 24, 24, 24, 25, 25, 25, 25, 25, 25, 25, 26, 26, 26, 26, 26, 26, 26, 26, 27, 27, 27, 27, 27, 27, 27, 27, 27, 27, 28, 28, 28, 28, 28, 28, 28, 28, 28, 28, 29, 29, 29, 29, 29, 29, 29, 29, 29, 29, 29, 29, 30, 30, 30, 30, 30, 30, 30, 30, 30, 30, 30, 30, 30, 30, 31, 31, 31, 31, 31, 31, 31, 31, 31, 31, 31, 31, 31, 31, 31};

constexpr size_t al256(size_t x) { return (x + 255) & ~(size_t)255; }
constexpr size_t WS_CTL = 0;
constexpr size_t CTL_BYTES = 32768;
constexpr size_t WS_BIAS = WS_CTL + CTL_BYTES;
constexpr size_t WS_LAM = WS_BIAS + al256(16 * 132 * 4);
constexpr size_t WS_CB = WS_LAM + 256;
constexpr size_t WS_WT1 = WS_CB + 2048;
constexpr size_t WS_WTV = WS_WT1 + (size_t)DEPTH * N1 * DM * 2;
constexpr size_t WS_WTO = WS_WTV + (size_t)DEPTH * NV * DM * 2;
constexpr size_t WS_WTQ = WS_WTO + (size_t)DEPTH * DM * DM * 2;
constexpr size_t WS_WCT = WS_WTQ + (size_t)DEPTH * DM * DM * 2;
constexpr size_t WS_SKB = WS_WCT + (size_t)DEPTH * 2 * 128 * 4096 * 2;
constexpr size_t WS_UB = WS_SKB + (size_t)DEPTH * 8 * 2 * 128 * 128 * 2;
constexpr size_t WS_VB = WS_UB + (size_t)DEPTH * 16384 * DM;
constexpr size_t WS_SCU = WS_VB + (size_t)DEPTH * 16384 * DM;
constexpr size_t WS_SCV = WS_SCU + (size_t)DEPTH * 16384 * 4;
constexpr size_t WS_HN = WS_SCV + (size_t)DEPTH * 16384 * 4;
constexpr size_t WS_PROJ = WS_HN + (size_t)T_TOK * DM * 2;
constexpr size_t WS_VT = WS_PROJ + (size_t)T_TOK * N1 * 2;
constexpr size_t WS_OMIX = WS_VT + (size_t)NV * T_TOK * 2;
constexpr size_t WS_OC = WS_OMIX + (size_t)T_TOK * DM * 2;
constexpr size_t WS_OW = WS_OC + (size_t)T_TOK * 1024 * 2;
constexpr size_t WS_XW = WS_OW + (size_t)T_TOK * 1024 * 2;
constexpr size_t WS_KCMP = WS_XW + (size_t)T_TOK * DM * 4;
constexpr size_t WS_VCMPT = WS_KCMP + (size_t)8 * 256 * 128 * 2;
constexpr size_t WS_KMEAN = WS_VCMPT + (size_t)8 * 128 * 256 * 2;
constexpr size_t WS_SELM = WS_KMEAN + (size_t)16 * 16 * 128 * 2;
constexpr size_t WS_EIDX = WS_SELM + (size_t)8 * 4096 * 8;
constexpr size_t WS_EGATE = WS_EIDX + (size_t)T_TOK * 128 * 4;
constexpr size_t WS_END = WS_EGATE + (size_t)T_TOK * 128 * 4;
static_assert(WS_END <= (size_t)1 << 30, "workspace over 1 GiB");

constexpr int CW_BAR = 0;
constexpr int CW_Q = 4096;
#define CWQ(i) (CW_Q + 64 * (i))

constexpr int LDS_MISC = 162816;
constexpr int LDS_BYTES = LDS_MISC + 1024;

struct Params {
    const float* x; const float* rel_bias; const float* attn_norm; const float* w_in; const float* diff_lambda; const float* diff_subln;
    const float* cmp_pos; const float* cmp_w; const float* w_out; const float* ffn_norm; const float* peer_wq; const float* peer_subkeys;
    const float* peer_u; const float* peer_v; const float* final_norm;
    float* out; unsigned char* ws;
};

#define GAS __attribute__((address_space(1)))
template <class T> __device__ __forceinline__ T gld(const void* p) { return *(const GAS T*)p; }
template <class T> __device__ __forceinline__ void gst(void* p, T v) { *(GAS T*)p = v; }
__device__ __forceinline__ unsigned cvt_pk_bf16(float lo, float hi) { unsigned r; asm volatile("v_cvt_pk_bf16_f32 %0, %1, %2" : "=v"(r) : "v"(lo), "v"(hi)); return r; }
__device__ __forceinline__ float bf_lo(unsigned u) { return __uint_as_float(u << 16); }
__device__ __forceinline__ float bf_hi(unsigned u) { return __uint_as_float(u & 0xffff0000u); }
__device__ __forceinline__ float pmax32(float v) { const auto r = __builtin_amdgcn_permlane32_swap(__float_as_uint(v), __float_as_uint(v), false, false); return fmaxf(__uint_as_float(r[0]), __uint_as_float(r[1])); }
__device__ __forceinline__ float psum32(float v) { const auto r = __builtin_amdgcn_permlane32_swap(__float_as_uint(v), __float_as_uint(v), false, false); return __uint_as_float(r[0]) + __uint_as_float(r[1]); }
__device__ __forceinline__ unsigned por32(unsigned v) { const auto r = __builtin_amdgcn_permlane32_swap(v, v, false, false); return r[0] | r[1]; }
template <int M> __device__ __forceinline__ float swz_xor(float v) { return __int_as_float(__builtin_amdgcn_ds_swizzle(__float_as_int(v), (M << 10) | 0x1f)); }
template <int M> __device__ __forceinline__ unsigned swz_xor_u(unsigned v) { return (unsigned)__builtin_amdgcn_ds_swizzle((int)v, (M << 10) | 0x1f); }
__device__ __forceinline__ float wave_sum(float v) {
    v = psum32(v); v += swz_xor<16>(v); v += swz_xor<8>(v); v += swz_xor<4>(v); v += swz_xor<2>(v); v += swz_xor<1>(v);
    return v;
}
__device__ __forceinline__ float wave_max(float v) {
    v = pmax32(v); v = fmaxf(v, swz_xor<16>(v)); v = fmaxf(v, swz_xor<8>(v)); v = fmaxf(v, swz_xor<4>(v)); v = fmaxf(v, swz_xor<2>(v)); v = fmaxf(v, swz_xor<1>(v));
    return v;
}

struct Ctx {
    LAS unsigned char* lds;
    int tid, lane, wave, G, bid;
    unsigned* ctl;
};

#ifndef PEER_FMT_U
#define PEER_FMT_U 6
#endif
#ifndef PEER_FMT_V
#define PEER_FMT_V 4
#endif
template <int FMT> struct PeerFmt { static constexpr int ROWB = DM * FMT / 8, LANEB = 32 * FMT / 8; static constexpr float MAXV = FMT == 8 ? 448.0f : (FMT == 6 ? 7.5f : 6.0f); };
typedef unsigned u32x6 __attribute__((ext_vector_type(6)));
typedef float f32x32 __attribute__((ext_vector_type(32)));
__device__ __forceinline__ unsigned enc_fp6(float y) {
    const float a = fabsf(y);
    float c = a < 2.0f ? a * 8.0f : (a < 4.0f ? 16.0f + (a - 2.0f) * 4.0f : 24.0f + (a - 4.0f) * 2.0f);
    unsigned q = (unsigned)__builtin_rintf(c); q = q > 31u ? 31u : q;
    return q | (y < 0.f ? 32u : 0u);
}
template <int FMT> __device__ __forceinline__ void enc32(const float (&y)[32], unsigned (&w)[6]) {
    if (FMT == 4) {
#pragma unroll
        for (int d = 0; d < 4; ++d) { unsigned t = 0u;
            t = __builtin_amdgcn_cvt_scalef32_pk_fp4_f32(t, y[8 * d + 0], y[8 * d + 1], 1.0f, 0);
            t = __builtin_amdgcn_cvt_scalef32_pk_fp4_f32(t, y[8 * d + 2], y[8 * d + 3], 1.0f, 1);
            t = __builtin_amdgcn_cvt_scalef32_pk_fp4_f32(t, y[8 * d + 4], y[8 * d + 5], 1.0f, 2);
            t = __builtin_amdgcn_cvt_scalef32_pk_fp4_f32(t, y[8 * d + 6], y[8 * d + 7], 1.0f, 3);
            w[d] = t; }
        w[4] = 0u; w[5] = 0u;
    } else {
        unsigned long long lo = 0ull, mid = 0ull, hi = 0ull;
#pragma unroll
        for (int i = 0; i < 32; ++i) {
            const unsigned long long q = enc_fp6(y[i]); const int bit = 6 * i;
            if (bit < 64) { lo |= q << bit; if (bit + 6 > 64) mid |= q >> (64 - bit); }
            else if (bit < 128) { mid |= q << (bit - 64); if (bit + 6 > 128) hi |= q >> (128 - bit); }
            else hi |= q << (bit - 128);
        }
        w[0] = (unsigned)lo; w[1] = (unsigned)(lo >> 32); w[2] = (unsigned)mid; w[3] = (unsigned)(mid >> 32); w[4] = (unsigned)hi; w[5] = (unsigned)(hi >> 32);
    }
}
template <int FMT> __device__ __forceinline__ void dec32(const unsigned (&w)[6], f32x2 (&o)[16]) {
    if (FMT == 4) {
#pragma unroll
        for (int d = 0; d < 4; ++d) {
            o[4 * d + 0] = __builtin_amdgcn_cvt_scalef32_pk_f32_fp4(w[d], 1.0f, 0); o[4 * d + 1] = __builtin_amdgcn_cvt_scalef32_pk_f32_fp4(w[d], 1.0f, 1);
            o[4 * d + 2] = __builtin_amdgcn_cvt_scalef32_pk_f32_fp4(w[d], 1.0f, 2); o[4 * d + 3] = __builtin_amdgcn_cvt_scalef32_pk_f32_fp4(w[d], 1.0f, 3);
        }
    } else {
        const u32x6 q = {w[0], w[1], w[2], w[3], w[4], w[5]};
        const f32x32 f = __builtin_amdgcn_cvt_scalef32_pk32_f32_fp6(q, 1.0f);
#pragma unroll
        for (int i = 0; i < 16; ++i) o[i] = (f32x2){f[2 * i], f[2 * i + 1]};
    }
}
__device__ __forceinline__ void ldrow_u6(const unsigned char* p16, int d8, unsigned (&w)[6]) {
    const u32x4 a = gld<u32x4>(p16); const u32x2 b = gld<u32x2>(p16 + d8);
    w[0] = a.x; w[1] = a.y; w[2] = a.z; w[3] = a.w; w[4] = b.x; w[5] = b.y;
}
template <int FMT> __device__ __forceinline__ void ldrow(const unsigned char* p, unsigned (&w)[6]) {
    if (FMT == 4) { const u32x4 v = gld<u32x4>(p); w[0] = v.x; w[1] = v.y; w[2] = v.z; w[3] = v.w; w[4] = 0u; w[5] = 0u; }
    else { const u32x2 a = gld<u32x2>(p), b = gld<u32x2>(p + 8), cc = gld<u32x2>(p + 16); w[0] = a.x; w[1] = a.y; w[2] = b.x; w[3] = b.y; w[4] = cc.x; w[5] = cc.y; }
}

__device__ __forceinline__ void conv_tile_T(const Ctx& c, const float* src, int ld_src, int k0, int src_col0, int nvalid, bf16_t* dst, int ldd, int n0) {
    LAS float* tile = (LAS float*)c.lds;
    const int tid = c.tid;
    {
        const int r = tid >> 4, c4 = (tid & 15) * 4;
#pragma unroll
        for (int i = 0; i < 2; ++i) {
            const int row = r + 32 * i;
            f32x4 v = {0.f, 0.f, 0.f, 0.f};
            if (c4 < nvalid) v = gld<f32x4>(src + (size_t)(k0 + row) * ld_src + src_col0 + c4);
            tile[row * 65 + c4 + 0] = v[0]; tile[row * 65 + c4 + 1] = v[1]; tile[row * 65 + c4 + 2] = v[2]; tile[row * 65 + c4 + 3] = v[3];
        }
    }
    __syncthreads();
    {
        const int n = tid >> 3, kc = (tid & 7) * 8;
        float v[8];
#pragma unroll
        for (int j = 0; j < 8; ++j) v[j] = tile[(kc + j) * 65 + n];
        u32x4 w; w.x = cvt_pk_bf16(v[0], v[1]); w.y = cvt_pk_bf16(v[2], v[3]); w.z = cvt_pk_bf16(v[4], v[5]); w.w = cvt_pk_bf16(v[6], v[7]);
        gst<u32x4>(dst + (size_t)(n0 + n) * ldd + k0 + kc, w);
    }
    __syncthreads();
}

__device__ __forceinline__ int n1_to_src(int n1) {
    if (n1 < 1024) return n1;
    if (n1 < 2048) return n1 + 512;
    if (n1 < 3840) return n1 + 1024;
    if (n1 < 4096) return n1 + 1280;
    return n1 + 1536;
}
__device__ __forceinline__ int nv_to_src(int nv) {
    if (nv < 512) return nv + 1024;
    if (nv < 1024) return nv + 2048;
    if (nv < 1280) return nv + 3840;
    return nv + 4096;
}

constexpr int CONV_STRIPS_A = 65 + 24 + 32 + 32;
constexpr int CONV_JOBS_A = CONV_STRIPS_A * 32;
constexpr int CONV_JOBS_L = CONV_JOBS_A + 4 * 64;

__device__ __forceinline__ void phase_prologue(const Ctx& c, const Params& p) {
    unsigned char* ws = p.ws;
    {
        const int tid = c.tid, lr = tid >> 4, lc4 = (tid & 15) * 4, sn = tid >> 3, skc = (tid & 7) * 8;
        const int njobs = DEPTH * CONV_JOBS_L;
        const float* s0 = nullptr; size_t srow = 0; bool ok = false; bf16_t* d0 = nullptr;
        f32x4 va = {0.f, 0.f, 0.f, 0.f}, vb = va;
        auto decode = [&](int job, const float*& sp, size_t& ld, bool& okk, bf16_t*& dp) {
            const int l = job / CONV_JOBS_L, j = job % CONV_JOBS_L;
            const float* src; int ldsrc, k0, col0, nvalid, ldd, n0; bf16_t* dst;
            if (j < CONV_JOBS_A) {
                const int strip = j >> 5, kt = j & 31; k0 = kt * 64; ldd = DM;
                if (strip < 65) { n0 = strip * 64; src = p.w_in + (size_t)l * DM * INW; ldsrc = INW; col0 = n1_to_src(n0); nvalid = strip < 64 ? 64 : 24; dst = (bf16_t*)(ws + WS_WT1) + (size_t)l * N1 * DM; }
                else if (strip < 89) { n0 = (strip - 65) * 64; src = p.w_in + (size_t)l * DM * INW; ldsrc = INW; col0 = nv_to_src(n0); nvalid = 64; dst = (bf16_t*)(ws + WS_WTV) + (size_t)l * NV * DM; }
                else if (strip < 121) { n0 = (strip - 89) * 64; src = p.w_out + (size_t)l * DM * DM; ldsrc = DM; col0 = n0; nvalid = 64; dst = (bf16_t*)(ws + WS_WTO) + (size_t)l * DM * DM; }
                else { n0 = (strip - 121) * 64; src = p.peer_wq + (size_t)l * DM * DM; ldsrc = DM; col0 = n0; nvalid = 64; dst = (bf16_t*)(ws + WS_WTQ) + (size_t)l * DM * DM; }
            } else {
                const int jj = j - CONV_JOBS_A, strip = jj >> 6, kt = jj & 63, kv = strip >> 1; k0 = kt * 64; n0 = (strip & 1) * 64; ldd = 4096;
                src = p.cmp_w + ((size_t)l * 2 + kv) * 4096 * 128; ldsrc = 128; col0 = n0; nvalid = 64; dst = (bf16_t*)(ws + WS_WCT) + ((size_t)l * 2 + kv) * 128 * 4096;
            }
            sp = src + (size_t)(k0 + lr) * ldsrc + col0 + lc4; ld = (size_t)32 * ldsrc; okk = lc4 < nvalid;
            dp = dst + (size_t)(n0 + sn) * ldd + k0 + skc;
        };
        int job = c.bid;
        if (job < njobs) { decode(job, s0, srow, ok, d0); if (ok) { va = gld<f32x4>(s0); vb = gld<f32x4>(s0 + srow); } }
        for (int it = 0; job < njobs; job += c.G, ++it) {
            LAS float* tile = (LAS float*)(c.lds + (it & 1) * 16896);
            bf16_t* dcur = d0;
            const f32x4 ca = va, cb = vb;
            const int nj = job + c.G;
            if (nj < njobs) { decode(nj, s0, srow, ok, d0); va = (f32x4){0.f, 0.f, 0.f, 0.f}; vb = va; if (ok) { va = gld<f32x4>(s0); vb = gld<f32x4>(s0 + srow); } }
            tile[lr * 65 + lc4 + 0] = ca[0]; tile[lr * 65 + lc4 + 1] = ca[1]; tile[lr * 65 + lc4 + 2] = ca[2]; tile[lr * 65 + lc4 + 3] = ca[3];
            tile[(lr + 32) * 65 + lc4 + 0] = cb[0]; tile[(lr + 32) * 65 + lc4 + 1] = cb[1]; tile[(lr + 32) * 65 + lc4 + 2] = cb[2]; tile[(lr + 32) * 65 + lc4 + 3] = cb[3];
            __syncthreads();
            float v[8];
#pragma unroll
            for (int jx = 0; jx < 8; ++jx) v[jx] = tile[(skc + jx) * 65 + sn];
            u32x4 w; w.x = cvt_pk_bf16(v[0], v[1]); w.y = cvt_pk_bf16(v[2], v[3]); w.z = cvt_pk_bf16(v[4], v[5]); w.w = cvt_pk_bf16(v[6], v[7]);
            gst<u32x4>(dcur, w);
        }
        __syncthreads();
    }
    const size_t gtid = (size_t)c.bid * 512 + c.tid, gthreads = (size_t)c.G * 512;
    for (size_t i = gtid; i < (size_t)DEPTH * 192 * DM / 8; i += gthreads) {
        const size_t l = i / (192 * DM / 8), r = i % (192 * DM / 8);
        gst<u32x4>((bf16_t*)(ws + WS_WT1) + (l * N1 + 4160) * DM + r * 8, (u32x4){0u, 0u, 0u, 0u});
    }
    {
        const int gw = c.bid * 8 + c.wave, nw = c.G * 8, lane = c.lane;
        for (int row = gw; row < 2 * DEPTH * 16384; row += nw) {
            const int tab = row / (DEPTH * 16384), rr = row % (DEPTH * 16384);
            const float* src = (tab ? p.peer_v : p.peer_u) + (size_t)rr * DM + lane * 32;
            float y[32]; float am = 0.f;
#pragma unroll
            for (int i = 0; i < 8; ++i) { const f32x4 v = gld<f32x4>(src + i * 4); y[4 * i] = v[0]; y[4 * i + 1] = v[1]; y[4 * i + 2] = v[2]; y[4 * i + 3] = v[3];
                am = fmaxf(am, fmaxf(fmaxf(fabsf(v[0]), fabsf(v[1])), fmaxf(fabsf(v[2]), fabsf(v[3])))); }
            am = wave_max(am);
            const float mx = tab ? PeerFmt<PEER_FMT_V>::MAXV : PeerFmt<PEER_FMT_U>::MAXV;
            const float sc = am > 0.f ? mx / am : 1.0f;
            if (lane == 0) ((float*)(ws + (tab ? WS_SCV : WS_SCU)))[rr] = am > 0.f ? am / mx : 1.0f;
#pragma unroll
            for (int i = 0; i < 32; ++i) y[i] *= sc;
            unsigned w[6];
            if (tab) {
                enc32<PEER_FMT_V>(y, w);
                unsigned char* dst = ws + WS_VB + (size_t)rr * PeerFmt<PEER_FMT_V>::ROWB + lane * PeerFmt<PEER_FMT_V>::LANEB;
                if (PEER_FMT_V == 4) gst<u32x4>(dst, (u32x4){w[0], w[1], w[2], w[3]});
                else { gst<u32x2>(dst, (u32x2){w[0], w[1]}); gst<u32x2>(dst + 8, (u32x2){w[2], w[3]}); gst<u32x2>(dst + 16, (u32x2){w[4], w[5]}); }
            } else {
                enc32<PEER_FMT_U>(y, w);
                unsigned char* dst = ws + WS_UB + (size_t)rr * PeerFmt<PEER_FMT_U>::ROWB + lane * PeerFmt<PEER_FMT_U>::LANEB;
                if (PEER_FMT_U == 4) gst<u32x4>(dst, (u32x4){w[0], w[1], w[2], w[3]});
                else {
                    unsigned char* d6 = ws + WS_UB + (size_t)rr * PeerFmt<PEER_FMT_U>::ROWB + (lane >> 3) * 192;
                    gst<u32x4>(d6 + (lane & 7) * 16, (u32x4){w[0], w[1], w[2], w[3]}); gst<u32x2>(d6 + 128 + (lane & 7) * 8, (u32x2){w[4], w[5]});
                }
            }
        }
        const size_t m8 = (size_t)DEPTH * 8 * 2 * 128 * 128 / 8;
        const float* ss = p.peer_subkeys; bf16_t* ds = (bf16_t*)(ws + WS_SKB);
        for (size_t i = gtid; i < m8; i += gthreads) {
            const f32x4 a = gld<f32x4>(ss + i * 8), b = gld<f32x4>(ss + i * 8 + 4);
            u32x4 w; w.x = cvt_pk_bf16(a[0], a[1]); w.y = cvt_pk_bf16(a[2], a[3]); w.z = cvt_pk_bf16(b[0], b[1]); w.w = cvt_pk_bf16(b[2], b[3]);
            gst<u32x4>(ds + i * 8, w);
        }
    }
    if (c.bid >= c.G - 4) {
        const int lk = c.bid - (c.G - 4), e = c.tid & 127, kq = c.tid >> 7;
        const float* pos = p.cmp_pos + (size_t)lk * 4096 + kq * 1024;
        const float* w = p.cmp_w + (size_t)lk * 4096 * 128 + (size_t)kq * 1024 * 128 + e;
        float s = 0.f;
#pragma unroll 8
        for (int k = 0; k < 1024; ++k) s = fmaf(pos[k], w[(size_t)k * 128], s);
        LAS float* red = (LAS float*)(c.lds + 32768);
        red[c.tid] = s;
        __syncthreads();
        if (c.tid < 128) ((float*)(ws + WS_CB))[lk * 128 + c.tid] = (red[c.tid] + red[128 + c.tid]) + (red[256 + c.tid] + red[384 + c.tid]);
    }
    if (c.bid == 0) {
        float* bt = (float*)(ws + WS_BIAS);
        for (int i = c.tid; i < 16 * 132; i += 512) {
            const int h = i / 132, d = i % 132;
            const int bucket = d < 128 ? (int)T5B[d] : 31;
            bt[i] = p.rel_bias[bucket * 16 + h] * LOG2E;
        }
        if (c.tid < DEPTH) {
            const float* lp = p.diff_lambda + (size_t)c.tid * 4 * 64;
            float s1 = 0.f, s2 = 0.f;
            for (int i = 0; i < 64; ++i) { s1 += lp[i] * lp[64 + i]; s2 += lp[128 + i] * lp[192 + i]; }
            const float lam_init = 0.8f - 0.6f * expf(-0.3f * (float)c.tid);
            ((float*)(ws + WS_LAM))[c.tid] = expf(s1) - expf(s2) + lam_init;
        }
    }
}

__device__ __forceinline__ void phase_rmsnorm_bf16(const Ctx& c, const float* x, const float* gain, bf16_t* out) {
    const int gw = c.bid * 8 + c.wave, nw = c.G * 8, lane = c.lane;
    f32x4 g[8];
#pragma unroll
    for (int i = 0; i < 8; ++i) g[i] = gld<f32x4>(gain + i * 256 + lane * 4);
    for (int row = gw; row < T_TOK; row += nw) {
        const float* xr = x + (size_t)row * DM;
        f32x4 v[8]; float ss = 0.f;
#pragma unroll
        for (int i = 0; i < 8; ++i) { v[i] = gld<f32x4>(xr + i * 256 + lane * 4); ss += v[i][0] * v[i][0] + v[i][1] * v[i][1] + v[i][2] * v[i][2] + v[i][3] * v[i][3]; }
        ss = wave_sum(ss);
        const float rstd = rsqrtf(ss * (1.0f / DM) + 1e-6f);
        bf16_t* orow = out + (size_t)row * DM;
#pragma unroll
        for (int i = 0; i < 8; ++i) {
            u32x2 w; w.x = cvt_pk_bf16(v[i][0] * rstd * g[i][0], v[i][1] * rstd * g[i][1]); w.y = cvt_pk_bf16(v[i][2] * rstd * g[i][2], v[i][3] * rstd * g[i][3]);
            gst<u32x2>(orow + i * 256 + lane * 4, w);
        }
    }
}
__device__ __forceinline__ void phase_rmsnorm_f32(const Ctx& c, const float* x, const float* gain, float* out) {
    const int gw = c.bid * 8 + c.wave, nw = c.G * 8, lane = c.lane;
    f32x4 g[8];
#pragma unroll
    for (int i = 0; i < 8; ++i) g[i] = gld<f32x4>(gain + i * 256 + lane * 4);
    for (int row = gw; row < T_TOK; row += nw) {
        const float* xr = x + (size_t)row * DM;
        f32x4 v[8]; float ss = 0.f;
#pragma unroll
        for (int i = 0; i < 8; ++i) { v[i] = gld<f32x4>(xr + i * 256 + lane * 4); ss += v[i][0] * v[i][0] + v[i][1] * v[i][1] + v[i][2] * v[i][2] + v[i][3] * v[i][3]; }
        ss = wave_sum(ss);
        const float rstd = rsqrtf(ss * (1.0f / DM) + 1e-6f);
        float* orow = out + (size_t)row * DM;
#pragma unroll
        for (int i = 0; i < 8; ++i) gst<f32x4>(orow + i * 256 + lane * 4, v[i] * rstd * g[i]);
    }
}
constexpr int A_KP = 272, A_VP = 144;
constexpr int A_KBUF = 64 * A_KP;
constexpr int A_VBUF = 128 * A_VP;
constexpr int A_K0 = 0, A_V0 = 2 * A_KBUF;
constexpr int A_BIAS = A_V0 + 2 * A_VBUF;
constexpr int A_TLIST = A_BIAS + 4 * 132 * 4;
constexpr int A_MISCW = A_TLIST + 160 * 4;
constexpr int A_IMP = 75776;
constexpr int A_SELM = A_IMP + 64 * 65 * 4;
constexpr int A_END = A_SELM + 64 * 8;
constexpr int A_Q = 93184;
static_assert(A_MISCW + 256 <= A_IMP && A_END <= A_Q && A_Q + 8 * 8192 <= LDS_MISC, "attention LDS map");

struct TileSrc { const unsigned char* kbase; int kpitch; const unsigned char* vbase; int vpitch; };

struct TileRegs { u32x4 k[2]; u32x4 v[2]; };
__device__ __forceinline__ void tile_load(TileRegs& r, const TileSrc& s, int key0, int tid) {
#pragma unroll
    for (int i = 0; i < 2; ++i) {
        const int ck = tid + 512 * i;
        r.k[i] = gld<u32x4>(s.kbase + (size_t)(key0 + (ck >> 4)) * s.kpitch + (ck & 15) * 16);
        r.v[i] = gld<u32x4>(s.vbase + (size_t)(ck >> 3) * s.vpitch + (size_t)key0 * 2 + (ck & 7) * 16);
    }
}
__device__ __forceinline__ void tile_store(const TileRegs& r, LAS unsigned char* lds, int buf, int tid) {
#pragma unroll
    for (int i = 0; i < 2; ++i) {
        const int ck = tid + 512 * i;
        *(LAS u32x4*)(lds + A_K0 + buf * A_KBUF + (ck >> 4) * A_KP + (ck & 15) * 16) = r.k[i];
        LAS unsigned char* vp = lds + A_V0 + buf * A_VBUF + (ck >> 3) * A_VP + ((ck & 7) >> 1) * 32 + (ck & 1) * 8;
        *(LAS u32x2*)(vp) = (u32x2){r.v[i].x, r.v[i].y};
        *(LAS u32x2*)(vp + 16) = (u32x2){r.v[i].z, r.v[i].w};
    }
}

struct SoftState { float m, l; };
#ifndef ATT_THR
#define ATT_THR 11.0f
#endif

template <int NKS, bool USE_BIAS, bool BINS>
__device__ __forceinline__ void attn_tile_core(LAS unsigned char* lds, int buf, int kcol, const LAS unsigned char* qf, f32x16 (&O)[4], SoftState& st, int lane,
                                          float cs, bool far, float bconst, int dq, unsigned W, bool okq, const LAS float* btab, float (&gs)[8], float (&gl)[8]) {
    const int r = lane & 31, h = lane >> 5;
    const LAS unsigned char* Kl = lds + A_K0 + buf * A_KBUF + r * A_KP + kcol + h * 16;
    f32x16 s0, s1;
#pragma unroll
    for (int i = 0; i < 16; ++i) { s0[i] = 0.f; s1[i] = 0.f; }
#pragma unroll
    for (int ks = 0; ks < NKS; ++ks) {
        const bf16x8 k0 = *(const LAS bf16x8*)(Kl + ks * 32);
        const bf16x8 k1 = *(const LAS bf16x8*)(Kl + 32 * A_KP + ks * 32);
        const bf16x8 qv = *(const LAS bf16x8*)(qf + ks * 1024);
        s0 = __builtin_amdgcn_mfma_f32_32x32x16_bf16(k0, qv, s0, 0, 0, 0);
        s1 = __builtin_amdgcn_mfma_f32_32x32x16_bf16(k1, qv, s1, 0, 0, 0);
    }
    const float NEG = -__builtin_inff();
    float tmax = NEG;
    if (far) {
#pragma unroll
        for (int i = 0; i < 16; ++i) {
            s0[i] = okq ? fmaf(s0[i], cs, bconst) : NEG; s1[i] = okq ? fmaf(s1[i], cs, bconst) : NEG;
            tmax = fmaxf(tmax, fmaxf(s0[i], s1[i]));
        }
    } else {
#pragma unroll
        for (int i = 0; i < 16; ++i) {
            const int c0 = (i & 3) + 8 * (i >> 2);
            const int d0 = dq - c0, d1 = dq - c0 - 32;
            float b0 = 0.f, b1 = 0.f;
            if (USE_BIAS) { b0 = btab[min(max(d0, 0), 128)]; b1 = btab[min(max(d1, 0), 128)]; }
            s0[i] = (okq && (unsigned)d0 < W) ? fmaf(s0[i], cs, b0) : NEG;
            s1[i] = (okq && (unsigned)d1 < W) ? fmaf(s1[i], cs, b1) : NEG;
            tmax = fmaxf(tmax, fmaxf(s0[i], s1[i]));
        }
    }
    tmax = pmax32(tmax);
    const float mn = fmaxf(st.m, tmax);
    const float alpha = __builtin_amdgcn_exp2f(st.m - mn);
    st.m = mn;
    float ps = 0.f;
#pragma unroll
    for (int i = 0; i < 16; ++i) { s0[i] = __builtin_amdgcn_exp2f(s0[i] - mn); s1[i] = __builtin_amdgcn_exp2f(s1[i] - mn); ps += s0[i] + s1[i]; }
    st.l = st.l * alpha + ps;
    if (BINS) {
#pragma unroll
        for (int gq = 0; gq < 4; ++gq) {
            gs[gq] = (s0[4 * gq] + s0[4 * gq + 1]) + (s0[4 * gq + 2] + s0[4 * gq + 3]); gl[gq] = s0[4 * gq + 3];
            gs[4 + gq] = (s1[4 * gq] + s1[4 * gq + 1]) + (s1[4 * gq + 2] + s1[4 * gq + 3]); gl[4 + gq] = s1[4 * gq + 3];
        }
    }
    if (!__all(alpha == 1.0f)) {
#pragma unroll
        for (int db = 0; db < 4; ++db)
#pragma unroll
            for (int i = 0; i < 16; ++i) O[db][i] *= alpha;
    }
    bf16x8 pf[4];
    {
        u32x4 w;
        w.x = cvt_pk_bf16(s0[0], s0[1]); w.y = cvt_pk_bf16(s0[2], s0[3]); w.z = cvt_pk_bf16(s0[4], s0[5]); w.w = cvt_pk_bf16(s0[6], s0[7]); pf[0] = __builtin_bit_cast(bf16x8, w);
        w.x = cvt_pk_bf16(s0[8], s0[9]); w.y = cvt_pk_bf16(s0[10], s0[11]); w.z = cvt_pk_bf16(s0[12], s0[13]); w.w = cvt_pk_bf16(s0[14], s0[15]); pf[1] = __builtin_bit_cast(bf16x8, w);
        w.x = cvt_pk_bf16(s1[0], s1[1]); w.y = cvt_pk_bf16(s1[2], s1[3]); w.z = cvt_pk_bf16(s1[4], s1[5]); w.w = cvt_pk_bf16(s1[6], s1[7]); pf[2] = __builtin_bit_cast(bf16x8, w);
        w.x = cvt_pk_bf16(s1[8], s1[9]); w.y = cvt_pk_bf16(s1[10], s1[11]); w.z = cvt_pk_bf16(s1[12], s1[13]); w.w = cvt_pk_bf16(s1[14], s1[15]); pf[3] = __builtin_bit_cast(bf16x8, w);
    }
    const LAS unsigned char* Vl = lds + A_V0 + buf * A_VBUF + r * A_VP + h * 16;
    bf16x8 v0 = *(const LAS bf16x8*)(Vl), v1 = *(const LAS bf16x8*)(Vl + 32);
#pragma unroll
    for (int idx = 0; idx < 16; ++idx) {
        bf16x8 vn = v1;
        if (idx + 2 < 16) vn = *(const LAS bf16x8*)(Vl + ((idx + 2) >> 2) * 32 * A_VP + ((idx + 2) & 3) * 32);
        O[idx >> 2] = __builtin_amdgcn_mfma_f32_32x32x16_bf16(v0, pf[idx & 3], O[idx >> 2], 0, 0, 0);
        v0 = v1; v1 = vn;
    }
}
template <int NKS, bool USE_BIAS>
__device__ __forceinline__ void attn_tile(LAS unsigned char* lds, int buf, int kcol, const LAS unsigned char* qf, f32x16 (&O)[4], SoftState& st, int lane,
                                          float cs, bool far, float bconst, int dq, unsigned W, bool okq, const LAS float* btab) {
    float gs[8], gl[8];
    attn_tile_core<NKS, USE_BIAS, false>(lds, buf, kcol, qf, O, st, lane, cs, far, bconst, dq, W, okq, btab, gs, gl);
}
template <int NKS>
__device__ __forceinline__ void attn_tile_p(LAS unsigned char* lds, int buf, const LAS unsigned char* qf, f32x16 (&O)[4], SoftState& st, int lane, float cs, int dq, float (&gs)[8], float (&gl)[8]) {
    attn_tile_core<NKS, false, true>(lds, buf, 0, qf, O, st, lane, cs, false, 0.f, dq, 0x80000000u, true, nullptr, gs, gl);
}

template <int NKS, bool USE_BIAS>
__device__ __forceinline__ void attn_qk_sm(LAS unsigned char* lds, int buf, int kcol, const LAS unsigned char* qf, f32x16 (&O)[4], SoftState& st, int lane,
                                           float cs, bool far, float bconst, int dq, unsigned W, bool okq, const LAS float* btab, bf16x8 (&pf)[4]) {
    const int r = lane & 31, h = lane >> 5;
    const LAS unsigned char* Kl = lds + A_K0 + buf * A_KBUF + r * A_KP + kcol + h * 16;
    f32x16 s0, s1;
#pragma unroll
    for (int i = 0; i < 16; ++i) { s0[i] = 0.f; s1[i] = 0.f; }
#pragma unroll
    for (int ks = 0; ks < NKS; ++ks) {
        const bf16x8 k0 = *(const LAS bf16x8*)(Kl + ks * 32);
        const bf16x8 k1 = *(const LAS bf16x8*)(Kl + 32 * A_KP + ks * 32);
        const bf16x8 qv = *(const LAS bf16x8*)(qf + ks * 1024);
        s0 = __builtin_amdgcn_mfma_f32_32x32x16_bf16(k0, qv, s0, 0, 0, 0);
        s1 = __builtin_amdgcn_mfma_f32_32x32x16_bf16(k1, qv, s1, 0, 0, 0);
    }
    const float NEG = -__builtin_inff();
    float ps = 0.f, alpha;
    bool resc = false;
    if (far) {
        float rmax = fmaxf(s0[0], s1[0]);
#pragma unroll
        for (int i = 1; i < 16; ++i) rmax = fmaxf(rmax, fmaxf(s0[i], s1[i]));
        float tmax = okq ? fmaf(rmax, cs, bconst) : NEG;
        tmax = pmax32(tmax);
        float mn = st.m; alpha = 1.0f;
        if (!__all(tmax - mn <= ATT_THR)) { mn = fmaxf(st.m, tmax); alpha = __builtin_amdgcn_exp2f(st.m - mn); st.m = mn; resc = true; }
        const float off = okq ? bconst - mn : NEG;
#pragma unroll
        for (int i = 0; i < 16; ++i) { s0[i] = __builtin_amdgcn_exp2f(fmaf(s0[i], cs, off)); s1[i] = __builtin_amdgcn_exp2f(fmaf(s1[i], cs, off)); ps += s0[i] + s1[i]; }
    } else {
        float tmax = NEG;
#pragma unroll
        for (int i = 0; i < 16; ++i) {
            const int d0 = dq - ((i & 3) + 8 * (i >> 2));
            float b0 = 0.f;
            if (USE_BIAS) b0 = btab[min(max(d0, 0), 128)];
            s0[i] = (okq && (unsigned)d0 < W) ? fmaf(s0[i], cs, b0) : NEG;
            tmax = fmaxf(tmax, s0[i]);
        }
        __builtin_amdgcn_sched_barrier(0);
#pragma unroll
        for (int i = 0; i < 16; ++i) {
            const int d1 = dq - ((i & 3) + 8 * (i >> 2)) - 32;
            float b1 = 0.f;
            if (USE_BIAS) b1 = btab[min(max(d1, 0), 128)];
            s1[i] = (okq && (unsigned)d1 < W) ? fmaf(s1[i], cs, b1) : NEG;
            tmax = fmaxf(tmax, s1[i]);
        }
        tmax = pmax32(tmax);
        float mn = st.m; alpha = 1.0f;
        if (!__all(tmax - mn <= ATT_THR)) { mn = fmaxf(st.m, tmax); alpha = __builtin_amdgcn_exp2f(st.m - mn); st.m = mn; resc = true; }
#pragma unroll
        for (int i = 0; i < 16; ++i) { s0[i] = __builtin_amdgcn_exp2f(s0[i] - mn); s1[i] = __builtin_amdgcn_exp2f(s1[i] - mn); ps += s0[i] + s1[i]; }
    }
    st.l = st.l * alpha + ps;
    if (resc) {
#pragma unroll
        for (int db = 0; db < 4; ++db)
#pragma unroll
            for (int i = 0; i < 16; ++i) O[db][i] *= alpha;
    }
    u32x4 w;
    w.x = cvt_pk_bf16(s0[0], s0[1]); w.y = cvt_pk_bf16(s0[2], s0[3]); w.z = cvt_pk_bf16(s0[4], s0[5]); w.w = cvt_pk_bf16(s0[6], s0[7]); pf[0] = __builtin_bit_cast(bf16x8, w);
    w.x = cvt_pk_bf16(s0[8], s0[9]); w.y = cvt_pk_bf16(s0[10], s0[11]); w.z = cvt_pk_bf16(s0[12], s0[13]); w.w = cvt_pk_bf16(s0[14], s0[15]); pf[1] = __builtin_bit_cast(bf16x8, w);
    w.x = cvt_pk_bf16(s1[0], s1[1]); w.y = cvt_pk_bf16(s1[2], s1[3]); w.z = cvt_pk_bf16(s1[4], s1[5]); w.w = cvt_pk_bf16(s1[6], s1[7]); pf[2] = __builtin_bit_cast(bf16x8, w);
    w.x = cvt_pk_bf16(s1[8], s1[9]); w.y = cvt_pk_bf16(s1[10], s1[11]); w.z = cvt_pk_bf16(s1[12], s1[13]); w.w = cvt_pk_bf16(s1[14], s1[15]); pf[3] = __builtin_bit_cast(bf16x8, w);
}
template <int NKS>
__device__ __forceinline__ void attn_qk_only(LAS unsigned char* lds, int buf, int kcol, const LAS unsigned char* qf, f32x16 (&O)[4], int lane, bf16x8 (&pf)[4]) {
    const int r = lane & 31, h = lane >> 5;
    const LAS unsigned char* Kl = lds + A_K0 + buf * A_KBUF + r * A_KP + kcol + h * 16;
    f32x16 s0, s1;
#pragma unroll
    for (int i = 0; i < 16; ++i) { s0[i] = 0.f; s1[i] = 0.f; }
#pragma unroll
    for (int ks = 0; ks < NKS; ++ks) {
        const bf16x8 k0 = *(const LAS bf16x8*)(Kl + ks * 32);
        const bf16x8 k1 = *(const LAS bf16x8*)(Kl + 32 * A_KP + ks * 32);
        const bf16x8 qv = *(const LAS bf16x8*)(qf + ks * 1024);
        s0 = __builtin_amdgcn_mfma_f32_32x32x16_bf16(k0, qv, s0, 0, 0, 0);
        s1 = __builtin_amdgcn_mfma_f32_32x32x16_bf16(k1, qv, s1, 0, 0, 0);
    }
    u32x4 w;
    w.x = __float_as_uint(s0[0]); w.y = __float_as_uint(s0[5]); w.z = __float_as_uint(s0[10]); w.w = __float_as_uint(s0[15]); pf[0] = __builtin_bit_cast(bf16x8, w);
    w.x = __float_as_uint(s0[1]); w.y = __float_as_uint(s0[6]); w.z = __float_as_uint(s0[11]); w.w = __float_as_uint(s0[12]); pf[1] = __builtin_bit_cast(bf16x8, w);
    w.x = __float_as_uint(s1[0]); w.y = __float_as_uint(s1[5]); w.z = __float_as_uint(s1[10]); w.w = __float_as_uint(s1[15]); pf[2] = __builtin_bit_cast(bf16x8, w);
    w.x = __float_as_uint(s1[1]); w.y = __float_as_uint(s1[6]); w.z = __float_as_uint(s1[11]); w.w = __float_as_uint(s1[12]); pf[3] = __builtin_bit_cast(bf16x8, w);
}
__device__ __forceinline__ void attn_pv(LAS unsigned char* lds, int buf, const bf16x8 (&pf)[4], f32x16 (&O)[4], int lane) {
    const int r = lane & 31, h = lane >> 5;
    const LAS unsigned char* Vl = lds + A_V0 + buf * A_VBUF + r * A_VP + h * 16;
    constexpr int PD = 8;
    bf16x8 vq[16];
#pragma unroll
    for (int i = 0; i < PD; ++i) vq[i] = *(const LAS bf16x8*)(Vl + (i >> 2) * 32 * A_VP + (i & 3) * 32);
#pragma unroll
    for (int idx = 0; idx < 16; ++idx) {
        if (idx + PD < 16) vq[idx + PD] = *(const LAS bf16x8*)(Vl + ((idx + PD) >> 2) * 32 * A_VP + ((idx + PD) & 3) * 32);
        O[idx >> 2] = __builtin_amdgcn_mfma_f32_32x32x16_bf16(vq[idx], pf[idx & 3], O[idx >> 2], 0, 0, 0);
    }
}

template <int NKS>
__device__ __forceinline__ void attn_tile_stats(LAS unsigned char* lds, int buf, const LAS unsigned char* qf, SoftState& st, int lane, float cs, int dq) {
    const int r = lane & 31, h = lane >> 5;
    const LAS unsigned char* Kl = lds + A_K0 + buf * A_KBUF + r * A_KP + h * 16;
    f32x16 s0, s1;
#pragma unroll
    for (int i = 0; i < 16; ++i) { s0[i] = 0.f; s1[i] = 0.f; }
#pragma unroll
    for (int ks = 0; ks < NKS; ++ks) {
        const bf16x8 k0 = *(const LAS bf16x8*)(Kl + ks * 32);
        const bf16x8 k1 = *(const LAS bf16x8*)(Kl + 32 * A_KP + ks * 32);
        const bf16x8 qv = *(const LAS bf16x8*)(qf + ks * 1024);
        s0 = __builtin_amdgcn_mfma_f32_32x32x16_bf16(k0, qv, s0, 0, 0, 0);
        s1 = __builtin_amdgcn_mfma_f32_32x32x16_bf16(k1, qv, s1, 0, 0, 0);
    }
    const float NEG = -__builtin_inff();
    float tmax = NEG;
#pragma unroll
    for (int i = 0; i < 16; ++i) {
        const int c0 = (i & 3) + 8 * (i >> 2);
        s0[i] = (dq - c0 >= 0) ? s0[i] * cs : NEG; s1[i] = (dq - c0 - 32 >= 0) ? s1[i] * cs : NEG;
        tmax = fmaxf(tmax, fmaxf(s0[i], s1[i]));
    }
    tmax = pmax32(tmax);
    const float mn = fmaxf(st.m, tmax);
    const float alpha = __builtin_amdgcn_exp2f(st.m - mn);
    st.m = mn;
    float ps = 0.f;
#pragma unroll
    for (int i = 0; i < 16; ++i) ps += __builtin_amdgcn_exp2f(s0[i] - mn) + __builtin_amdgcn_exp2f(s1[i] - mn);
    st.l = st.l * alpha + ps;
}

template <int NKS>
__device__ __forceinline__ const LAS unsigned char* load_qfrags(const Ctx& c, const bf16_t* qrow0, int pitch_elems) {
    const int lane = c.lane;
    const bf16_t* pq = qrow0 + (size_t)(lane & 31) * pitch_elems + (lane >> 5) * 8;
    LAS unsigned char* dst = c.lds + A_Q + c.wave * 8192 + lane * 16;
#pragma unroll
    for (int ks = 0; ks < NKS; ++ks) *(LAS bf16x8*)(dst + ks * 1024) = gld<bf16x8>(pq + ks * 16);
    return dst;
}

__device__ __forceinline__ void store_o_bf16(const f32x16 (&O)[4], float scale, bf16_t* orow, int lane) {
    const int h = lane >> 5;
#pragma unroll
    for (int db = 0; db < 4; ++db)
#pragma unroll
        for (int g = 0; g < 4; ++g) {
            u32x2 w; w.x = cvt_pk_bf16(O[db][4 * g] * scale, O[db][4 * g + 1] * scale); w.y = cvt_pk_bf16(O[db][4 * g + 2] * scale, O[db][4 * g + 3] * scale);
            gst<u32x2>(orow + db * 32 + g * 8 + h * 4, w);
        }
}

__device__ __forceinline__ int next_item(const Ctx& c, int q) {
    volatile LAS int* slot = (volatile LAS int*)(c.lds + LDS_MISC + 64);
    __syncthreads();
    if (c.tid == 0) *slot = (int)__hip_atomic_fetch_add(c.ctl + CWQ(q), 1u, __ATOMIC_RELAXED, __HIP_MEMORY_SCOPE_AGENT);
    __syncthreads();
    return *slot;
}

#define ATTN_LOOP_BEGIN(ntiles, src)                                                          \
    {   TileRegs tr_;                                                                          \
        const volatile LAS int* tl_ = (const volatile LAS int*)(c.lds + A_TLIST);              \
        const int nt_ = (ntiles);                                                              \
        if (nt_ > 0) { tile_load(tr_, (src), tl_[0], c.tid); tile_store(tr_, c.lds, 0, c.tid); } \
        __syncthreads();                                                                       \
        for (int ti_ = 0; ti_ < nt_; ++ti_) {                                                  \
            const int buf_ = ti_ & 1; const int key0 = tl_[ti_];                               \
            if (ti_ + 1 < nt_) tile_load(tr_, (src), tl_[ti_ + 1], c.tid);
#define ATTN_LOOP_END()                                                                        \
            if (ti_ + 1 < nt_) tile_store(tr_, c.lds, buf_ ^ 1, c.tid);                        \
            __syncthreads();                                                                   \
        }                                                                                      \
    }
#ifndef ATTN_STAGGER
#define ATTN_STAGGER 0
#endif
#if ATTN_STAGGER
#define ATTN_LOOP2(ntiles, src)                                                                \
    {   TileRegs tr_;                                                                          \
        const volatile LAS int* tl_ = (const volatile LAS int*)(c.lds + A_TLIST);              \
        const int nt_ = (ntiles);                                                              \
        bf16x8 pf_[4]; bool hasp_ = false;                                                     \
        if (nt_ > 0) { tile_load(tr_, (src), tl_[0], c.tid); tile_store(tr_, c.lds, 0, c.tid); } \
        __syncthreads();                                                                       \
        if ((c.wave >> 2) == 0) {                                                              \
            for (int ti_ = 0; ti_ < nt_; ++ti_) {                                              \
                const int buf_ = ti_ & 1; const int key0 = tl_[ti_];                           \
                if (ti_ + 1 < nt_) tile_load(tr_, (src), tl_[ti_ + 1], c.tid);                 \
                hasp_ = false;                                                                 \
                { ATTN_QKSM }                                                                  \
                __syncthreads();                                                               \
                if (hasp_) attn_pv(c.lds, buf_, pf_, O, lane);                                 \
                if (ti_ + 1 < nt_) tile_store(tr_, c.lds, buf_ ^ 1, c.tid);                    \
                __syncthreads();                                                               \
            }                                                                                  \
            __syncthreads();                                                                   \
        } else {                                                                               \
            for (int ti_ = 0; ti_ < nt_; ++ti_) {                                              \
                const int buf_ = ti_ & 1; const int key0 = tl_[ti_];                           \
                if (ti_ + 1 < nt_) tile_load(tr_, (src), tl_[ti_ + 1], c.tid);                 \
                if (hasp_) attn_pv(c.lds, buf_ ^ 1, pf_, O, lane);                             \
                __syncthreads();                                                               \
                hasp_ = false;                                                                 \
                { ATTN_QKSM }                                                                  \
                if (ti_ + 1 < nt_) tile_store(tr_, c.lds, buf_ ^ 1, c.tid);                    \
                __syncthreads();                                                               \
            }                                                                                  \
            if (hasp_) attn_pv(c.lds, (nt_ - 1) & 1, pf_, O, lane);                            \
            __syncthreads();                                                                   \
        }                                                                                      \
    }
#else
#define ATTN_TL0 0
#define ATTN_LOOP2(ntiles, src)                                                                \
    {   TileRegs tr_;                                                                          \
        const volatile LAS int* tl_ = (const volatile LAS int*)(c.lds + A_TLIST) + (ATTN_TL0); \
        const int nt_ = (ntiles);                                                              \
        bf16x8 pf_[4]; bool hasp_ = false;                                                     \
        if (nt_ > 0) { tile_load(tr_, (src), tl_[0], c.tid); tile_store(tr_, c.lds, 0, c.tid); } \
        __syncthreads();                                                                       \
        for (int ti_ = 0; ti_ < nt_; ++ti_) {                                                  \
            const int buf_ = ti_ & 1; const int key0 = tl_[ti_];                               \
            if (ti_ + 1 < nt_) tile_load(tr_, (src), tl_[ti_ + 1], c.tid);                     \
            hasp_ = false;                                                                     \
            { ATTN_QKSM }                                                                      \
            if (ti_ + 1 < nt_) tile_store(tr_, c.lds, buf_ ^ 1, c.tid);                        \
            if (hasp_) attn_pv(c.lds, buf_, pf_, O, lane);                                     \
            __syncthreads();                                                                   \
        }                                                                                      \
    }
#endif


__device__ __forceinline__ void tile_load_k(TileRegs& r, const TileSrc& s, int key0, int tid) {
#pragma unroll
    for (int i = 0; i < 2; ++i) { const int ck = tid + 512 * i; r.k[i] = gld<u32x4>(s.kbase + (size_t)(key0 + (ck >> 4)) * s.kpitch + (ck & 15) * 16); }
}
__device__ __forceinline__ void tile_load_v(TileRegs& r, const TileSrc& s, int key0, int tid) {
#pragma unroll
    for (int i = 0; i < 2; ++i) { const int ck = tid + 512 * i; r.v[i] = gld<u32x4>(s.vbase + (size_t)(ck >> 3) * s.vpitch + (size_t)key0 * 2 + (ck & 7) * 16); }
}
__device__ __forceinline__ void tile_store_k(const TileRegs& r, LAS unsigned char* lds, int buf, int tid) {
#pragma unroll
    for (int i = 0; i < 2; ++i) { const int ck = tid + 512 * i; *(LAS u32x4*)(lds + A_K0 + buf * A_KBUF + (ck >> 4) * A_KP + (ck & 15) * 16) = r.k[i]; }
}
__device__ __forceinline__ void tile_store_v(const TileRegs& r, LAS unsigned char* lds, int buf, int tid) {
#pragma unroll
    for (int i = 0; i < 2; ++i) {
        const int ck = tid + 512 * i;
        LAS unsigned char* vp = lds + A_V0 + buf * A_VBUF + (ck >> 3) * A_VP + ((ck & 7) >> 1) * 32 + (ck & 1) * 8;
        *(LAS u32x2*)(vp) = (u32x2){r.v[i].x, r.v[i].y};
        *(LAS u32x2*)(vp + 16) = (u32x2){r.v[i].z, r.v[i].w};
    }
}
typedef float f2v_t __attribute__((ext_vector_type(2)));
__device__ __forceinline__ unsigned cvt_pk_bf16x(float lo, float hi) { f2v_t f; f.x = lo; f.y = hi; const bf2_t v = __builtin_convertvector(f, bf2_t); return __builtin_bit_cast(unsigned, v); }
template <int NKS>
__device__ __forceinline__ void attf_qk(LAS unsigned char* lds, int buf, int kcol, const LAS unsigned char* qf, int lane, f32x16& s0, f32x16& s1) {
    const int r = lane & 31, h = lane >> 5;
    const LAS unsigned char* Kl = lds + A_K0 + buf * A_KBUF + r * A_KP + kcol + h * 16;
#pragma unroll
    for (int i = 0; i < 16; ++i) { s0[i] = 0.f; s1[i] = 0.f; }
#pragma unroll
    for (int ks = 0; ks < NKS; ++ks) {
        const bf16x8 k0 = *(const LAS bf16x8*)(Kl + ks * 32);
        const bf16x8 k1 = *(const LAS bf16x8*)(Kl + 32 * A_KP + ks * 32);
        const bf16x8 qv = *(const LAS bf16x8*)(qf + ks * 1024);
        s0 = __builtin_amdgcn_mfma_f32_32x32x16_bf16(k0, qv, s0, 0, 0, 0);
        s1 = __builtin_amdgcn_mfma_f32_32x32x16_bf16(k1, qv, s1, 0, 0, 0);
    }
}
__device__ __forceinline__ void attf_p1(const f32x16& s0, const f32x16& s1, f32x16 (&O)[4], SoftState& st, float& off, float cs, float bconst, bool okq) {
    const float NEG = -__builtin_inff();
    float rmax = fmaxf(s0[0], s1[0]);
#pragma unroll
    for (int i = 1; i < 16; ++i) rmax = fmaxf(rmax, fmaxf(s0[i], s1[i]));
    float tmax = okq ? fmaf(rmax, cs, bconst) : NEG;
    tmax = pmax32(tmax);
    float mn = st.m;
    if (!__all(tmax - mn <= ATT_THR)) {
        mn = fmaxf(st.m, tmax);
        const float alpha = __builtin_amdgcn_exp2f(st.m - mn);
        st.m = mn; st.l *= alpha;
#pragma unroll
        for (int db = 0; db < 4; ++db)
#pragma unroll
            for (int i = 0; i < 16; ++i) O[db][i] *= alpha;
    }
    off = okq ? bconst - mn : NEG;
}
__device__ __forceinline__ void attf_fin(const f32x16& s0, const f32x16& s1, SoftState& st, float cs, float off, bf16x8 (&pf)[4]) {
    float ps = 0.f;
    unsigned pw[16];
#pragma unroll
    for (int i = 0; i < 8; ++i) {
        const float a0 = __builtin_amdgcn_exp2f(fmaf(s0[2 * i], cs, off)), a1 = __builtin_amdgcn_exp2f(fmaf(s0[2 * i + 1], cs, off));
        const float b0 = __builtin_amdgcn_exp2f(fmaf(s1[2 * i], cs, off)), b1 = __builtin_amdgcn_exp2f(fmaf(s1[2 * i + 1], cs, off));
        ps += (a0 + a1) + (b0 + b1);
        pw[i] = cvt_pk_bf16x(a0, a1); pw[8 + i] = cvt_pk_bf16x(b0, b1);
    }
    st.l += ps;
#pragma unroll
    for (int f = 0; f < 4; ++f) { u32x4 w; w.x = pw[4 * f]; w.y = pw[4 * f + 1]; w.z = pw[4 * f + 2]; w.w = pw[4 * f + 3]; pf[f] = __builtin_bit_cast(bf16x8, w); }
}
#define ATTF_SBAR __builtin_amdgcn_sched_barrier(0)
#define ATTF_STAGE(SRC)                                                                         \
        if (j_ + 1 < nt_) tile_store_k(tr_, c.lds, buf_ ^ 1, c.tid);                            \
        tile_store_v(tr_, c.lds, buf_, c.tid);                                                  \
        if (j_ + 2 < nt_) tile_load_k(tr_, (SRC), tl_[j_ + 2], c.tid);                          \
        if (j_ + 1 < nt_) tile_load_v(tr_, (SRC), tl_[j_ + 1], c.tid);
#define ATTF_STEP(J, N, P, SRC)                                                                 \
    {   const int j_ = (J); const int key0 = tl_[j_]; const int buf_ = j_ & 1;                  \
        ATTF_STAGE(SRC)                                                                         \
        ATTF_SBAR; ATTF_QK(s##N##0_, s##N##1_); attf_fin(s##P##0_, s##P##1_, st, ATTF_CS, off##P##_, pf_); ATTF_SBAR; \
        attn_pv(c.lds, buf_ ^ 1, pf_, O, lane); attf_p1(s##N##0_, s##N##1_, O, st, off##N##_, ATTF_CS, bconst, (ATTF_OKQ)); ATTF_SBAR; \
        __syncthreads();                                                                        \
    }
#define ATTN_LOOPF(ntiles, src)                                                                \
    {   TileRegs tr_;                                                                          \
        const volatile LAS int* tl_ = (const volatile LAS int*)(c.lds + A_TLIST);              \
        const int nt_ = (ntiles);                                                              \
        if (nt_ > 0) {                                                                         \
            bf16x8 pf_[4]; f32x16 sA0_, sA1_, sB0_, sB1_; float offA_, offB_;                  \
            tile_load_k(tr_, (src), tl_[0], c.tid); tile_store_k(tr_, c.lds, 0, c.tid);        \
            if (nt_ > 1) tile_load_k(tr_, (src), tl_[1], c.tid);                               \
            tile_load_v(tr_, (src), tl_[0], c.tid);                                            \
            __syncthreads();                                                                   \
            {   const int j_ = 0; const int key0 = tl_[0]; const int buf_ = 0;                 \
                ATTF_STAGE(src)                                                                \
                ATTF_QK(sA0_, sA1_); attf_p1(sA0_, sA1_, O, st, offA_, ATTF_CS, bconst, (ATTF_OKQ)); \
                __syncthreads();                                                               \
            }                                                                                  \
            int jj_ = 1;                                                                       \
            for (; jj_ + 1 < nt_; jj_ += 2) { ATTF_STEP(jj_, B, A, src) ATTF_STEP(jj_ + 1, A, B, src) } \
            if (jj_ < nt_) {                                                                   \
                ATTF_STEP(jj_, B, A, src)                                                      \
                attf_fin(sB0_, sB1_, st, ATTF_CS, offB_, pf_); attn_pv(c.lds, (nt_ - 1) & 1, pf_, O, lane); \
            } else {                                                                           \
                attf_fin(sA0_, sA1_, st, ATTF_CS, offA_, pf_); attn_pv(c.lds, (nt_ - 1) & 1, pf_, O, lane); \
            }                                                                                  \
            __syncthreads();                                                                   \
        }                                                                                      \
    }

__device__ __forceinline__ void phase_prep(const Ctx& c, const Params& p, int l) {
    unsigned char* ws = p.ws;
    const bf16_t* PROJ = (const bf16_t*)(ws + WS_PROJ);
    const int gw = c.bid * 8 + c.wave, nw = c.G * 8, lane = c.lane;
    for (int it = c.bid; it < 256; it += c.G) {
        const int bh = it >> 4, blk = it & 15, b = bh >> 2, hh = bh & 3;
        const bf16_t* src = PROJ + (size_t)(b * SEQ + blk * 256 + c.wave * 32 + (lane >> 4)) * N1 + C_MK + hh * 128 + (lane & 15) * 8;
        float s8[8];
#pragma unroll
        for (int i = 0; i < 8; ++i) s8[i] = 0.f;
#pragma unroll
        for (int k = 0; k < 8; ++k) {
            const u32x4 v = gld<u32x4>(src + (size_t)k * 4 * N1);
            s8[0] += bf_lo(v.x); s8[1] += bf_hi(v.x); s8[2] += bf_lo(v.y); s8[3] += bf_hi(v.y); s8[4] += bf_lo(v.z); s8[5] += bf_hi(v.z); s8[6] += bf_lo(v.w); s8[7] += bf_hi(v.w);
        }
#pragma unroll
        for (int i = 0; i < 8; ++i) { s8[i] += swz_xor<16>(s8[i]); s8[i] = psum32(s8[i]); }
        LAS float* red = (LAS float*)c.lds;
        __syncthreads();
        if (lane < 16) {
#pragma unroll
            for (int i = 0; i < 8; ++i) red[c.wave * 128 + lane * 8 + i] = s8[i];
        }
        __syncthreads();
        if (c.tid < 64) {
            float a0 = 0.f, a1 = 0.f;
#pragma unroll
            for (int w = 0; w < 8; ++w) { a0 += red[w * 128 + 2 * c.tid]; a1 += red[w * 128 + 2 * c.tid + 1]; }
            gst<unsigned>((bf16_t*)(ws + WS_KMEAN) + (size_t)it * 128 + 2 * c.tid, cvt_pk_bf16(a0 * (1.0f / 256.0f), a1 * (1.0f / 256.0f)));
        }
    }
    for (int it = c.bid; it < 256; it += c.G) {
        const int ep = it & 1, nt = (it >> 1) & 7, bg = (it >> 4) & 7, kv = it >> 7;
        const int b = bg >> 1, g = bg & 1;
        const int r = lane & 31, h = lane >> 5;
        const int et = ep * 2 + (c.wave & 1), kq = c.wave >> 1;
        int n = nt * 32 + r; if (n > 254) n = 254;
        const bf16_t* arow = PROJ + (size_t)(b * SEQ + 16 * n) * N1 + (kv ? C_VC : C_KC) + g * 128;
        const bf16_t* wrow = (const bf16_t*)(ws + WS_WCT) + (((size_t)l * 2 + kv) * 128 + et * 32 + r) * 4096;
        f32x16 acc;
#pragma unroll
        for (int i = 0; i < 16; ++i) acc[i] = 0.f;
#pragma unroll 1
        for (int b8 = 0; b8 < 8; ++b8) {
            bf16x8 av[8], bw[8];
#pragma unroll
            for (int i = 0; i < 8; ++i) { const int k = (kq * 64 + b8 * 8 + i) * 16 + h * 8; av[i] = gld<bf16x8>(arow + (size_t)(k >> 7) * N1 + (k & 127)); bw[i] = gld<bf16x8>(wrow + k); }
            __builtin_amdgcn_sched_barrier(0);
#pragma unroll
            for (int i = 0; i < 8; ++i) acc = __builtin_amdgcn_mfma_f32_32x32x16_bf16(av[i], bw[i], acc, 0, 0, 0);
        }
        LAS float* red = (LAS float*)c.lds;
        __syncthreads();
        if (kq != 0) {
#pragma unroll
            for (int i = 0; i < 16; ++i) red[(c.wave * 16 + i) * 64 + lane] = acc[i];
        }
        __syncthreads();
        if (kq == 0) {
            const int e = et * 32 + r;
            const float cb = ((const float*)(ws + WS_CB))[(l * 2 + kv) * 128 + e];
#pragma unroll
            for (int i = 0; i < 16; ++i) acc[i] += cb + (red[((c.wave + 2) * 16 + i) * 64 + lane] + red[((c.wave + 4) * 16 + i) * 64 + lane]) + red[((c.wave + 6) * 16 + i) * 64 + lane];
            if (kv == 0) {
                bf16_t* dst = (bf16_t*)(ws + WS_KCMP) + (size_t)bg * 256 * 128;
#pragma unroll
                for (int i = 0; i < 16; ++i) {
                    const int nn = nt * 32 + (i & 3) + 8 * (i >> 2) + 4 * h;
                    dst[(size_t)nn * 128 + e] = nn < 255 ? (bf16_t)(cvt_pk_bf16(acc[i], 0.f) & 0xffffu) : (bf16_t)0;
                }
            } else {
                bf16_t* dst = (bf16_t*)(ws + WS_VCMPT) + (size_t)bg * 128 * 256 + (size_t)e * 256;
#pragma unroll
                for (int g4 = 0; g4 < 4; ++g4) {
                    const int nn = nt * 32 + 8 * g4 + 4 * h;
                    u32x2 w; w.x = cvt_pk_bf16(acc[4 * g4], acc[4 * g4 + 1]); w.y = cvt_pk_bf16(acc[4 * g4 + 2], nn + 3 < 255 ? acc[4 * g4 + 3] : 0.f);
                    gst<u32x2>(dst + nn, w);
                }
            }
        }
    }
}
#ifndef ATTF_DIFF
#define ATTF_DIFF 1
#endif
#ifndef ATTF_SEL
#define ATTF_SEL 1
#endif
#ifndef ATTF_MOBA
#define ATTF_MOBA 1
#endif
__device__ __forceinline__ unsigned wave_or(unsigned v) {
    v = por32(v); v |= swz_xor_u<16>(v); v |= swz_xor_u<8>(v); v |= swz_xor_u<4>(v); v |= swz_xor_u<2>(v); v |= swz_xor_u<1>(v);
    return (unsigned)__builtin_amdgcn_readfirstlane((int)v);
}
__device__ __forceinline__ float sigmoidf_(float x) { return 1.0f / (1.0f + __expf(-x)); }
__device__ __forceinline__ void zero_o(f32x16 (&O)[4]) {
#pragma unroll
    for (int db = 0; db < 4; ++db)
#pragma unroll
        for (int i = 0; i < 16; ++i) O[db][i] = 0.f;
}
__device__ __forceinline__ void load_bias_tab(const Ctx& c, const Params& p, int head0, int nheads) {
    LAS float* bt = (LAS float*)(c.lds + A_BIAS);
    const float* src = (const float*)(p.ws + WS_BIAS) + head0 * 132;
    for (int i = c.tid; i < nheads * 132; i += 512) bt[i] = src[i];
}

__device__ __forceinline__ void item_moba(const Ctx& c0, const Params& p, int b, int hh, int own) {
    Ctx c = c0; asm volatile("" : "+v"(c.tid), "+v"(c.lane));
    unsigned char* ws = p.ws;
    const bf16_t* PROJ = (const bf16_t*)(ws + WS_PROJ);
    const int lane = c.lane, r = lane & 31, h = lane >> 5, tok0 = b * SEQ;
    const int qw0 = own * 256 + 32 * c.wave, qpos = qw0 + r;
    volatile LAS unsigned* mw = (volatile LAS unsigned*)(c.lds + A_MISCW);
    volatile LAS int* tl = (volatile LAS int*)(c.lds + A_TLIST);
    if (c.tid == 0) mw[0] = 0u;
    load_bias_tab(c, p, hh, 1);
    const LAS unsigned char* qf = load_qfrags<8>(c, PROJ + (size_t)(tok0 + qw0) * N1 + C_MQ + hh * 128, N1);
    __syncthreads();
    unsigned sel = 0u;
    {
        const bf16_t* km = (const bf16_t*)(ws + WS_KMEAN) + ((size_t)(b * 4 + hh) * 16 + (r < 16 ? r : 15)) * 128 + h * 8;
        f32x16 gsc;
#pragma unroll
        for (int i = 0; i < 16; ++i) gsc[i] = 0.f;
        bf16x8 kmf[8];
#pragma unroll
        for (int ks = 0; ks < 8; ++ks) kmf[ks] = gld<bf16x8>(km + ks * 16);
        __builtin_amdgcn_sched_barrier(0);
#pragma unroll
        for (int ks = 0; ks < 8; ++ks) gsc = __builtin_amdgcn_mfma_f32_32x32x16_bf16(kmf[ks], *(const LAS bf16x8*)(qf + ks * 1024), gsc, 0, 0, 0);
        const float NEG = -__builtin_inff();
        float v[8];
#pragma unroll
        for (int i = 0; i < 8; ++i) {
            const int blk = (i & 3) + 8 * (i >> 2) + 4 * h;
            v[i] = blk < own ? __uint_as_float((__float_as_uint(gsc[i]) & ~15u) | (unsigned)(15 - blk)) : NEG;
        }
#pragma unroll
        for (int it = 0; it < 3; ++it) {
            float lm = v[0];
#pragma unroll
            for (int i = 1; i < 8; ++i) lm = fmaxf(lm, v[i]);
            const float pm = pmax32(lm);
            if (pm > NEG) sel |= 1u << (15u - (__float_as_uint(pm) & 15u));
#pragma unroll
            for (int i = 0; i < 8; ++i) v[i] = (v[i] == pm) ? NEG : v[i];
        }
    }
    const unsigned wsel = wave_or(sel);
    if (lane == 0 && wsel) __hip_atomic_fetch_or((LAS unsigned*)(c.lds + A_MISCW), wsel, __ATOMIC_RELAXED, __HIP_MEMORY_SCOPE_WORKGROUP);
    __syncthreads();
    const unsigned bsel = mw[0];
    if (c.tid == 0) {
        int n = 0;
        for (int j = 0; j < own; ++j) if ((bsel >> j) & 1u) { for (int t = 0; t < 4; ++t) tl[n++] = j * 256 + t * 64; }
        for (int t = 0; t < 4; ++t) tl[n++] = own * 256 + t * 64;
        mw[1] = (unsigned)n;
        mw[2] = (unsigned)(n - 4 - ((own >= 1 && ((bsel >> (own - 1)) & 1u)) ? 2 : 0));
    }
    __syncthreads();
    const int ntiles = (int)mw[1];
    const int nfar = ATTF_MOBA ? (int)mw[2] : 0;
    TileSrc src;
    src.kbase = (const unsigned char*)(PROJ + (size_t)tok0 * N1 + C_MK + hh * 128); src.kpitch = N1 * 2;
    src.vbase = (const unsigned char*)((const bf16_t*)(ws + WS_VT) + (size_t)(R_MV + hh * 128) * T_TOK + tok0); src.vpitch = T_TOK * 2;
    f32x16 O[4]; zero_o(O);
    SoftState st; st.m = -1e30f; st.l = 0.f;
    const LAS float* bt = (const LAS float*)(c.lds + A_BIAS);
    const float bconst = bt[128];
#define ATTN_QKSM \
        const int blk = key0 >> 8; \
        const bool past = blk < own; \
        const bool need = past ? (((wsel >> blk) & 1u) != 0u) : (key0 <= qw0 + 31); \
        if (need) { \
            const bool okq = past ? (((sel >> blk) & 1u) != 0u) : true; \
            const bool far = (qw0 - (key0 + 63)) >= 128; \
            attn_qk_sm<8, true>(c.lds, buf_, 0, qf, O, st, lane, ATT_C128, far, bconst, qpos - key0 - 4 * h, 0x80000000u, okq, bt, pf_); \
            hasp_ = true; \
        }
#if ATTF_MOBA
#define ATTF_QK(S0, S1) attf_qk<8>(c.lds, buf_, 0, qf, lane, S0, S1)
#define ATTF_OKQ (((sel >> (key0 >> 8)) & 1u) != 0u)
#define ATTF_CS ATT_C128
    ATTN_LOOPF(nfar, src)
#undef ATTF_QK
#undef ATTF_OKQ
#undef ATTF_CS
#undef ATTN_TL0
#define ATTN_TL0 nfar
    ATTN_LOOP2(ntiles - nfar, src)
#undef ATTN_TL0
#define ATTN_TL0 0
#else
    ATTN_LOOP2(ntiles, src)
#endif
#undef ATTN_QKSM
    const float lt = psum32(st.l);
    const float inv = lt > 0.f ? 1.0f / lt : 0.f;
#ifdef ABL_MOBA
    store_o_bf16(O, 0.f, (bf16_t*)(ws + WS_OMIX) + (size_t)(tok0 + qpos) * DM + hh * 128, lane);
#else
    store_o_bf16(O, inv, (bf16_t*)(ws + WS_OMIX) + (size_t)(tok0 + qpos) * DM + hh * 128, lane);
#endif
}

template <int XM>
__device__ __forceinline__ void item_diff(const Ctx& c0, const Params& p, int l, int b, int hh, int qb) {
    Ctx c = c0; asm volatile("" : "+v"(c.tid), "+v"(c.lane));
    unsigned char* ws = p.ws;
    const bf16_t* PROJ = (const bf16_t*)(ws + WS_PROJ);
    const int lane = c.lane, r = lane & 31, h = lane >> 5, tok0 = b * SEQ;
    const int map = c.wave >> 2, sub = c.wave & 3;
    const int qw0 = qb * 128 + 32 * sub, qpos = qw0 + r;
    volatile LAS int* tl = (volatile LAS int*)(c.lds + A_TLIST);
    const int ntiles = 2 * qb + 2;
    for (int i = c.tid; i < ntiles; i += 512) tl[i] = i * 64;
    load_bias_tab(c, p, 4 + hh, 1);
    const LAS unsigned char* qf = load_qfrags<4>(c, PROJ + (size_t)(tok0 + qw0) * N1 + C_DQ + hh * 128 + map * 64, N1);
    TileSrc src;
    src.kbase = (const unsigned char*)(PROJ + (size_t)tok0 * N1 + C_DK + hh * 128); src.kpitch = N1 * 2;
    src.vbase = (const unsigned char*)((const bf16_t*)(ws + WS_VT) + (size_t)(R_DV + hh * 128) * T_TOK + tok0); src.vpitch = T_TOK * 2;
    f32x16 O[4]; zero_o(O);
    SoftState st; st.m = -1e30f; st.l = 0.f;
    const LAS float* bt = (const LAS float*)(c.lds + A_BIAS);
    __syncthreads();
    const float bconst = bt[128];
#define ATTN_QKSM \
        if (XM != 3 && key0 <= qw0 + 31) { \
            const bool far = (qw0 - (key0 + 63)) >= 128; \
            if (XM == 4) attn_qk_only<4>(c.lds, buf_, map * 128, qf, O, lane, pf_); \
            else attn_qk_sm<4, true>(c.lds, buf_, map * 128, qf, O, st, lane, ATT_C64, far, bconst, qpos - key0 - 4 * h, 0x80000000u, true, bt, pf_); \
            hasp_ = (XM != 2); \
        }
#if ATTF_DIFF
    const int nfar = qb >= 1 ? 2 * qb - 2 : 0;
#define ATTF_QK(S0, S1) attf_qk<4>(c.lds, buf_, map * 128, qf, lane, S0, S1)
#define ATTF_OKQ true
#define ATTF_CS ATT_C64
    ATTN_LOOPF(nfar, src)
#undef ATTF_QK
#undef ATTF_OKQ
#undef ATTF_CS
#undef ATTN_TL0
#define ATTN_TL0 nfar
    ATTN_LOOP2(ntiles - nfar, src)
#undef ATTN_TL0
#define ATTN_TL0 0
#else
    ATTN_LOOP2(ntiles, src)
#endif
#undef ATTN_QKSM
    const float lt = psum32(st.l);
    const float inv = lt > 0.f ? 1.0f / lt : 0.f;
    LAS float* ex = (LAS float*)c.lds;
    if (map == 1) {
#pragma unroll
        for (int db = 0; db < 4; ++db)
#pragma unroll
            for (int g = 0; g < 4; ++g)
                *(LAS f32x4*)(ex + (sub * 32 + r) * 132 + db * 32 + g * 8 + h * 4) = (f32x4){O[db][4 * g] * inv, O[db][4 * g + 1] * inv, O[db][4 * g + 2] * inv, O[db][4 * g + 3] * inv};
    }
    __syncthreads();
    if (map == 0) {
        const float lam = ((const float*)(ws + WS_LAM))[l];
        const float lam_init = 0.8f - 0.6f * expf(-0.3f * (float)l);
        float ss = 0.f;
#pragma unroll
        for (int db = 0; db < 4; ++db)
#pragma unroll
            for (int g = 0; g < 4; ++g) {
                const f32x4 o2 = *(const LAS f32x4*)(ex + (sub * 32 + r) * 132 + db * 32 + g * 8 + h * 4);
#pragma unroll
                for (int j = 0; j < 4; ++j) { const float o = O[db][4 * g + j] * inv - lam * o2[j]; O[db][4 * g + j] = o; ss += o * o; }
            }
        ss = psum32(ss);
#ifdef ABL_DIFF
        const float rr = 0.f;
#else
        const float rr = rsqrtf(ss * (1.0f / 128.0f) + 1e-5f) * (1.0f - lam_init);
#endif
        const float* sg = p.diff_subln + (size_t)l * 128;
        bf16_t* orow = (bf16_t*)(ws + (XM ? WS_OC : WS_OMIX)) + (size_t)(tok0 + qpos) * DM + 512 + hh * 128;
#pragma unroll
        for (int db = 0; db < 4; ++db)
#pragma unroll
            for (int g = 0; g < 4; ++g) {
                const int d = db * 32 + g * 8 + h * 4;
                const f32x4 gg = gld<f32x4>(sg + d);
                u32x2 w; w.x = cvt_pk_bf16(O[db][4 * g] * rr * gg[0], O[db][4 * g + 1] * rr * gg[1]); w.y = cvt_pk_bf16(O[db][4 * g + 2] * rr * gg[2], O[db][4 * g + 3] * rr * gg[3]);
                gst<u32x2>(orow + d, w);
            }
    }
}

__device__ __forceinline__ void item_nsa_win(const Ctx& c0, const Params& p, int b, int g, int qb) {
    Ctx c = c0; asm volatile("" : "+v"(c.tid), "+v"(c.lane));
    unsigned char* ws = p.ws;
    const bf16_t* PROJ = (const bf16_t*)(ws + WS_PROJ);
    const int lane = c.lane, r = lane & 31, h = lane >> 5, tok0 = b * SEQ;
    const int r4 = c.wave & 3, sub = c.wave >> 2, hn = g * 4 + r4;
    const int qw0 = qb * 64 + 32 * sub, qpos = qw0 + r;
    volatile LAS int* tl = (volatile LAS int*)(c.lds + A_TLIST);
    const int t_lo = qb >= 8 ? qb - 8 : 0, ntiles = qb - t_lo + 1;
    for (int i = c.tid; i < ntiles; i += 512) tl[i] = (t_lo + i) * 64;
    load_bias_tab(c, p, 8 + g * 4, 4);
    const LAS unsigned char* qf = load_qfrags<8>(c, PROJ + (size_t)(tok0 + qw0) * N1 + C_NQ + hn * 128, N1);
    TileSrc src;
    src.kbase = (const unsigned char*)(PROJ + (size_t)tok0 * N1 + C_KW + g * 128); src.kpitch = N1 * 2;
    src.vbase = (const unsigned char*)((const bf16_t*)(ws + WS_VT) + (size_t)(R_VW + g * 128) * T_TOK + tok0); src.vpitch = T_TOK * 2;
    f32x16 O[4]; zero_o(O);
    SoftState st; st.m = -1e30f; st.l = 0.f;
    const LAS float* bt = (const LAS float*)(c.lds + A_BIAS) + r4 * 132;
    __syncthreads();
    const float bconst = bt[128];
#define ATTN_QKSM \
        if (key0 <= qw0 + 31 && key0 + 63 >= qw0 - 511) { \
            const bool far = (qw0 - (key0 + 63)) >= 128 && (qw0 + 31 - key0) < 512; \
            attn_qk_sm<8, true>(c.lds, buf_, 0, qf, O, st, lane, ATT_C128, far, bconst, qpos - key0 - 4 * h, 512u, true, bt, pf_); \
            hasp_ = true; \
        }
    ATTN_LOOP2(ntiles, src)
#undef ATTN_QKSM
    const float lt = psum32(st.l);
    const float gate = sigmoidf_(bf_lo((unsigned)((const GAS bf16_t*)PROJ)[(size_t)(tok0 + qpos) * N1 + C_GATE + hn * 3 + 2]));
#ifdef ABL_WIN
    const float sc = 0.f;
#else
    const float sc = lt > 0.f ? gate / lt : 0.f;
#endif
    store_o_bf16(O, sc, (bf16_t*)(ws + WS_OW) + (size_t)(tok0 + qpos) * 1024 + hn * 128, lane);
}

__device__ __forceinline__ void item_nsa_cmp(const Ctx& c0, const Params& p, int b, int g, int qb) {
    Ctx c = c0; asm volatile("" : "+v"(c.tid), "+v"(c.lane));
    unsigned char* ws = p.ws;
    const bf16_t* PROJ = (const bf16_t*)(ws + WS_PROJ);
    const int lane = c.lane, r = lane & 31, h = lane >> 5, tok0 = b * SEQ, bg = b * 2 + g;
    const int r4 = c.wave & 3, sub = c.wave >> 2, hn = g * 4 + r4;
    const int qw0 = qb * 64 + 32 * sub, qpos = qw0 + r, ql = 32 * sub + r;
    volatile LAS int* tl = (volatile LAS int*)(c.lds + A_TLIST);
    LAS float* imp = (LAS float*)(c.lds + A_IMP);
    LAS unsigned* selm = (LAS unsigned*)(c.lds + A_SELM);
    const int nmax_blk = (qb * 64 + 63 - 31) >> 4;
    const int nt = (nmax_blk >> 6) + 1;
    for (int i = c.tid; i < nt; i += 512) tl[i] = i * 64;
    for (int i = c.tid; i < 64 * 65; i += 512) imp[i] = 0.f;
    for (int i = c.tid; i < 128; i += 512) selm[i] = 0u;
    const LAS unsigned char* qf = load_qfrags<8>(c, PROJ + (size_t)(tok0 + qw0) * N1 + C_NQ + hn * 128, N1);
    TileSrc src;
    src.kbase = ws + WS_KCMP + (size_t)bg * 256 * 128 * 2; src.kpitch = 256;
    src.vbase = ws + WS_VCMPT + (size_t)bg * 128 * 256 * 2; src.vpitch = 512;
    const int nmax_q = qpos >= 31 ? (qpos - 31) >> 4 : -1;
    const int nmax_w = (qw0 + 31) >= 31 ? (qw0 + 31 - 31) >> 4 : -1;
    f32x16 O[4]; zero_o(O);
    SoftState st; st.m = -1e30f; st.l = 0.f;
    float inv = 0.f;
    __syncthreads();
    ATTN_LOOP_BEGIN(nt, src)
        if (key0 <= nmax_w) attn_tile_stats<8>(c.lds, buf_, qf, st, lane, ATT_C128, nmax_q - key0 - 4 * h);
    ATTN_LOOP_END()
    {
        const float lt = psum32(st.l);
        inv = lt > 0.f ? 1.0f / lt : 0.f;
        st.l = 0.f;
    }
    ATTN_LOOP_BEGIN(nt, src)
        if (key0 <= nmax_w) {
            float gs[8], gl[8];
            attn_tile_p<8>(c.lds, buf_, qf, O, st, lane, ATT_C128, nmax_q - key0 - 4 * h, gs, gl);
#pragma unroll
            for (int kb = 0; kb < 2; ++kb)
#pragma unroll
                for (int gq = 0; gq < 4; ++gq) {
                    const int m = (key0 >> 2) + 8 * kb + 2 * gq + h;
                    __hip_atomic_fetch_add(imp + ql * 65 + m, gs[4 * kb + gq] * inv, __ATOMIC_RELAXED, __HIP_MEMORY_SCOPE_WORKGROUP);
                    __hip_atomic_fetch_add(imp + ql * 65 + m + 1, gl[4 * kb + gq] * inv, __ATOMIC_RELAXED, __HIP_MEMORY_SCOPE_WORKGROUP);
                }
        }
    ATTN_LOOP_END()
    {
        const float gate = sigmoidf_(bf_lo((unsigned)((const GAS bf16_t*)PROJ)[(size_t)(tok0 + qpos) * N1 + C_GATE + hn * 3 + 0]));
#ifdef ABL_CMP
        const float cscale = 0.f;
#else
        const float cscale = inv * gate;
#endif
        store_o_bf16(O, cscale, (bf16_t*)(ws + WS_OC) + (size_t)(tok0 + qpos) * 1024 + hn * 128, lane);
    }
    {
        const int own = qb, q = c.tid >> 3, part = c.tid & 7;
        unsigned lo = 0u, hi = 0u;
        if (own + 1 <= 16) {
            if (part == 0) { lo = own >= 31 ? 0xffffffffu : ((2u << own) - 1u); }
        } else {
            if (part == 0) { lo = 1u; const int a = own - 1; if (a < 32) lo |= 1u << a; else hi |= 1u << (a - 32); if (own < 32) lo |= 1u << own; else hi |= 1u << (own - 32); }
            const LAS float* iq = imp + q * 65;
            for (int mm = part * 8; mm < part * 8 + 8; ++mm) {
                if (mm >= 1 && mm <= own - 2) {
                    const float vme = iq[mm];
                    int rank = 0;
                    for (int m2 = 1; m2 <= own - 2; ++m2) { const float v2 = iq[m2]; rank += (v2 > vme || (v2 == vme && m2 < mm)) ? 1 : 0; }
                    if (rank < 13) { if (mm < 32) lo |= 1u << mm; else hi |= 1u << (mm - 32); }
                }
            }
        }
        if (lo) __hip_atomic_fetch_or(selm + q * 2, lo, __ATOMIC_RELAXED, __HIP_MEMORY_SCOPE_WORKGROUP);
        if (hi) __hip_atomic_fetch_or(selm + q * 2 + 1, hi, __ATOMIC_RELAXED, __HIP_MEMORY_SCOPE_WORKGROUP);
        __syncthreads();
        if (c.tid < 64) {
            const volatile LAS unsigned* sv = (const volatile LAS unsigned*)selm;
            u32x2 w; w.x = sv[c.tid * 2]; w.y = sv[c.tid * 2 + 1];
            gst<u32x2>(ws + WS_SELM + ((size_t)bg * SEQ + qb * 64 + c.tid) * 8, w);
        }
    }
}

__device__ __forceinline__ void item_nsa_sel(const Ctx& c0, const Params& p, int b, int g, int qb) {
    Ctx c = c0; asm volatile("" : "+v"(c.tid), "+v"(c.lane));
    unsigned char* ws = p.ws;
    const bf16_t* PROJ = (const bf16_t*)(ws + WS_PROJ);
    const int lane = c.lane, r = lane & 31, h = lane >> 5, tok0 = b * SEQ, bg = b * 2 + g;
    const int r4 = c.wave & 3, sub = c.wave >> 2, hn = g * 4 + r4;
    const int qw0 = qb * 64 + 32 * sub, qpos = qw0 + r;
    volatile LAS unsigned* mw = (volatile LAS unsigned*)(c.lds + A_MISCW);
    volatile LAS int* tl = (volatile LAS int*)(c.lds + A_TLIST);
    if (c.tid == 0) { mw[0] = 0u; mw[1] = 0u; }
    load_bias_tab(c, p, 8 + g * 4, 4);
    const u32x2 mq = gld<u32x2>(ws + WS_SELM + ((size_t)bg * SEQ + qpos) * 8);
    const unsigned wlo = wave_or(mq.x), whi = wave_or(mq.y);
    const LAS unsigned char* qf = load_qfrags<8>(c, PROJ + (size_t)(tok0 + qw0) * N1 + C_NQ + hn * 128, N1);
    __syncthreads();
    if (lane == 0) {
        if (wlo) __hip_atomic_fetch_or((LAS unsigned*)(c.lds + A_MISCW), wlo, __ATOMIC_RELAXED, __HIP_MEMORY_SCOPE_WORKGROUP);
        if (whi) __hip_atomic_fetch_or((LAS unsigned*)(c.lds + A_MISCW) + 1, whi, __ATOMIC_RELAXED, __HIP_MEMORY_SCOPE_WORKGROUP);
    }
    __syncthreads();
    if (c.tid == 0) {
        const unsigned blo = mw[0], bhi = mw[1];
        int n = 0, nf = 0;
        for (int m = 0; m <= qb; ++m) { const unsigned bit = m < 32 ? (blo >> m) & 1u : (bhi >> (m - 32)) & 1u; if (bit) { tl[n++] = m * 64; if (m <= qb - 3) nf = n; } }
        mw[2] = (unsigned)n; mw[3] = (unsigned)nf;
    }
    __syncthreads();
    const int ntiles = (int)mw[2];
    const int nfar = ATTF_SEL ? (int)mw[3] : 0;
    TileSrc src;
    src.kbase = (const unsigned char*)(PROJ + (size_t)tok0 * N1 + C_KS + g * 128); src.kpitch = N1 * 2;
    src.vbase = (const unsigned char*)((const bf16_t*)(ws + WS_VT) + (size_t)(R_VS + g * 128) * T_TOK + tok0); src.vpitch = T_TOK * 2;
    f32x16 O[4]; zero_o(O);
    SoftState st; st.m = -1e30f; st.l = 0.f;
    const LAS float* bt = (const LAS float*)(c.lds + A_BIAS) + r4 * 132;
    const float bconst = bt[128];
#define ATTN_QKSM \
        const int m = key0 >> 6; \
        const bool need = (m < 32 ? (wlo >> m) & 1u : (whi >> (m - 32)) & 1u) != 0u; \
        if (need && key0 <= qw0 + 31) { \
            const bool okq = (m < 32 ? (mq.x >> m) & 1u : (mq.y >> (m - 32)) & 1u) != 0u; \
            const bool far = (qw0 - (key0 + 63)) >= 128; \
            attn_qk_sm<8, true>(c.lds, buf_, 0, qf, O, st, lane, ATT_C128, far, bconst, qpos - key0 - 4 * h, 0x80000000u, okq, bt, pf_); \
            hasp_ = true; \
        }
#if ATTF_SEL
#define ATTF_QK(S0, S1) attf_qk<8>(c.lds, buf_, 0, qf, lane, S0, S1)
#define ATTF_OKQ (((key0 >> 6) < 32 ? (mq.x >> (key0 >> 6)) & 1u : (mq.y >> ((key0 >> 6) - 32)) & 1u) != 0u)
#define ATTF_CS ATT_C128
    ATTN_LOOPF(nfar, src)
#undef ATTF_QK
#undef ATTF_OKQ
#undef ATTF_CS
#undef ATTN_TL0
#define ATTN_TL0 nfar
    ATTN_LOOP2(ntiles - nfar, src)
#undef ATTN_TL0
#define ATTN_TL0 0
#else
    ATTN_LOOP2(ntiles, src)
#endif
#undef ATTN_QKSM
    const float lt = psum32(st.l);
    const float gate = sigmoidf_(bf_lo((unsigned)((const GAS bf16_t*)PROJ)[(size_t)(tok0 + qpos) * N1 + C_GATE + hn * 3 + 1]));
#ifdef ABL_SEL
    const float sc = 0.f;
#else
    const float sc = lt > 0.f ? gate / lt : 0.f;
#endif
    unsigned lo1 = (unsigned)(r * 2048 + h * 8), lo2 = (unsigned)(r * 4096 + h * 8);
    asm volatile("" : "+v"(lo1), "+v"(lo2));
    const GAS unsigned char* ocb = (const GAS unsigned char*)(ws + WS_OC) + ((size_t)(tok0 + qw0) * 1024 + hn * 128) * 2 + lo1;
    const GAS unsigned char* owb = (const GAS unsigned char*)(ws + WS_OW) + ((size_t)(tok0 + qw0) * 1024 + hn * 128) * 2 + lo1;
    GAS unsigned char* orb = (GAS unsigned char*)(ws + WS_OMIX) + ((size_t)(tok0 + qw0) * DM + 1024 + hn * 128) * 2 + lo2;
#pragma unroll
    for (int db = 0; db < 4; ++db) {
#pragma unroll
        for (int gq = 0; gq < 4; ++gq) {
            const int off = (db * 32 + gq * 8) * 2;
            const u32x2 a = *(const GAS u32x2*)(ocb + off), bw = *(const GAS u32x2*)(owb + off);
            u32x2 w;
            w.x = cvt_pk_bf16(O[db][4 * gq] * sc + bf_lo(a.x) + bf_lo(bw.x), O[db][4 * gq + 1] * sc + bf_hi(a.x) + bf_hi(bw.x));
            w.y = cvt_pk_bf16(O[db][4 * gq + 2] * sc + bf_lo(a.y) + bf_lo(bw.y), O[db][4 * gq + 3] * sc + bf_hi(a.y) + bf_hi(bw.y));
            *(GAS u32x2*)(orb + off) = w;
        }
    }
}

#define CEX(a, b) do { const float _hi = fmaxf((a), (b)), _lo = fminf((a), (b)); (a) = _hi; (b) = _lo; } while (0)
__device__ __forceinline__ void sort16_desc(float (&v)[16]) {
#pragma unroll
    for (int k = 2; k <= 16; k <<= 1)
#pragma unroll
        for (int j = k >> 1; j > 0; j >>= 1)
#pragma unroll
            for (int i = 0; i < 16; ++i) {
                const int l = i ^ j;
                if (l > i) { if ((i & k) == 0) CEX(v[i], v[l]); else CEX(v[l], v[i]); }
            }
}
__device__ __forceinline__ void merge_top16(float (&a)[16], const float (&b)[16]) {
#pragma unroll
    for (int i = 0; i < 16; ++i) a[i] = fmaxf(a[i], b[15 - i]);
#pragma unroll
    for (int j = 8; j > 0; j >>= 1)
#pragma unroll
        for (int i = 0; i < 16; ++i) { const int l = i ^ j; if (l > i) CEX(a[i], a[l]); }
}

__device__ __forceinline__ float partner32(float v, int h) { const auto r = __builtin_amdgcn_permlane32_swap(__float_as_uint(v), __float_as_uint(v), false, false); return __uint_as_float(h ? r[0] : r[1]); }
__device__ __forceinline__ void top16_of_128(f32x16 (&sc)[4], int h, float (&top)[16]) {
    float g[4][16];
#pragma unroll
    for (int kb = 0; kb < 4; ++kb) {
#pragma unroll
        for (int i = 0; i < 16; ++i) {
            const int key = kb * 32 + (i & 3) + 8 * (i >> 2) + 4 * h;
            g[kb][i] = __uint_as_float((__float_as_uint(sc[kb][i]) & ~127u) | (unsigned)(127 - key));
        }
        sort16_desc(g[kb]);
    }
    merge_top16(g[0], g[1]); merge_top16(g[2], g[3]); merge_top16(g[0], g[2]);
    float pb[16];
#pragma unroll
    for (int i = 0; i < 16; ++i) pb[i] = partner32(g[0][i], h);
    merge_top16(g[0], pb);
#pragma unroll
    for (int i = 0; i < 16; ++i) top[i] = g[0][i];
}

__device__ __forceinline__ void phase_peer_topk(const Ctx& c, const Params& p, int l) {
    unsigned char* ws = p.ws;
    const bf16_t* QRY = (const bf16_t*)(ws + WS_PROJ);
    const int gw = c.bid * 8 + c.wave, nw = c.G * 8, lane = c.lane, r = lane & 31, h = lane >> 5;
    const float NEG = -__builtin_inff();
    for (int it = gw; it < 2048; it += nw) {
        const int tt = it >> 2, hp = it & 3;
#pragma unroll 1
        for (int hh = 0; hh < 2; ++hh) {
            const int hd = hp * 2 + hh;
            float s1[16], s2[16];
#pragma unroll
            for (int pp = 0; pp < 2; ++pp) {
                const bf16_t* sk = (const bf16_t*)(ws + WS_SKB) + ((((size_t)l * 8 + hd) * 2 + pp) * 128 + r) * 128 + h * 8;
                const bf16_t* qr = QRY + (size_t)(tt * 32 + r) * DM + hd * 256 + pp * 128 + h * 8;
                f32x16 sc[4];
#pragma unroll
                for (int kb = 0; kb < 4; ++kb)
#pragma unroll
                    for (int i = 0; i < 16; ++i) sc[kb][i] = 0.f;
                constexpr int TK_PD = 2;
                bf16x8 qv[8], kf[8][4];
#pragma unroll
                for (int ks = 0; ks < TK_PD; ++ks) {
                    qv[ks] = gld<bf16x8>(qr + ks * 16);
#pragma unroll
                    for (int kb = 0; kb < 4; ++kb) kf[ks][kb] = gld<bf16x8>(sk + (size_t)kb * 32 * 128 + ks * 16);
                }
#pragma unroll
                for (int ks = 0; ks < 8; ++ks) {
                    if (ks + TK_PD < 8) {
                        qv[ks + TK_PD] = gld<bf16x8>(qr + (ks + TK_PD) * 16);
#pragma unroll
                        for (int kb = 0; kb < 4; ++kb) kf[ks + TK_PD][kb] = gld<bf16x8>(sk + (size_t)kb * 32 * 128 + (ks + TK_PD) * 16);
                    }
                    __builtin_amdgcn_sched_barrier(0);
#pragma unroll
                    for (int kb = 0; kb < 4; ++kb) sc[kb] = __builtin_amdgcn_mfma_f32_32x32x16_bf16(kf[ks][kb], qv[ks], sc[kb], 0, 0, 0);
                    __builtin_amdgcn_sched_barrier(0);
                }
                if (pp == 0) top16_of_128(sc, h, s1); else top16_of_128(sc, h, s2);
            }
            float cg[4][16];
#pragma unroll
            for (int q = 0; q < 4; ++q)
#pragma unroll
                for (int i = 0; i < 16; ++i) cg[q][i] = NEG;
            {
                int n1 = 0, n2 = 0, n3 = 0;
#pragma unroll
                for (int a = 0; a < 16; ++a)
#pragma unroll
                    for (int b = 0; b < 16; ++b)
                        if ((a + 1) * (b + 1) <= 16) {
                            const unsigned eid = ((127u - (__float_as_uint(s1[a]) & 127u)) << 7) | (127u - (__float_as_uint(s2[b]) & 127u));
                            const float v = __uint_as_float((__float_as_uint(s1[a] + s2[b]) & ~0x3fffu) | eid);
                            if (a == 0) cg[0][b] = v; else if (a <= 2) cg[1][n1++] = v; else if (a <= 7) cg[2][n2++] = v; else cg[3][n3++] = v;
                        }
            }
            sort16_desc(cg[0]); sort16_desc(cg[1]); sort16_desc(cg[2]); sort16_desc(cg[3]);
            merge_top16(cg[0], cg[1]); merge_top16(cg[2], cg[3]); merge_top16(cg[0], cg[2]);
            float tv[16]; int te[16];
#pragma unroll
            for (int k = 0; k < 16; ++k) { tv[k] = cg[0][k]; te[k] = (int)(__float_as_uint(cg[0][k]) & 0x3fffu); }
            const float tmx = tv[0];
            float wsum = 0.f;
#pragma unroll
            for (int k = 0; k < 16; ++k) { tv[k] = __expf(tv[k] - tmx); wsum += tv[k]; }
            const float winv = 1.0f / wsum;
#pragma unroll
            for (int k = 0; k < 16; ++k) tv[k] *= winv;
            GAS int* ei = (GAS int*)(ws + WS_EIDX) + (size_t)(tt * 32 + r) * 128 + hd * 16 + h * 8;
            GAS float* eg = (GAS float*)(ws + WS_EGATE) + (size_t)(tt * 32 + r) * 128 + hd * 16 + h * 8;
#pragma unroll
            for (int j = 0; j < 8; ++j) { ei[j] = h ? te[8 + j] : te[j]; eg[j] = h ? tv[8 + j] : tv[j]; }
        }
    }
}

__device__ __forceinline__ void unpack_fp8x16(u32x4 q, f32x2 (&o)[8]) {
    o[0] = __builtin_amdgcn_cvt_pk_f32_fp8((int)q.x, false); o[1] = __builtin_amdgcn_cvt_pk_f32_fp8((int)q.x, true);
    o[2] = __builtin_amdgcn_cvt_pk_f32_fp8((int)q.y, false); o[3] = __builtin_amdgcn_cvt_pk_f32_fp8((int)q.y, true);
    o[4] = __builtin_amdgcn_cvt_pk_f32_fp8((int)q.z, false); o[5] = __builtin_amdgcn_cvt_pk_f32_fp8((int)q.z, true);
    o[6] = __builtin_amdgcn_cvt_pk_f32_fp8((int)q.w, false); o[7] = __builtin_amdgcn_cvt_pk_f32_fp8((int)q.w, true);
}
template <bool DRY>
__device__ __forceinline__ void phase_peer_gather(const Ctx& c, const Params& p, int l) {
    unsigned char* ws = p.ws;
    const int gw = c.bid * 8 + c.wave, nw = c.G * 8, lane = c.lane;
    bf16_t* HN = (bf16_t*)(ws + WS_HN);
    float* XW = (float*)(ws + WS_XW);
    const unsigned char* UB = ws + WS_UB + (size_t)l * 16384 * DM;
    const unsigned char* VB = ws + WS_VB + (size_t)l * 16384 * DM;
    const GAS float* SCU = (const GAS float*)(ws + WS_SCU) + (size_t)l * 16384;
    const GAS float* SCV = (const GAS float*)(ws + WS_SCV) + (size_t)l * 16384;
    const bool b5 = (lane & 32) != 0, b4 = (lane & 16) != 0, b3 = (lane & 8) != 0;
    for (int t = gw; t < T_TOK; t += nw) {
        f32x2 xf[2][8];
#pragma unroll
        for (int cc = 0; cc < 2; ++cc) {
            const u32x4 lo = gld<u32x4>(HN + (size_t)t * DM + cc * 1024 + lane * 16), hi = gld<u32x4>(HN + (size_t)t * DM + cc * 1024 + lane * 16 + 8);
            xf[cc][0] = (f32x2){bf_lo(lo.x), bf_hi(lo.x)}; xf[cc][1] = (f32x2){bf_lo(lo.y), bf_hi(lo.y)}; xf[cc][2] = (f32x2){bf_lo(lo.z), bf_hi(lo.z)}; xf[cc][3] = (f32x2){bf_lo(lo.w), bf_hi(lo.w)};
            xf[cc][4] = (f32x2){bf_lo(hi.x), bf_hi(hi.x)}; xf[cc][5] = (f32x2){bf_lo(hi.y), bf_hi(hi.y)}; xf[cc][6] = (f32x2){bf_lo(hi.z), bf_hi(hi.z)}; xf[cc][7] = (f32x2){bf_lo(hi.w), bf_hi(hi.w)};
        }
        const int e_lo = ((const GAS int*)(ws + WS_EIDX))[(size_t)t * 128 + lane], e_hi = ((const GAS int*)(ws + WS_EIDX))[(size_t)t * 128 + 64 + lane];
        const float g_lo = ((const GAS float*)(ws + WS_EGATE))[(size_t)t * 128 + lane], g_hi = ((const GAS float*)(ws + WS_EGATE))[(size_t)t * 128 + 64 + lane];
        const float su_lo = SCU[e_lo], su_hi = SCU[e_hi], sv_lo = SCV[e_lo], sv_hi = SCV[e_hi];
        float h_lo = 0.f, h_hi = 0.f;
#pragma unroll 1
        for (int bt = 0; bt < 16; ++bt) {
            const int ev = bt < 8 ? e_lo : e_hi;
            const int b8 = bt & 7;
            u32x4 rw[8][2];
#pragma unroll
            for (int j = 0; j < 8; ++j) {
                const int ek = __builtin_amdgcn_readlane(ev, b8 * 8 + j);
                const unsigned char* row = UB + (size_t)ek * DM + lane * 16;
                rw[j][0] = gld<u32x4>(row); rw[j][1] = gld<u32x4>(row + 1024);
            }
            float ps[8];
#pragma unroll
            for (int j = 0; j < 8; ++j) {
                f32x2 a2 = {0.f, 0.f};
#pragma unroll
                for (int cc = 0; cc < 2; ++cc) {
                    f32x2 uf[8]; unpack_fp8x16(rw[j][cc], uf);
#pragma unroll
                    for (int i = 0; i < 8; ++i) a2 = __builtin_elementwise_fma(uf[i], xf[cc][i], a2);
                }
                ps[j] = a2.x + a2.y;
            }
            float q4[4];
#pragma unroll
            for (int i = 0; i < 4; ++i) { const float keep = b5 ? ps[i + 4] : ps[i], give = b5 ? ps[i] : ps[i + 4]; q4[i] = keep + __shfl_xor(give, 32); }
            float q2[2];
#pragma unroll
            for (int i = 0; i < 2; ++i) { const float keep = b4 ? q4[i + 2] : q4[i], give = b4 ? q4[i] : q4[i + 2]; q2[i] = keep + __shfl_xor(give, 16); }
            float q1;
            { const float keep = b3 ? q2[1] : q2[0], give = b3 ? q2[0] : q2[1]; q1 = keep + __shfl_xor(give, 8); }
            q1 += __shfl_xor(q1, 4); q1 += __shfl_xor(q1, 2); q1 += __shfl_xor(q1, 1);
            const float mine = __shfl(q1, 8 * (lane & 7));
            if ((lane >> 3) == b8) { if (bt < 8) h_lo = mine; else h_hi = mine; }
        }
        h_lo *= su_lo; h_hi *= su_hi;
#ifdef ABL_PEER
        const float a_lo = 0.f, a_hi = 0.f;
#else
        const float a_lo = 0.5f * h_lo * (1.0f + erff(h_lo * 0.70710678118f)) * g_lo * sv_lo;
        const float a_hi = 0.5f * h_hi * (1.0f + erff(h_hi * 0.70710678118f)) * g_hi * sv_hi;
#endif
        f32x2 acc[2][8];
#pragma unroll
        for (int cc = 0; cc < 2; ++cc)
#pragma unroll
            for (int i = 0; i < 8; ++i) acc[cc][i] = (f32x2){0.f, 0.f};
#pragma unroll 1
        for (int bt = 0; bt < 16; ++bt) {
            const int ev = bt < 8 ? e_lo : e_hi;
            const float avv = bt < 8 ? a_lo : a_hi;
            const int b8 = (bt & 7) * 8;
            u32x4 rw[8][2];
#pragma unroll
            for (int j = 0; j < 8; ++j) {
                const int ek = __builtin_amdgcn_readlane(ev, b8 + j);
                const unsigned char* row = VB + (size_t)ek * DM + lane * 16;
                rw[j][0] = gld<u32x4>(row); rw[j][1] = gld<u32x4>(row + 1024);
            }
#pragma unroll
            for (int j = 0; j < 8; ++j) {
                const float a = __uint_as_float((unsigned)__builtin_amdgcn_readlane((int)__float_as_uint(avv), b8 + j));
                const f32x2 a2 = {a, a};
#pragma unroll
                for (int cc = 0; cc < 2; ++cc) {
                    f32x2 vf[8]; unpack_fp8x16(rw[j][cc], vf);
#pragma unroll
                    for (int i = 0; i < 8; ++i) acc[cc][i] = __builtin_elementwise_fma(vf[i], a2, acc[cc][i]);
                }
            }
        }
        float* xw = XW + (size_t)t * DM;
        float* xwo = DRY ? (float*)(ws + WS_OC) + (size_t)(t & 4095) * DM : xw;
        bf16_t* hno = DRY ? (bf16_t*)(ws + WS_OMIX) + (size_t)t * DM : HN + (size_t)t * DM;
        float ss = 0.f;
#pragma unroll
        for (int cc = 0; cc < 2; ++cc)
#pragma unroll
            for (int i = 0; i < 4; ++i) {
                const f32x4 a = gld<f32x4>(xw + cc * 1024 + lane * 16 + i * 4);
                acc[cc][2 * i].x += a[0]; acc[cc][2 * i].y += a[1]; acc[cc][2 * i + 1].x += a[2]; acc[cc][2 * i + 1].y += a[3];
                ss += acc[cc][2 * i].x * acc[cc][2 * i].x + acc[cc][2 * i].y * acc[cc][2 * i].y + acc[cc][2 * i + 1].x * acc[cc][2 * i + 1].x + acc[cc][2 * i + 1].y * acc[cc][2 * i + 1].y;
            }
        ss = wave_sum(ss);
        const float rstd = rsqrtf(ss * (1.0f / DM) + 1e-6f);
        if (l + 1 < DEPTH) {
            const float* gn = p.attn_norm + (size_t)(l + 1) * DM;
#pragma unroll
            for (int cc = 0; cc < 2; ++cc) {
                unsigned wv_[8];
#pragma unroll
                for (int i = 0; i < 4; ++i) {
                    gst<f32x4>(xwo + cc * 1024 + lane * 16 + i * 4, (f32x4){acc[cc][2 * i].x, acc[cc][2 * i].y, acc[cc][2 * i + 1].x, acc[cc][2 * i + 1].y});
                    const f32x4 g = gld<f32x4>(gn + cc * 1024 + lane * 16 + i * 4);
                    wv_[2 * i] = cvt_pk_bf16(acc[cc][2 * i].x * rstd * g[0], acc[cc][2 * i].y * rstd * g[1]);
                    wv_[2 * i + 1] = cvt_pk_bf16(acc[cc][2 * i + 1].x * rstd * g[2], acc[cc][2 * i + 1].y * rstd * g[3]);
                }
                gst<u32x4>(hno + cc * 1024 + lane * 16, (u32x4){wv_[0], wv_[1], wv_[2], wv_[3]});
                gst<u32x4>(hno + cc * 1024 + lane * 16 + 8, (u32x4){wv_[4], wv_[5], wv_[6], wv_[7]});
            }
        } else {
            const float* gn = p.final_norm;
            float* orow = DRY ? xwo : p.out + (size_t)t * DM;
#pragma unroll
            for (int cc = 0; cc < 2; ++cc)
#pragma unroll
                for (int i = 0; i < 4; ++i) {
                    const f32x4 g = gld<f32x4>(gn + cc * 1024 + lane * 16 + i * 4);
                    gst<f32x4>(orow + cc * 1024 + lane * 16 + i * 4, (f32x4){acc[cc][2 * i].x * rstd * g[0], acc[cc][2 * i].y * rstd * g[1], acc[cc][2 * i + 1].x * rstd * g[2], acc[cc][2 * i + 1].y * rstd * g[3]});
                }
        }
    }
}

template <int XU>
__device__ __forceinline__ void phase_peer_u(const Ctx& c, const Params& p, int l) {
    constexpr int FMT = PEER_FMT_U; typedef PeerFmt<FMT> F;
    unsigned char* ws = p.ws;
    const int lane = c.lane, li = lane & 7, rg = lane >> 3;
    const int slice = c.bid & 7, nblk = (c.G - slice + 7) >> 3;
    const int w0 = (c.bid >> 3) * 8 + c.wave, wstride = nblk * 8;
    const bf16_t* HN = (const bf16_t*)(ws + WS_HN) + slice * 256 + li * 32;
    const unsigned char* UB = ws + WS_UB + (size_t)l * 16384 * F::ROWB + slice * (F::ROWB / 8) + li * (FMT == 6 ? 16 : F::LANEB);
    const int d8 = 128 - 8 * li;
    GAS float* HP = (GAS float*)(ws + (XU ? WS_OMIX : WS_OC)) + (size_t)slice * T_TOK * 128;
    const GAS int* EI = (const GAS int*)(ws + WS_EIDX);
    const bool b2 = (lane & 4) != 0, b1 = (lane & 2) != 0, b0 = (lane & 1) != 0;
    const int bpa0 = rg * 4;
    int e_lo = 0, e_hi = 0; u32x4 xr[4] = {};
    if (w0 < T_TOK) { e_lo = EI[(size_t)w0 * 128 + lane]; e_hi = EI[(size_t)w0 * 128 + 64 + lane];
#pragma unroll
        for (int q = 0; q < 4; ++q) xr[q] = gld<u32x4>(HN + (size_t)w0 * DM + q * 8); }
    for (int t = w0; t < T_TOK; t += wstride) {
        int bpa = bpa0; asm volatile("" : "+v"(bpa));
        unsigned rw[16][6];
#pragma unroll
        for (int j = 0; j < 16; ++j) {
            const int ek = __builtin_amdgcn_ds_bpermute(bpa + 32 * (j & 7), j < 8 ? e_lo : e_hi);
            if (FMT == 6) ldrow_u6(UB + (size_t)ek * F::ROWB, d8, rw[j]); else ldrow<FMT>(UB + (size_t)ek * F::ROWB, rw[j]);
        }
        f32x2 xf[16];
#pragma unroll
        for (int q = 0; q < 4; ++q) { const u32x4 v = xr[q];
            xf[4 * q] = (f32x2){bf_lo(v.x), bf_hi(v.x)}; xf[4 * q + 1] = (f32x2){bf_lo(v.y), bf_hi(v.y)}; xf[4 * q + 2] = (f32x2){bf_lo(v.z), bf_hi(v.z)}; xf[4 * q + 3] = (f32x2){bf_lo(v.w), bf_hi(v.w)}; }
        const int tn = t + wstride;
        if (tn < T_TOK) { e_lo = EI[(size_t)tn * 128 + lane]; e_hi = EI[(size_t)tn * 128 + 64 + lane];
#pragma unroll
            for (int q = 0; q < 4; ++q) xr[q] = gld<u32x4>(HN + (size_t)tn * DM + q * 8); }
        __builtin_amdgcn_sched_barrier(0);
        float pv[16];
#pragma unroll
        for (int j = 0; j < 16; ++j) {
            f32x2 uf[16];
            if (XU == 2) {
#pragma unroll
                for (int i = 0; i < 16; ++i) uf[i] = (f32x2){__uint_as_float(rw[j][i % 6]), __uint_as_float(rw[j][(i + 1) % 6])};
            } else dec32<FMT>(rw[j], uf);
            f32x2 a2 = {0.f, 0.f}, a3 = {0.f, 0.f};
#pragma unroll
            for (int i = 0; i < (XU == 3 ? 1 : 8); ++i) { a2 = __builtin_elementwise_fma(uf[2 * i], xf[2 * i], a2); a3 = __builtin_elementwise_fma(uf[2 * i + 1], xf[2 * i + 1], a3); }
            pv[j] = (a2.x + a2.y) + (a3.x + a3.y);
            __builtin_amdgcn_sched_barrier(0);
        }
        float q8[8];
#pragma unroll
        for (int i = 0; i < 8; ++i) { const float keep = b2 ? pv[8 + i] : pv[i], give = b2 ? pv[i] : pv[8 + i]; q8[i] = keep + swz_xor<4>(give); }
        float q4[4];
#pragma unroll
        for (int i = 0; i < 4; ++i) { const float keep = b1 ? q8[4 + i] : q8[i], give = b1 ? q8[i] : q8[4 + i]; q4[i] = keep + swz_xor<2>(give); }
        float q2[2];
#pragma unroll
        for (int i = 0; i < 2; ++i) { const float keep = b0 ? q4[2 + i] : q4[i], give = b0 ? q4[i] : q4[2 + i]; q2[i] = keep + swz_xor<1>(give); }
        const int x0 = 2 * li, s0 = 64 * (x0 >> 3) + 8 * (x0 & 7) + rg;
        GAS float* hp = HP + (size_t)t * 128 + s0;
        hp[0] = q2[0]; hp[8] = q2[1];
    }
}

__device__ __forceinline__ void phase_peer_a(const Ctx& c, const Params& p, int l) {
    unsigned char* ws = p.ws;
    const int gw = c.bid * 8 + c.wave, nw = c.G * 8, lane = c.lane;
    const GAS float* HP = (const GAS float*)(ws + WS_OC);
    const GAS float* SCU = (const GAS float*)(ws + WS_SCU) + (size_t)l * 16384;
    const GAS float* SCV = (const GAS float*)(ws + WS_SCV) + (size_t)l * 16384;
    GAS float* EG = (GAS float*)(ws + WS_EGATE);
    for (int t = gw; t < T_TOK; t += nw) {
        const int e_lo = ((const GAS int*)(ws + WS_EIDX))[(size_t)t * 128 + lane], e_hi = ((const GAS int*)(ws + WS_EIDX))[(size_t)t * 128 + 64 + lane];
        const float g_lo = EG[(size_t)t * 128 + lane], g_hi = EG[(size_t)t * 128 + 64 + lane];
        float h_lo = 0.f, h_hi = 0.f;
#pragma unroll
        for (int s = 0; s < 8; ++s) { h_lo += HP[((size_t)s * T_TOK + t) * 128 + lane]; h_hi += HP[((size_t)s * T_TOK + t) * 128 + 64 + lane]; }
        h_lo *= SCU[e_lo]; h_hi *= SCU[e_hi];
#ifdef ABL_PEER
        const float a_lo = 0.f, a_hi = 0.f;
#else
        const float a_lo = 0.5f * h_lo * (1.0f + erff(h_lo * 0.70710678118f)) * g_lo * SCV[e_lo];
        const float a_hi = 0.5f * h_hi * (1.0f + erff(h_hi * 0.70710678118f)) * g_hi * SCV[e_hi];
#endif
        EG[(size_t)t * 128 + lane] = a_lo; EG[(size_t)t * 128 + 64 + lane] = a_hi;
    }
}
template <int XV>
__device__ __forceinline__ void phase_peer_v(const Ctx& c, const Params& p, int l) {
    constexpr int FMT = PEER_FMT_V; typedef PeerFmt<FMT> F;
    unsigned char* ws = p.ws;
    const int lane = c.lane, li = lane & 7, rg = lane >> 3;
    const int slice = c.bid & 7, nblk = (c.G - slice + 7) >> 3;
    const int w0 = (c.bid >> 3) * 8 + c.wave, wstride = nblk * 8;
    float* XW = (float*)(ws + WS_XW) + slice * 256 + li * 32 + rg * 4;
    const unsigned char* VB = ws + WS_VB + (size_t)l * 16384 * F::ROWB + slice * (F::ROWB / 8) + li * F::LANEB;
    const GAS int* EI = (const GAS int*)(ws + WS_EIDX);
    const GAS float* EA = (const GAS float*)(ws + WS_EGATE);
    const bool b5 = (lane & 32) != 0, b4 = (lane & 16) != 0, b3 = (lane & 8) != 0;
    const int bpa0 = rg * 4;
    int e_lo = 0, e_hi = 0; float a_lo = 0.f, a_hi = 0.f;
    if (w0 < T_TOK) { e_lo = EI[(size_t)w0 * 128 + lane]; e_hi = EI[(size_t)w0 * 128 + 64 + lane]; a_lo = EA[(size_t)w0 * 128 + lane]; a_hi = EA[(size_t)w0 * 128 + 64 + lane]; }
    for (int t = w0; t < T_TOK; t += wstride) {
        int bpa = bpa0; asm volatile("" : "+v"(bpa));
        unsigned rw[16][6]; float av[16];
#pragma unroll
        for (int j = 0; j < 16; ++j) {
            const int ek = __builtin_amdgcn_ds_bpermute(bpa + 32 * (j & 7), j < 8 ? e_lo : e_hi);
            av[j] = __int_as_float(__builtin_amdgcn_ds_bpermute(bpa + 32 * (j & 7), __float_as_int(j < 8 ? a_lo : a_hi)));
            ldrow<FMT>(VB + (size_t)ek * F::ROWB, rw[j]);
        }
        const f32x4 xo = gld<f32x4>(XW + (size_t)t * DM);
        const int tn = t + wstride;
        if (tn < T_TOK) { e_lo = EI[(size_t)tn * 128 + lane]; e_hi = EI[(size_t)tn * 128 + 64 + lane]; a_lo = EA[(size_t)tn * 128 + lane]; a_hi = EA[(size_t)tn * 128 + 64 + lane]; }
        __builtin_amdgcn_sched_barrier(0);
        f32x2 acc[16];
#pragma unroll
        for (int i = 0; i < 16; ++i) acc[i] = (f32x2){0.f, 0.f};
#pragma unroll
        for (int j = 0; j < 16; ++j) {
            f32x2 vf[16];
            if (XV == 2) {
#pragma unroll
                for (int i = 0; i < 16; ++i) vf[i] = (f32x2){__uint_as_float(rw[j][i & 3]), __uint_as_float(rw[j][(i + 1) & 3])};
            } else dec32<FMT>(rw[j], vf);
            const f32x2 a2 = {av[j], av[j]};
#pragma unroll
            for (int i = 0; i < 16; ++i) acc[i] = __builtin_elementwise_fma(vf[i], a2, acc[i]);
            __builtin_amdgcn_sched_barrier(0);
        }
        f32x2 r8[8];
#pragma unroll
        for (int i = 0; i < 8; ++i) {
            const f32x2 keep = b5 ? acc[8 + i] : acc[i], give = b5 ? acc[i] : acc[8 + i];
            const auto gx = __builtin_amdgcn_permlane32_swap(__float_as_uint(give.x), __float_as_uint(give.x), false, false);
            const auto gy = __builtin_amdgcn_permlane32_swap(__float_as_uint(give.y), __float_as_uint(give.y), false, false);
            r8[i] = (f32x2){keep.x + __uint_as_float(b5 ? gx[0] : gx[1]), keep.y + __uint_as_float(b5 ? gy[0] : gy[1])};
        }
        f32x2 r4[4];
#pragma unroll
        for (int i = 0; i < 4; ++i) { const f32x2 keep = b4 ? r8[4 + i] : r8[i], give = b4 ? r8[i] : r8[4 + i]; r4[i] = (f32x2){keep.x + swz_xor<16>(give.x), keep.y + swz_xor<16>(give.y)}; }
        f32x2 r2[2];
#pragma unroll
        for (int i = 0; i < 2; ++i) { const f32x2 keep = b3 ? r4[2 + i] : r4[i], give = b3 ? r4[i] : r4[2 + i]; r2[i] = (f32x2){keep.x + swz_xor<8>(give.x), keep.y + swz_xor<8>(give.y)}; }
        float* xp = XW + (size_t)t * DM;
        gst<f32x4>(XV ? (float*)(ws + WS_OMIX) + (size_t)(t & 8191) * DM + slice * 256 + li * 32 + rg * 4 : xp, (f32x4){xo[0] + r2[0].x, xo[1] + r2[0].y, xo[2] + r2[1].x, xo[3] + r2[1].y});
    }
}
constexpr int LDS_PARAMS = LDS_MISC + 128;
__device__ __forceinline__ Ctx make_ctx(Params& p, int wv) {
    extern __shared__ __attribute__((aligned(16))) unsigned char lds_raw[];
    Ctx c;
    asm volatile("" ::: "memory");
    c.lds = (LAS unsigned char*)lds_raw;
    int ln; asm volatile("v_mbcnt_lo_u32_b32 %0, -1, 0\n\tv_mbcnt_hi_u32_b32 %0, -1, %0" : "=v"(ln));
    int wz = wv; asm volatile("" : "+s"(wz));
    int gz = gridDim.x; asm volatile("" : "+s"(gz));
    int bz = blockIdx.x; asm volatile("" : "+s"(bz));
    c.lane = ln; c.wave = wz; c.tid = (wz << 6) | ln;
    c.G = gz; c.bid = bz;
    {
        const LAS unsigned long long* q = (const LAS unsigned long long*)(c.lds + LDS_PARAMS);
#define LDP(i) ((unsigned long long)(unsigned)__builtin_amdgcn_readfirstlane((int)(unsigned)q[i]) | ((unsigned long long)(unsigned)__builtin_amdgcn_readfirstlane((int)(unsigned)(q[i] >> 32)) << 32))
        p.x = (const float*)LDP(0); p.rel_bias = (const float*)LDP(1); p.attn_norm = (const float*)LDP(2); p.w_in = (const float*)LDP(3); p.diff_lambda = (const float*)LDP(4); p.diff_subln = (const float*)LDP(5);
        p.cmp_pos = (const float*)LDP(6); p.cmp_w = (const float*)LDP(7); p.w_out = (const float*)LDP(8); p.ffn_norm = (const float*)LDP(9); p.peer_wq = (const float*)LDP(10); p.peer_subkeys = (const float*)LDP(11);
        p.peer_u = (const float*)LDP(12); p.peer_v = (const float*)LDP(13); p.final_norm = (const float*)LDP(14); p.out = (float*)LDP(15); p.ws = (unsigned char*)LDP(16);
#undef LDP
    }
    c.ctl = (unsigned*)(p.ws + WS_CTL);
    return c;
}
__device__ __forceinline__ void ph_barrier(int wv) {
    Params p; Ctx c = make_ctx(p, wv);
    XcdBarrier bar; bar.bar = c.ctl + CW_BAR; bar.x = xb_xcc_id(); bar.st = (volatile LAS unsigned*)(c.lds + LDS_MISC);
    xcd_barrier(bar, c.tid);
#ifdef EXP_BAR2
    xcd_barrier(bar, c.tid);
#endif
}
__device__ __forceinline__ void ph_prologue(int wv) {
    Params p; Ctx c = make_ctx(p, wv);
    phase_prologue(c, p);
    phase_rmsnorm_bf16(c, p.x, p.attn_norm, (bf16_t*)(p.ws + WS_HN));
}
__device__ __forceinline__ void ph_gemm_in(int wv, int l) {
    Params p; Ctx c = make_ctx(p, wv);
    unsigned char* ws = p.ws;
    {
        pg8::Gemm g{(const bf16_t*)(ws + WS_HN), (const bf16_t*)(ws + WS_WT1) + (size_t)l * N1 * DM, T_TOK, N1, DM};
        pg8::StaticOrder S; S.init(T_TOK, N1, c.G, c.bid);
        pg8::EpiBf16<0> E{(bf16_t*)(ws + WS_PROJ), N1, nullptr, 0, 0};
        pg8::gemm_phase<pg8::EpiBf16<0>, pg8::StaticOrder, false>(c.lds, g, S, E, nullptr, c.tid);
    }
}
__device__ __forceinline__ void ph_gemm_vt(int wv, int l) {
    Params p; Ctx c = make_ctx(p, wv);
    unsigned char* ws = p.ws;
    {
        pg8::Gemm g{(const bf16_t*)(ws + WS_WTV) + (size_t)l * NV * DM, (const bf16_t*)(ws + WS_HN), NV, T_TOK, DM};
        pg8::StaticOrder S; S.init(NV, T_TOK, c.G, c.G - 1 - c.bid);
        pg8::EpiBf16<0> E{(bf16_t*)(ws + WS_VT), T_TOK, nullptr, 0, 0};
        pg8::gemm_phase<pg8::EpiBf16<0>, pg8::StaticOrder, false>(c.lds, g, S, E, nullptr, c.tid);
    }
}
__device__ __forceinline__ void ph_gemm_out(int wv, int l) {
    Params p; Ctx c = make_ctx(p, wv);
    unsigned char* ws = p.ws;
    float* XW = (float*)(ws + WS_XW);
    pg8::Gemm g{(const bf16_t*)(ws + WS_OMIX), (const bf16_t*)(ws + WS_WTO) + (size_t)l * DM * DM, T_TOK, DM, DM};
    pg8::StaticOrder S; S.init(T_TOK, DM, c.G, c.bid);
    pg8::EpiResF32 E{XW, l == 0 ? p.x : (const float*)XW, DM};
    pg8::gemm_phase<pg8::EpiResF32, pg8::StaticOrder, false>(c.lds, g, S, E, nullptr, c.tid);
}
__device__ __forceinline__ void ph_gemm_q(int wv, int l) {
    Params p; Ctx c = make_ctx(p, wv);
    unsigned char* ws = p.ws;
    pg8::Gemm g{(const bf16_t*)(ws + WS_HN), (const bf16_t*)(ws + WS_WTQ) + (size_t)l * DM * DM, T_TOK, DM, DM};
    pg8::StaticOrder S; S.init(T_TOK, DM, c.G, c.bid);
    pg8::EpiBf16<0> E{(bf16_t*)(ws + WS_PROJ), DM, nullptr, 0, 0};
    pg8::gemm_phase<pg8::EpiBf16<0>, pg8::StaticOrder, false>(c.lds, g, S, E, nullptr, c.tid);
}
__device__ __forceinline__ void ph_prep(int wv, int l) { Params p; Ctx c = make_ctx(p, wv); phase_prep(c, p, l); }
template <int XM = 0>
__device__ __forceinline__ void ph_diff(int wv, int l, int qo = 0) {
    Params p; Ctx c = make_ctx(p, wv);
    for (;;) { const int idx = next_item(c, l * 8 + 0 + qo); if (idx >= 512) break; item_diff<XM>(c, p, l, (idx & 15) >> 2, idx & 3, 31 - (idx >> 4)); }
}
__device__ __forceinline__ void ph_moba(int wv, int l, int qo = 0) {
    Params p; Ctx c = make_ctx(p, wv);
    for (;;) { const int idx = next_item(c, l * 8 + 1 + qo); if (idx >= 256) break; item_moba(c, p, (idx & 15) >> 2, idx & 3, 15 - (idx >> 4)); }
}
__device__ __forceinline__ void ph_cmp(int wv, int l, int qo = 0) {
    Params p; Ctx c = make_ctx(p, wv);
    for (;;) { const int idx = next_item(c, l * 8 + 2 + qo); if (idx >= 512) break; item_nsa_cmp(c, p, (idx & 7) >> 1, idx & 1, 63 - (idx >> 3)); }
}
__device__ __forceinline__ void ph_win(int wv, int l, int qo = 0) {
    Params p; Ctx c = make_ctx(p, wv);
    for (;;) { const int idx = next_item(c, l * 8 + 3 + qo); if (idx >= 512) break; item_nsa_win(c, p, (idx & 7) >> 1, idx & 1, 63 - (idx >> 3)); }
}
__device__ __forceinline__ void ph_sel(int wv, int l, int qo = 0) {
    Params p; Ctx c = make_ctx(p, wv);
    for (;;) { const int idx = next_item(c, l * 8 + 4 + qo); if (idx >= 512) break; item_nsa_sel(c, p, (idx & 7) >> 1, idx & 1, 63 - (idx >> 3)); }
}
__device__ __forceinline__ void ph_norm2(int wv, int l) {
    Params p; Ctx c = make_ctx(p, wv);
    phase_rmsnorm_bf16(c, (const float*)(p.ws + WS_XW), p.ffn_norm + (size_t)l * DM, (bf16_t*)(p.ws + WS_HN));
}
__device__ __forceinline__ void ph_topk(int wv, int l) { Params p; Ctx c = make_ctx(p, wv); phase_peer_topk(c, p, l); }
__device__ __forceinline__ void ph_gather(int wv, int l) { Params p; Ctx c = make_ctx(p, wv); phase_peer_gather<false>(c, p, l); }
__device__ __forceinline__ void ph_peer_u(int wv, int l) { Params p; Ctx c = make_ctx(p, wv); phase_peer_u<0>(c, p, l); }
template <int XU> __device__ __forceinline__ void ph_peer_ux(int wv, int l) { Params p; Ctx c = make_ctx(p, wv); phase_peer_u<XU>(c, p, l); }
__device__ __forceinline__ void ph_peer_v(int wv, int l) { Params p; Ctx c = make_ctx(p, wv); phase_peer_v<0>(c, p, l); }
__device__ __forceinline__ void ph_peer_a(int wv, int l) { Params p; Ctx c = make_ctx(p, wv); phase_peer_a(c, p, l); }
template <int XV> __device__ __forceinline__ void ph_peer_vx(int wv, int l) { Params p; Ctx c = make_ctx(p, wv); phase_peer_v<XV>(c, p, l); }
__device__ __forceinline__ void ph_norm_next(int wv, int l) {
    Params p; Ctx c = make_ctx(p, wv);
    if (l + 1 < DEPTH) phase_rmsnorm_bf16(c, (const float*)(p.ws + WS_XW), p.attn_norm + (size_t)(l + 1) * DM, (bf16_t*)(p.ws + WS_HN));
    else phase_rmsnorm_f32(c, (const float*)(p.ws + WS_XW), p.final_norm, p.out);
}
__device__ __forceinline__ void ph_gather_dry(int wv, int l) { Params p; Ctx c = make_ctx(p, wv); phase_peer_gather<true>(c, p, l); }

template <int L>
__device__ __forceinline__ void layer_body(int wv) {
    constexpr int l = L;
    ph_gemm_in(wv, l); ph_gemm_vt(wv, l);
#ifdef EXP_GEMM2
    ph_barrier(wv); ph_gemm_in(wv, l); ph_gemm_vt(wv, l);
#endif
    ph_barrier(wv);
    ph_prep(wv, l);
    ph_barrier(wv);
#ifdef EXP_PREP2
    ph_prep(wv, l);
    ph_barrier(wv);
#endif
    if (wv >= 4) __builtin_amdgcn_s_setprio(1);
    ph_diff(wv, l); ph_moba(wv, l); ph_cmp(wv, l); ph_win(wv, l);
    ph_barrier(wv);
    ph_sel(wv, l);
    __builtin_amdgcn_s_setprio(0);
    ph_barrier(wv);
#ifdef EXP_ATTN2
    ph_diff(wv, l, 32); ph_moba(wv, l, 32); ph_cmp(wv, l, 32); ph_win(wv, l, 32);
    ph_barrier(wv);
    ph_sel(wv, l, 32);
    ph_barrier(wv);
#endif
#ifdef EXP_DIFFX
    ph_diff<EXP_DIFFX>(wv, l, 32);
    ph_barrier(wv);
#endif
#ifdef EXP_SEL2
    ph_sel(wv, l, 32);
    ph_barrier(wv);
#endif
    ph_gemm_out(wv, l);
    ph_barrier(wv);
    ph_norm2(wv, l);
    ph_barrier(wv);
    ph_gemm_q(wv, l);
#ifdef EXP_GEMM2
    ph_barrier(wv); ph_gemm_q(wv, l);
#endif
    ph_barrier(wv);
    ph_topk(wv, l);
#ifdef EXP_TOPK2
    ph_barrier(wv); ph_topk(wv, l);
#endif
    ph_barrier(wv);
#ifdef EXP_GATHER2
    ph_gather_dry(wv, l);
    ph_barrier(wv);
#endif
#ifdef PEER_WHOLE_ROWS
    ph_gather(wv, l);
    ph_barrier(wv);
#else
    ph_peer_u(wv, l);
    ph_barrier(wv);
#ifdef EXP_PUX
    ph_peer_ux<EXP_PUX>(wv, l);
    ph_barrier(wv);
#endif
    ph_peer_a(wv, l);
    ph_barrier(wv);
#ifdef EXP_PVX
    ph_peer_vx<EXP_PVX>(wv, l);
    ph_barrier(wv);
#endif
    ph_peer_v(wv, l);
    ph_barrier(wv);
    ph_norm_next(wv, l);
    ph_barrier(wv);
#endif
}

__global__ void __launch_bounds__(512, 2) hybrid_fwd(Params pk) {
    extern __shared__ __attribute__((aligned(16))) unsigned char lds_raw[];
    const int wv = __builtin_amdgcn_readfirstlane((int)threadIdx.x >> 6);
    {
        LAS unsigned char* lds = (LAS unsigned char*)lds_raw;
        volatile LAS unsigned* misc = (volatile LAS unsigned*)(lds + LDS_MISC);
        for (int u = threadIdx.x; u < 32; u += 512) misc[u] = 0u;
        if (threadIdx.x == 0) {
            LAS unsigned long long* q = (LAS unsigned long long*)(lds + LDS_PARAMS);
            q[0] = (unsigned long long)pk.x; q[1] = (unsigned long long)pk.rel_bias; q[2] = (unsigned long long)pk.attn_norm; q[3] = (unsigned long long)pk.w_in; q[4] = (unsigned long long)pk.diff_lambda;
            q[5] = (unsigned long long)pk.diff_subln; q[6] = (unsigned long long)pk.cmp_pos; q[7] = (unsigned long long)pk.cmp_w; q[8] = (unsigned long long)pk.w_out; q[9] = (unsigned long long)pk.ffn_norm;
            q[10] = (unsigned long long)pk.peer_wq; q[11] = (unsigned long long)pk.peer_subkeys; q[12] = (unsigned long long)pk.peer_u; q[13] = (unsigned long long)pk.peer_v; q[14] = (unsigned long long)pk.final_norm;
            q[15] = (unsigned long long)pk.out; q[16] = (unsigned long long)pk.ws;
        }
        __syncthreads();
        (void)xcd_barrier_post((unsigned*)(pk.ws + WS_CTL) + CW_BAR, misc);
    }
    ph_prologue(wv);
    ph_barrier(wv);
#ifdef EXP_PRO2
    ph_prologue(wv);
    ph_barrier(wv);
#endif
    layer_body<0>(wv);
    layer_body<1>(wv);
}

extern "C" void kernel_launch(void* const* d_in, const int* in_sizes, int n_in, void* d_out, int out_size, void* d_ws, size_t ws_size, hipStream_t stream) {
    static int grid = 0;
    if (!grid) {
        int dev = 0, cus = 0;
        if (n_in != 15 || out_size != T_TOK * DM || ws_size < WS_END) { fprintf(stderr, "kernel_launch: unexpected shapes (n_in %d, out %d, ws %zu < %zu)\n", n_in, out_size, ws_size, (size_t)WS_END); grid = -1; return; }
        if (hipGetDevice(&dev) != hipSuccess || hipDeviceGetAttribute(&cus, hipDeviceAttributeMultiprocessorCount, dev) != hipSuccess || cus < 8) { grid = -1; return; }
        if (hipFuncSetAttribute((const void*)hybrid_fwd, hipFuncAttributeMaxDynamicSharedMemorySize, LDS_BYTES) != hipSuccess) { fprintf(stderr, "kernel_launch: hipFuncSetAttribute failed\n"); grid = -1; return; }
        grid = cus;
    }
    if (grid < 0) return;
    (void)hipMemsetAsync((char*)d_ws + WS_CTL, 0, CTL_BYTES, stream);
    Params p;
    memset(&p, 0, sizeof(p));
    p.x = (const float*)d_in[0]; p.rel_bias = (const float*)d_in[1]; p.attn_norm = (const float*)d_in[2]; p.w_in = (const float*)d_in[3];
    p.diff_lambda = (const float*)d_in[4]; p.diff_subln = (const float*)d_in[5]; p.cmp_pos = (const float*)d_in[6]; p.cmp_w = (const float*)d_in[7];
    p.w_out = (const float*)d_in[8]; p.ffn_norm = (const float*)d_in[9]; p.peer_wq = (const float*)d_in[10]; p.peer_subkeys = (const float*)d_in[11];
    p.peer_u = (const float*)d_in[12]; p.peer_v = (const float*)d_in[13]; p.final_norm = (const float*)d_in[14];
    p.out = (float*)d_out; p.ws = (unsigned char*)d_ws;
    hipLaunchKernelGGL(hybrid_fwd, dim3(grid), dim3(512), LDS_BYTES, stream, p);
}
```

```cpp
#include <hip/hip_runtime.h>
#include <cstdint>
#include <cstdio>
#include <cstring>

#define LAS __attribute__((address_space(3)))
typedef unsigned short bf16_t;
typedef short bf16x8 __attribute__((ext_vector_type(8)));
typedef short bf16x4 __attribute__((ext_vector_type(4)));
typedef float f32x4 __attribute__((ext_vector_type(4)));
typedef float f32x2 __attribute__((ext_vector_type(2)));
typedef float f32x16 __attribute__((ext_vector_type(16)));
typedef unsigned u32x4 __attribute__((ext_vector_type(4)));
typedef unsigned u32x2 __attribute__((ext_vector_type(2)));
typedef __bf16 bf2_t __attribute__((ext_vector_type(2)));

#define XB_TMO      128
#define XB_XCNT(j)  (256  + 64 * (j))
#define XB_XSUB(j)  (1280 + 64 * (j))
#define XB_XGEN(j)  (2304 + 64 * (j))
#define XB_TOP      3328
#define XB_TOPGEN   3392
#define XCD_BAR_WORDS 3456
#define XB_SPIN_CAP (1u << 18)
#define LAS __attribute__((address_space(3)))

__device__ __forceinline__ unsigned xb_ld(unsigned* p)              { return __hip_atomic_load(p, __ATOMIC_RELAXED, __HIP_MEMORY_SCOPE_AGENT); }
__device__ __forceinline__ unsigned xb_add(unsigned* p, unsigned v) { return __hip_atomic_fetch_add(p, v, __ATOMIC_RELAXED, __HIP_MEMORY_SCOPE_AGENT); }
__device__ __forceinline__ unsigned xb_xcc_id() { return (unsigned)__builtin_amdgcn_s_getreg((3 << 11) | 20) & 0xFu; }
#define XB_SPIN(cond, bar) do { unsigned _sp = 0; while (cond) { __builtin_amdgcn_s_sleep(1); \
    if ((++_sp & 255u) == 0u) { if (xb_ld(&(bar)[XB_TMO])) break; if (_sp > XB_SPIN_CAP) { atomicAdd(&(bar)[XB_TMO], 1u); break; } } } } while (0)

struct XcdBarrier {
    unsigned* bar; unsigned x;
    volatile LAS unsigned* st;
};

__device__ __forceinline__ XcdBarrier xcd_barrier_post(unsigned* bar, volatile LAS unsigned* st) {
    XcdBarrier b; b.bar = bar; b.x = xb_xcc_id(); b.st = st;
    if (threadIdx.x == 0) (void)xb_add(&bar[XB_XCNT(b.x)], 1u);
    return b;
}
__device__ __forceinline__ void xcd_barrier_complete(unsigned* bar, unsigned x, unsigned& nloc, unsigned& nx) {
    const unsigned G = gridDim.x * gridDim.y * gridDim.z;
    unsigned sum, cnt, mine, sp = 0u;
    for (;;) {
        sum = 0u; cnt = 0u; mine = 0u;
#pragma unroll
        for (unsigned j = 0; j < 16; ++j) { const unsigned c = xb_ld(&bar[XB_XCNT(j)]); sum += c; cnt += (c > 0u) ? 1u : 0u; mine = (j == x) ? c : mine; }
        if (sum == G) break;
        __builtin_amdgcn_s_sleep(1);
        if ((++sp & 255u) == 0u) { if (xb_ld(&bar[XB_TMO])) break; if (sp > XB_SPIN_CAP) { atomicAdd(&bar[XB_TMO], 1u); break; } }
    }
    nloc = mine > 0u ? mine : 1u; nx = cnt > 0u ? cnt : 1u;
}

__device__ __forceinline__ void xcd_barrier(const XcdBarrier& b, int tid_in) {
    asm volatile("s_waitcnt vmcnt(0)" ::: "memory");
    __syncthreads();
    if (tid_in == 0) {
        unsigned* bar = b.bar;
        __builtin_amdgcn_s_waitcnt(0);
        unsigned nloc = b.st[0], nx = b.st[1];
        if (nloc == 0u) { xcd_barrier_complete(bar, b.x, nloc, nx); b.st[0] = nloc; b.st[1] = nx; }
        const unsigned old = xb_add(&bar[XB_XSUB(b.x)], 1u);
        const unsigned gen = old / nloc;
        if (old + 1u == (gen + 1u) * nloc) {
            __builtin_amdgcn_fence(__ATOMIC_RELEASE, "agent");
            asm volatile("s_waitcnt vmcnt(0)" ::: "memory");
            const unsigned og = xb_add(&bar[XB_TOP], 1u);
            const unsigned tg = og / nx;
            if (og + 1u == (tg + 1u) * nx) xb_add(&bar[XB_TOPGEN], 1u);
            else XB_SPIN(xb_ld(&bar[XB_TOPGEN]) == tg, bar);
            __builtin_amdgcn_fence(__ATOMIC_ACQUIRE, "agent");
            xb_add(&bar[XB_XGEN(b.x)], 1u);
            asm volatile("s_waitcnt vmcnt(0)" ::: "memory");
        } else {
            XB_SPIN(xb_ld(&bar[XB_XGEN(b.x)]) == gen, bar);
            __builtin_amdgcn_fence(__ATOMIC_ACQUIRE, "agent");
            asm volatile("s_waitcnt vmcnt(0)" ::: "memory");
        }
    }
    __syncthreads();
}
namespace pg8 {
#define PG8_LAS __attribute__((address_space(3)))
typedef unsigned short bf16_t;
typedef short bf16x8 __attribute__((ext_vector_type(8)));
typedef float f32x4 __attribute__((ext_vector_type(4)));
typedef unsigned u32x4 __attribute__((ext_vector_type(4)));
constexpr int BM = 256, BK = 64, HALF = 128, HTB = HALF * BK * 2  , STAGE_BYTES = 8 * HTB, NXCD = 8, WGM = 8;

__host__ __device__ __forceinline__ int lds_byte(int r, int c) { const int st = (r >> 4) * 2 + (c >> 5), rr = r & 15, cc = c & 31, ob = rr * 64 + cc * 2; return st * 1024 + (ob ^ (((ob >> 9) & 1) << 5)); }
__host__ __device__ __forceinline__ void stage_rc(int b, int& R, int& C) { const int st = b / 1024, sb = b % 1024, swz = sb ^ (((sb >> 9) & 1) << 5); R = (st >> 1) * 16 + swz / 64; C = (st & 1) * 32 + (swz % 64) / 2; }
__host__ __device__ __forceinline__ int perm32(int rho) { const int n = rho >> 4, i = rho & 15; return 8 * (i >> 2) + 4 * n + (i & 3); }

struct Unit { int pm, pn; };
struct Gemm { const bf16_t* A; const bf16_t* Bt; int M, N, K; };

struct StaticOrder {
    int nM, nN, nwg, G, c;
    __host__ __device__ void init(int M, int N, int G_, int c_) { nM = M / BM; nN = N / BM; nwg = nM * nN; G = G_; c = c_; }
    __host__ __device__ bool next(int i, Unit& u) const {
        const long L = (long)i * G + c; if (L >= nwg) return false;
        int wgid = (int)L; { const int q = nwg / NXCD, r = nwg % NXCD, xcd = wgid % NXCD, off = wgid / NXCD; wgid = (xcd < r ? xcd * (q + 1) : r * (q + 1) + (xcd - r) * q) + off; }
        const int nig = WGM * nN, gid = wgid / nig, fm = gid * WGM, gsz = (nM - fm) < WGM ? (nM - fm) : WGM;
        u.pm = fm + ((wgid % nig) % gsz); u.pn = (wgid % nig) / gsz; return true;
    }
    __device__ __forceinline__ void a_ready(const Unit&) const {}
    __device__ __forceinline__ void done(const Unit&) const {}
};
struct CountedOrder : StaticOrder {
    const unsigned* ready; unsigned need; unsigned* tmo;
    __device__ __forceinline__ void a_ready(const Unit& u) const {
        if (threadIdx.x < 64) {
            const unsigned long long t0 = __builtin_amdgcn_s_memrealtime(); unsigned polls = 0;
            while ((unsigned)__builtin_amdgcn_readfirstlane(__hip_atomic_load(ready + 64 * u.pm, __ATOMIC_RELAXED, __HIP_MEMORY_SCOPE_AGENT)) < need) {
                if ((++polls & 255u) == 0u && __builtin_amdgcn_readfirstlane(__hip_atomic_load(tmo, __ATOMIC_RELAXED, __HIP_MEMORY_SCOPE_AGENT)) != 0u) break;
                if (__builtin_amdgcn_s_memrealtime() - t0 > 2000000ull) {
                    if (threadIdx.x == 0) { unsigned expect = 0u; __hip_atomic_compare_exchange_strong(tmo + 1, &expect, 0x600u | (unsigned)(u.pm & 0xff), __ATOMIC_RELAXED, __ATOMIC_RELAXED, __HIP_MEMORY_SCOPE_AGENT); __hip_atomic_store(tmo, 1u, __ATOMIC_RELAXED, __HIP_MEMORY_SCOPE_AGENT); }
                    break; }
                __builtin_amdgcn_s_sleep(2); }
            __builtin_amdgcn_fence(__ATOMIC_ACQUIRE, "agent");
            asm volatile("s_waitcnt vmcnt(0)" ::: "memory");
        }
#if !defined(BROKEN_HOOK_NO_BARRIER)
        asm volatile("" ::: "memory"); __builtin_amdgcn_s_barrier(); asm volatile("" ::: "memory");
#endif
    }
};

__device__ __forceinline__ unsigned cvt_pk_bf16(float lo, float hi) { unsigned r; asm volatile("v_cvt_pk_bf16_f32 %0, %1, %2" : "=v"(r) : "v"(lo), "v"(hi)); return r; }
typedef float f32x2 __attribute__((ext_vector_type(2)));
__device__ __forceinline__ f32x2 gelu_pk(f32x2 v) {
    const f32x2 av = __builtin_elementwise_abs(v), d = av * 0.2316418882f + 1.0f;
    f32x2 t; t.x = __builtin_amdgcn_rcpf(d.x); t.y = __builtin_amdgcn_rcpf(d.y);
    f32x2 q = t * 0.5307027145f + (-0.7265760135f); q = q * t + 0.7107068705f; q = q * t + (-0.142248368f); q = q * t + 0.127414796f; q = q * t;
    const f32x2 s = (v * v) * (-0.72134752044f);
    f32x2 e; e.x = __builtin_amdgcn_exp2f(s.x); e.y = __builtin_amdgcn_exp2f(s.y);
    const f32x2 m = v * (q * e), r = v - m;
    f32x2 o; o.x = v.x < 0.f ? m.x : r.x; o.y = v.y < 0.f ? m.y : r.y; return o;
}

struct EpiF32 {
    static constexpr bool PERM = false, AFTER_DRAIN = false;
    float* C; int ldc; const float* bias;
    __device__ __forceinline__ void operator()(const f32x4 (&acc)[2][2][4][2], const Unit& u, int wr, int wc, int fr, int fq) const {
        const int row0 = u.pm * BM + wr * 64 + fr, col0 = u.pn * BM + wc * 32 + 4 * fq;
        f32x4 bv[2][2];
#pragma unroll
        for (int bj = 0; bj < 2; ++bj)
#pragma unroll
            for (int n = 0; n < 2; ++n) bv[bj][n] = bias ? *(const f32x4*)(bias + col0 + bj * HALF + n * 16) : (f32x4){0.f, 0.f, 0.f, 0.f};
#pragma unroll
        for (int ai = 0; ai < 2; ++ai)
#pragma unroll
            for (int m = 0; m < 4; ++m) { float* rowp = C + (size_t)(row0 + ai * HALF + m * 16) * ldc + col0;
#pragma unroll
                for (int bj = 0; bj < 2; ++bj)
#pragma unroll
                    for (int n = 0; n < 2; ++n) *(f32x4*)(rowp + bj * HALF + n * 16) = acc[ai][bj][m][n] + bv[bj][n]; }
    }
};
template <int ACT  > struct EpiBf16 {
    static constexpr bool PERM = true, AFTER_DRAIN = false;
    bf16_t* O; int ldc; const float* bias; int split_cols; size_t split_stride;
    __device__ __forceinline__ void operator()(const f32x4 (&acc)[2][2][4][2], const Unit& u, int wr, int wc, int fr, int fq) const {
        const int row0 = u.pm * BM + wr * 64 + fr; int colt = u.pn * BM; bf16_t* base = O;
        if (split_cols) { const int t = colt / split_cols; base += (size_t)t * split_stride; colt -= t * split_cols; }
        const int col0 = colt + wc * 32 + 8 * fq, bcol0 = u.pn * BM + wc * 32 + 8 * fq;
        f32x4 bv[2][2];
#pragma unroll
        for (int bj = 0; bj < 2; ++bj)
#pragma unroll
            for (int n = 0; n < 2; ++n) bv[bj][n] = bias ? *(const f32x4*)(bias + bcol0 + bj * HALF + 4 * n) : (f32x4){0.f, 0.f, 0.f, 0.f};
#pragma unroll
        for (int ai = 0; ai < 2; ++ai)
#pragma unroll
            for (int m = 0; m < 4; ++m) { bf16_t* rowp = base + (size_t)(row0 + ai * HALF + m * 16) * ldc + col0;
#pragma unroll
                for (int bj = 0; bj < 2; ++bj) { f32x4 v0 = acc[ai][bj][m][0] + bv[bj][0], v1 = acc[ai][bj][m][1] + bv[bj][1];
                    if (ACT == 1) { f32x2 a = gelu_pk((f32x2){v0[0], v0[1]}), b = gelu_pk((f32x2){v0[2], v0[3]}), c = gelu_pk((f32x2){v1[0], v1[1]}), d = gelu_pk((f32x2){v1[2], v1[3]});
                        v0 = (f32x4){a.x, a.y, b.x, b.y}; v1 = (f32x4){c.x, c.y, d.x, d.y}; }
                    if (ACT == 2) {
#pragma unroll
                        for (int j = 0; j < 4; ++j) { v0[j] = 0.5f * v0[j] * (1.0f + erff(v0[j] * 0.70710678f)); v1[j] = 0.5f * v1[j] * (1.0f + erff(v1[j] * 0.70710678f)); } }
                    u32x4 w; w.x = cvt_pk_bf16(v0[0], v0[1]); w.y = cvt_pk_bf16(v0[2], v0[3]); w.z = cvt_pk_bf16(v1[0], v1[1]); w.w = cvt_pk_bf16(v1[2], v1[3]);
                    *(u32x4*)(rowp + bj * HALF) = w; } }
    }
};
struct EpiResF32 {
    static constexpr bool PERM = false, AFTER_DRAIN = false;
    float* C; const float* R; int ldc;
    __device__ __forceinline__ void operator()(const f32x4 (&acc)[2][2][4][2], const Unit& u, int wr, int wc, int fr, int fq) const {
        typedef __attribute__((address_space(1))) const f32x4 GCV; typedef __attribute__((address_space(1))) f32x4 GV;
        const int row0 = u.pm * BM + wr * 64 + fr, col0 = u.pn * BM + wc * 32 + 4 * fq;
#pragma unroll
        for (int ai = 0; ai < 2; ++ai)
#pragma unroll
            for (int mp = 0; mp < 2; ++mp) {
                f32x4 r[2][2][2];
#pragma unroll
                for (int mi = 0; mi < 2; ++mi) { const size_t off = (size_t)(row0 + ai * HALF + (mp * 2 + mi) * 16) * ldc + col0;
#pragma unroll
                    for (int bj = 0; bj < 2; ++bj)
#pragma unroll
                        for (int n = 0; n < 2; ++n) r[mi][bj][n] = *(GCV*)(R + off + bj * HALF + n * 16); }
                __builtin_amdgcn_sched_barrier(0);
#pragma unroll
                for (int mi = 0; mi < 2; ++mi) { const size_t off = (size_t)(row0 + ai * HALF + (mp * 2 + mi) * 16) * ldc + col0;
#pragma unroll
                    for (int bj = 0; bj < 2; ++bj)
#pragma unroll
                        for (int n = 0; n < 2; ++n) *(GV*)(C + off + bj * HALF + n * 16) = acc[ai][bj][mp * 2 + mi][n] + r[mi][bj][n]; }
                __builtin_amdgcn_sched_barrier(0);
            }
    }
};
template <class Epi, class Sched, bool STAMP = false>
__device__ __forceinline__ void gemm_phase(PG8_LAS unsigned char* lds, const Gemm g, const Sched& S, const Epi& E, unsigned long long* stamps, int tid_in) {
    const int tid = tid_in, wid = __builtin_amdgcn_readfirstlane(tid >> 6), lane = tid & 63, wr = wid >> 2, wc = wid & 3, fr = lane & 15, fq = lane >> 4;
    const int K = g.K, nt = K / BK;
    int ts_lo = 0, ts_hi = 0, nts = 0; const unsigned long long rt_entry = STAMP ? (unsigned long long)wall_clock64() : 0ull;
#define PG8_STAMP() do { if (STAMP && wid == 0 && nts < 64) { const unsigned long long _c = (unsigned long long)clock64(); \
        ts_lo = (lane == nts) ? (int)(unsigned)_c : ts_lo; ts_hi = (lane == nts) ? (int)(unsigned)(_c >> 32) : ts_hi; ++nts; } } while (0)
    PG8_STAMP();
    unsigned voffA[2], voffB[2];
#pragma unroll
    for (int i = 0; i < 2; ++i) { int R, C; stage_rc(tid * 16 + i * 8192, R, C); const int Rb = Epi::PERM ? ((R & ~31) + perm32(R & 31)) : R;
        voffA[i] = (unsigned)(R * K + C) * 2u; voffB[i] = (unsigned)(Rb * K + C) * 2u; }
    const size_t kstep = (size_t)(BK * 2);
    const size_t hstep = (size_t)HALF * K * 2;
    const size_t tstep = 2 * hstep;
    const unsigned ldsw = (unsigned)wid * 1024u;
    const int aoff = lds_byte(wr * 64 + fr, fq * 8), boff = lds_byte(wc * 32 + fr, fq * 8);
#define PG8_SA(b, h) (((b) * 2 + (h)) * HTB)
#define PG8_SB(b, h) ((4 + (b) * 2 + (h)) * HTB)
#define PG8_STAGE(bufoff, gbase, voff) do { _Pragma("unroll") for (int _i = 0; _i < 2; ++_i) \
        __builtin_amdgcn_global_load_lds((const unsigned*)((const char*)(gbase) + (voff)[_i]), (PG8_LAS unsigned*)(lds + (bufoff) + ldsw + _i * 8192), 16, 0, 0); } while (0)
#define PG8_LDA(dst, b, h) do { _Pragma("unroll") for (int m = 0; m < 4; ++m) _Pragma("unroll") for (int k = 0; k < 2; ++k) dst[m][k] = *(const PG8_LAS bf16x8*)(lds + PG8_SA(b, h) + aoff + m * 2048 + k * 1024); } while (0)
#define PG8_LDB(dst, b, h) do { _Pragma("unroll") for (int n = 0; n < 2; ++n) _Pragma("unroll") for (int k = 0; k < 2; ++k) dst[n][k] = *(const PG8_LAS bf16x8*)(lds + PG8_SB(b, h) + boff + n * 2048 + k * 1024); } while (0)
#define PG8_MMA(ai, bj, At, Bt) do { __builtin_amdgcn_s_setprio(1); _Pragma("unroll") for (int m = 0; m < 4; ++m) _Pragma("unroll") for (int n = 0; n < 2; ++n) _Pragma("unroll") for (int k = 0; k < 2; ++k) \
        acc[ai][bj][m][n] = __builtin_amdgcn_mfma_f32_16x16x32_bf16(Bt[n][k], At[m][k], acc[ai][bj][m][n], 0, 0, 0); __builtin_amdgcn_s_setprio(0); } while (0)
#define PG8_WAIT_V(n) asm volatile("s_waitcnt vmcnt(" #n ")" ::: "memory")
#define PG8_WAIT_L(n) asm volatile("s_waitcnt lgkmcnt(" #n ")" ::: "memory")
#define PG8_BAR __builtin_amdgcn_s_barrier()
#define PG8_SCHED __builtin_amdgcn_sched_barrier(0)
    Unit cur, nxt; int ui = 0;
    if (!S.next(0, cur)) return;
    f32x4 acc[2][2][4][2];
#pragma unroll
    for (int a = 0; a < 2; ++a)
#pragma unroll
        for (int b = 0; b < 2; ++b)
#pragma unroll
            for (int m = 0; m < 4; ++m)
#pragma unroll
                for (int n = 0; n < 2; ++n) acc[a][b][m][n] = (f32x4){0.f, 0.f, 0.f, 0.f};
    bf16x8 At[4][2], B0[2][2], B1[2][2];
    const char* cA = (const char*)g.A + (size_t)cur.pm * tstep; const char* cB = (const char*)g.Bt + (size_t)cur.pn * tstep;
    S.a_ready(cur);
    PG8_STAGE(PG8_SB(0, 0), cB, voffB); PG8_STAGE(PG8_SA(0, 0), cA, voffA); PG8_STAGE(PG8_SB(0, 1), cB + hstep, voffB); PG8_STAGE(PG8_SA(0, 1), cA + hstep, voffA);
    if (wr == 1) PG8_BAR;
    PG8_WAIT_V(4); PG8_BAR;
    PG8_STAGE(PG8_SB(1, 0), cB + kstep, voffB); PG8_STAGE(PG8_SA(1, 0), cA + kstep, voffA); PG8_STAGE(PG8_SB(1, 1), cB + hstep + kstep, voffB);
    PG8_WAIT_V(6); PG8_BAR;
    PG8_STAMP();
    for (;;) {
        const bool has_next = S.next(ui + 1, nxt);
        const char* nA = has_next ? (const char*)g.A + (size_t)nxt.pm * tstep : cA; const char* nB = has_next ? (const char*)g.Bt + (size_t)nxt.pn * tstep : cB;
        for (int t = 0; t < nt; t += 2) {
            const bool last = (t == nt - 2);
            const char* a1 = cA + (size_t)(t + 1) * kstep;
            const char* a2 = last ? nA : cA + (size_t)(t + 2) * kstep; const char* b2 = last ? nB : cB + (size_t)(t + 2) * kstep;
            const char* a3 = a2 + kstep; const char* b3 = b2 + kstep;
            if (last && has_next) S.a_ready(nxt);
            PG8_LDB(B0, 0, 0); PG8_SCHED; PG8_LDA(At, 0, 0); PG8_STAGE(PG8_SA(1, 1), a1 + hstep, voffA);
            PG8_WAIT_L(8); PG8_BAR; PG8_WAIT_L(0); PG8_MMA(0, 0, At, B0); PG8_BAR; PG8_SCHED;
            PG8_LDB(B1, 0, 1); PG8_STAGE(PG8_SB(0, 0), b2, voffB);
            PG8_BAR; PG8_WAIT_L(0); PG8_MMA(0, 1, At, B1); PG8_BAR;
            PG8_LDA(At, 0, 1); PG8_STAGE(PG8_SA(0, 0), a2, voffA);
            PG8_BAR; PG8_WAIT_L(0); PG8_MMA(1, 0, At, B0); PG8_BAR; PG8_SCHED;
            PG8_STAGE(PG8_SB(0, 1), b2 + hstep, voffB);
            PG8_WAIT_V(6); PG8_BAR; PG8_MMA(1, 1, At, B1); PG8_BAR;
            PG8_LDB(B0, 1, 0); PG8_SCHED; PG8_LDA(At, 1, 0); PG8_STAGE(PG8_SA(0, 1), a2 + hstep, voffA);
            PG8_WAIT_L(8); PG8_BAR; PG8_WAIT_L(0); PG8_MMA(0, 0, At, B0); PG8_BAR; PG8_SCHED;
            PG8_LDB(B1, 1, 1); PG8_STAGE(PG8_SB(1, 0), b3, voffB);
            PG8_BAR; PG8_WAIT_L(0); PG8_MMA(0, 1, At, B1); PG8_BAR;
            PG8_LDA(At, 1, 1); PG8_STAGE(PG8_SA(1, 0), a3, voffA);
            PG8_BAR; PG8_WAIT_L(0); PG8_MMA(1, 0, At, B0); PG8_BAR; PG8_SCHED;
            PG8_STAGE(PG8_SB(1, 1), b3 + hstep, voffB);
            PG8_WAIT_V(6); PG8_BAR; PG8_MMA(1, 1, At, B1); PG8_BAR;
        }
        PG8_STAMP();
        if constexpr (!Epi::AFTER_DRAIN) { E(acc, cur, wr, wc, fr, fq); S.done(cur); }
        PG8_STAMP();
        if (!has_next) break;
#pragma unroll
        for (int a = 0; a < 2; ++a)
#pragma unroll
            for (int b = 0; b < 2; ++b)
#pragma unroll
                for (int m = 0; m < 4; ++m)
#pragma unroll
                    for (int n = 0; n < 2; ++n) acc[a][b][m][n] = (f32x4){0.f, 0.f, 0.f, 0.f};
        cur = nxt; cA = nA; cB = nB; ++ui;
    }
    PG8_WAIT_V(0);
    if (wr == 0) PG8_BAR;
    PG8_BAR;
    if constexpr (Epi::AFTER_DRAIN) { E.fused(acc, cur, wr, wc, fr, fq, lds, wid, lane); S.done(cur); }
    PG8_STAMP();
    if (STAMP && wid == 0) { stamps[lane] = lane < nts ? (((unsigned long long)(unsigned)ts_hi << 32) | (unsigned)ts_lo) : 0ull;
        if (lane == 62) stamps[62] = rt_entry; if (lane == 63) stamps[63] = (unsigned long long)wall_clock64(); }
#undef PG8_STAMP
#undef PG8_SA
#undef PG8_SB
#undef PG8_STAGE
#undef PG8_LDA
#undef PG8_LDB
#undef PG8_MMA
#undef PG8_WAIT_V
#undef PG8_WAIT_L
#undef PG8_BAR
#undef PG8_SCHED
}
}

constexpr int T_TOK = 16384, DM = 2048, SEQ = 4096, NBATCH = 4, DEPTH = 2;
constexpr int INW = 5656;
constexpr int N1 = 4352;
constexpr int NV = 1536;
constexpr int C_MQ = 0, C_MK = 512, C_DQ = 1024, C_DK = 1536, C_NQ = 2048, C_KC = 3072, C_VC = 3328, C_KS = 3584, C_KW = 3840, C_GATE = 4096;
constexpr int R_MV = 0, R_DV = 512, R_VS = 1024, R_VW = 1280;
constexpr float LOG2E = 1.4426950408889634f;
constexpr float ATT_C128 = 0.08838834764831845f * LOG2E;
constexpr float ATT_C64 = 0.125f * LOG2E;

__device__ const unsigned char T5B[128] = {0, 1, 2, 3, 4, 5, 6, 7, 8, 9, 10, 11, 12, 13, 14, 15, 16, 16, 16, 17, 17, 18, 18, 18, 19, 19, 19, 20, 20, 20, 20, 21, 21, 21, 21, 22, 22, 22, 22, 22, 23, 23, 23, 23, 23, 23, 24, 24, 24, 24, 24, 24, 25, 25, 25, 25, 25, 25, 25, 26, 26, 26, 26, 26, 26, 26, 26, 27, 27, 27, 27, 27, 27, 27, 27, 27, 27, 28, 28, 28, 28, 28, 28, 28, 28, 28, 28, 29, 29, 29, 29, 29, 29, 29, 29, 29, 29, 29, 29, 30, 30, 30, 30, 30, 30, 30, 30, 30, 30, 30, 30, 30, 30, 31, 31, 31, 31, 31, 31, 31, 31, 31, 31, 31, 31, 31, 31, 31};

constexpr size_t al256(size_t x) { return (x + 255) & ~(size_t)255; }
constexpr size_t WS_CTL = 0;
constexpr size_t CTL_BYTES = 32768;
constexpr size_t WS_BIAS = WS_CTL + CTL_BYTES;
constexpr size_t WS_LAM = WS_BIAS + al256(16 * 132 * 4);
constexpr size_t WS_CB = WS_LAM + 256;
constexpr size_t WS_WT1 = WS_CB + 2048;
constexpr size_t WS_WTV = WS_WT1 + (size_t)DEPTH * N1 * DM * 2;
constexpr size_t WS_WTO = WS_WTV + (size_t)DEPTH * NV * DM * 2;
constexpr size_t WS_WTQ = WS_WTO + (size_t)DEPTH * DM * DM * 2;
constexpr size_t WS_WCT = WS_WTQ + (size_t)DEPTH * DM * DM * 2;
constexpr size_t WS_SKB = WS_WCT + (size_t)DEPTH * 2 * 128 * 4096 * 2;
constexpr size_t WS_UB = WS_SKB + (size_t)DEPTH * 8 * 2 * 128 * 128 * 2;
constexpr size_t WS_VB = WS_UB + (size_t)DEPTH * 16384 * DM;
constexpr size_t WS_SCU = WS_VB + (size_t)DEPTH * 16384 * DM;
constexpr size_t WS_SCV = WS_SCU + (size_t)DEPTH * 16384 * 4;
constexpr size_t WS_HN = WS_SCV + (size_t)DEPTH * 16384 * 4;
constexpr size_t WS_PROJ = WS_HN + (size_t)T_TOK * DM * 2;
constexpr size_t WS_VT = WS_PROJ + (size_t)T_TOK * N1 * 2;
constexpr size_t WS_OMIX = WS_VT + (size_t)NV * T_TOK * 2;
constexpr size_t WS_OC = WS_OMIX + (size_t)T_TOK * DM * 2;
constexpr size_t WS_OW = WS_OC + (size_t)T_TOK * 1024 * 2;
constexpr size_t WS_XW = WS_OW + (size_t)T_TOK * 1024 * 2;
constexpr size_t WS_KCMP = WS_XW + (size_t)T_TOK * DM * 4;
constexpr size_t WS_VCMPT = WS_KCMP + (size_t)8 * 256 * 128 * 2;
constexpr size_t WS_KMEAN = WS_VCMPT + (size_t)8 * 128 * 256 * 2;
constexpr size_t WS_SELM = WS_KMEAN + (size_t)16 * 16 * 128 * 2;
constexpr size_t WS_EIDX = WS_SELM + (size_t)8 * 4096 * 8;
constexpr size_t WS_EGATE = WS_EIDX + (size_t)T_TOK * 128 * 4;
constexpr size_t WS_END = WS_EGATE + (size_t)T_TOK * 128 * 4;
static_assert(WS_END <= (size_t)1 << 30, "workspace over 1 GiB");

constexpr int CW_BAR = 0;
constexpr int CW_Q = 4096;
#define CWQ(i) (CW_Q + 64 * (i))

constexpr int LDS_MISC = 162816;
constexpr int LDS_BYTES = LDS_MISC + 1024;

struct Params {
    const float* x; const float* rel_bias; const float* attn_norm; const float* w_in; const float* diff_lambda; const float* diff_subln;
    const float* cmp_pos; const float* cmp_w; const float* w_out; const float* ffn_norm; const float* peer_wq; const float* peer_subkeys;
    const float* peer_u; const float* peer_v; const float* final_norm;
    float* out; unsigned char* ws;
};

#define GAS __attribute__((address_space(1)))
template <class T> __device__ __forceinline__ T gld(const void* p) { return *(const GAS T*)p; }
template <class T> __device__ __forceinline__ void gst(void* p, T v) { *(GAS T*)p = v; }
__device__ __forceinline__ unsigned cvt_pk_bf16(float lo, float hi) { unsigned r; asm volatile("v_cvt_pk_bf16_f32 %0, %1, %2" : "=v"(r) : "v"(lo), "v"(hi)); return r; }
__device__ __forceinline__ float bf_lo(unsigned u) { return __uint_as_float(u << 16); }
__device__ __forceinline__ float bf_hi(unsigned u) { return __uint_as_float(u & 0xffff0000u); }
__device__ __forceinline__ float pmax32(float v) { const auto r = __builtin_amdgcn_permlane32_swap(__float_as_uint(v), __float_as_uint(v), false, false); return fmaxf(__uint_as_float(r[0]), __uint_as_float(r[1])); }
__device__ __forceinline__ float psum32(float v) { const auto r = __builtin_amdgcn_permlane32_swap(__float_as_uint(v), __float_as_uint(v), false, false); return __uint_as_float(r[0]) + __uint_as_float(r[1]); }
__device__ __forceinline__ unsigned por32(unsigned v) { const auto r = __builtin_amdgcn_permlane32_swap(v, v, false, false); return r[0] | r[1]; }
template <int M> __device__ __forceinline__ float swz_xor(float v) { return __int_as_float(__builtin_amdgcn_ds_swizzle(__float_as_int(v), (M << 10) | 0x1f)); }
template <int M> __device__ __forceinline__ unsigned swz_xor_u(unsigned v) { return (unsigned)__builtin_amdgcn_ds_swizzle((int)v, (M << 10) | 0x1f); }
__device__ __forceinline__ float wave_sum(float v) {
    v = psum32(v); v += swz_xor<16>(v); v += swz_xor<8>(v); v += swz_xor<4>(v); v += swz_xor<2>(v); v += swz_xor<1>(v);
    return v;
}
__device__ __forceinline__ float wave_max(float v) {
    v = pmax32(v); v = fmaxf(v, swz_xor<16>(v)); v = fmaxf(v, swz_xor<8>(v)); v = fmaxf(v, swz_xor<4>(v)); v = fmaxf(v, swz_xor<2>(v)); v = fmaxf(v, swz_xor<1>(v));
    return v;
}

struct Ctx {
    LAS unsigned char* lds;
    int tid, lane, wave, G, bid;
    unsigned* ctl;
};

#ifndef PEER_FMT_U
#define PEER_FMT_U 6
#endif
#ifndef PEER_FMT_V
#define PEER_FMT_V 4
#endif
template <int FMT> struct PeerFmt { static constexpr int ROWB = DM * FMT / 8, LANEB = 32 * FMT / 8; static constexpr float MAXV = FMT == 8 ? 448.0f : (FMT == 6 ? 7.5f : 6.0f); };
typedef unsigned u32x6 __attribute__((ext_vector_type(6)));
typedef float f32x32 __attribute__((ext_vector_type(32)));
__device__ __forceinline__ unsigned enc_fp6(float y) {
    const float a = fabsf(y);
    float c = a < 2.0f ? a * 8.0f : (a < 4.0f ? 16.0f + (a - 2.0f) * 4.0f : 24.0f + (a - 4.0f) * 2.0f);
    unsigned q = (unsigned)__builtin_rintf(c); q = q > 31u ? 31u : q;
    return q | (y < 0.f ? 32u : 0u);
}
template <int FMT> __device__ __forceinline__ void enc32(const float (&y)[32], unsigned (&w)[6]) {
    if (FMT == 4) {
#pragma unroll
        for (int d = 0; d < 4; ++d) { unsigned t = 0u;
            t = __builtin_amdgcn_cvt_scalef32_pk_fp4_f32(t, y[8 * d + 0], y[8 * d + 1], 1.0f, 0);
            t = __builtin_amdgcn_cvt_scalef32_pk_fp4_f32(t, y[8 * d + 2], y[8 * d + 3], 1.0f, 1);
            t = __builtin_amdgcn_cvt_scalef32_pk_fp4_f32(t, y[8 * d + 4], y[8 * d + 5], 1.0f, 2);
            t = __builtin_amdgcn_cvt_scalef32_pk_fp4_f32(t, y[8 * d + 6], y[8 * d + 7], 1.0f, 3);
            w[d] = t; }
        w[4] = 0u; w[5] = 0u;
    } else {
        unsigned long long lo = 0ull, mid = 0ull, hi = 0ull;
#pragma unroll
        for (int i = 0; i < 32; ++i) {
            const unsigned long long q = enc_fp6(y[i]); const int bit = 6 * i;
            if (bit < 64) { lo |= q << bit; if (bit + 6 > 64) mid |= q >> (64 - bit); }
            else if (bit < 128) { mid |= q << (bit - 64); if (bit + 6 > 128) hi |= q >> (128 - bit); }
            else hi |= q << (bit - 128);
        }
        w[0] = (unsigned)lo; w[1] = (unsigned)(lo >> 32); w[2] = (unsigned)mid; w[3] = (unsigned)(mid >> 32); w[4] = (unsigned)hi; w[5] = (unsigned)(hi >> 32);
    }
}
template <int FMT> __device__ __forceinline__ void dec32(const unsigned (&w)[6], f32x2 (&o)[16]) {
    if (FMT == 4) {
#pragma unroll
        for (int d = 0; d < 4; ++d) {
            o[4 * d + 0] = __builtin_amdgcn_cvt_scalef32_pk_f32_fp4(w[d], 1.0f, 0); o[4 * d + 1] = __builtin_amdgcn_cvt_scalef32_pk_f32_fp4(w[d], 1.0f, 1);
            o[4 * d + 2] = __builtin_amdgcn_cvt_scalef32_pk_f32_fp4(w[d], 1.0f, 2); o[4 * d + 3] = __builtin_amdgcn_cvt_scalef32_pk_f32_fp4(w[d], 1.0f, 3);
        }
    } else {
        const u32x6 q = {w[0], w[1], w[2], w[3], w[4], w[5]};
        const f32x32 f = __builtin_amdgcn_cvt_scalef32_pk32_f32_fp6(q, 1.0f);
#pragma unroll
        for (int i = 0; i < 16; ++i) o[i] = (f32x2){f[2 * i], f[2 * i + 1]};
    }
}
__device__ __forceinline__ void ldrow_u6(const unsigned char* p16, int d8, unsigned (&w)[6]) {
    const u32x4 a = gld<u32x4>(p16); const u32x2 b = gld<u32x2>(p16 + d8);
    w[0] = a.x; w[1] = a.y; w[2] = a.z; w[3] = a.w; w[4] = b.x; w[5] = b.y;
}
template <int FMT> __device__ __forceinline__ void ldrow(const unsigned char* p, unsigned (&w)[6]) {
    if (FMT == 4) { const u32x4 v = gld<u32x4>(p); w[0] = v.x; w[1] = v.y; w[2] = v.z; w[3] = v.w; w[4] = 0u; w[5] = 0u; }
    else { const u32x2 a = gld<u32x2>(p), b = gld<u32x2>(p + 8), cc = gld<u32x2>(p + 16); w[0] = a.x; w[1] = a.y; w[2] = b.x; w[3] = b.y; w[4] = cc.x; w[5] = cc.y; }
}

__device__ __forceinline__ void conv_tile_T(const Ctx& c, const float* src, int ld_src, int k0, int src_col0, int nvalid, bf16_t* dst, int ldd, int n0) {
    LAS float* tile = (LAS float*)c.lds;
    const int tid = c.tid;
    {
        const int r = tid >> 4, c4 = (tid & 15) * 4;
#pragma unroll
        for (int i = 0; i < 2; ++i) {
            const int row = r + 32 * i;
            f32x4 v = {0.f, 0.f, 0.f, 0.f};
            if (c4 < nvalid) v = gld<f32x4>(src + (size_t)(k0 + row) * ld_src + src_col0 + c4);
            tile[row * 65 + c4 + 0] = v[0]; tile[row * 65 + c4 + 1] = v[1]; tile[row * 65 + c4 + 2] = v[2]; tile[row * 65 + c4 + 3] = v[3];
        }
    }
    __syncthreads();
    {
        const int n = tid >> 3, kc = (tid & 7) * 8;
        float v[8];
#pragma unroll
        for (int j = 0; j < 8; ++j) v[j] = tile[(kc + j) * 65 + n];
        u32x4 w; w.x = cvt_pk_bf16(v[0], v[1]); w.y = cvt_pk_bf16(v[2], v[3]); w.z = cvt_pk_bf16(v[4], v[5]); w.w = cvt_pk_bf16(v[6], v[7]);
        gst<u32x4>(dst + (size_t)(n0 + n) * ldd + k0 + kc, w);
    }
    __syncthreads();
}

__device__ __forceinline__ int n1_to_src(int n1) {
    if (n1 < 1024) return n1;
    if (n1 < 2048) return n1 + 512;
    if (n1 < 3840) return n1 + 1024;
    if (n1 < 4096) return n1 + 1280;
    return n1 + 1536;
}
__device__ __forceinline__ int nv_to_src(int nv) {
    if (nv < 512) return nv + 1024;
    if (nv < 1024) return nv + 2048;
    if (nv < 1280) return nv + 3840;
    return nv + 4096;
}

constexpr int CONV_STRIPS_A = 65 + 24 + 32 + 32;
constexpr int CONV_JOBS_A = CONV_STRIPS_A * 32;
constexpr int CONV_JOBS_L = CONV_JOBS_A + 4 * 64;

__device__ __forceinline__ void phase_prologue(const Ctx& c, const Params& p) {
    unsigned char* ws = p.ws;
    {
        const int tid = c.tid, lr = tid >> 4, lc4 = (tid & 15) * 4, sn = tid >> 3, skc = (tid & 7) * 8;
        const int njobs = DEPTH * CONV_JOBS_L;
        const float* s0 = nullptr; size_t srow = 0; bool ok = false; bf16_t* d0 = nullptr;
        f32x4 va = {0.f, 0.f, 0.f, 0.f}, vb = va;
        auto decode = [&](int job, const float*& sp, size_t& ld, bool& okk, bf16_t*& dp) {
            const int l = job / CONV_JOBS_L, j = job % CONV_JOBS_L;
            const float* src; int ldsrc, k0, col0, nvalid, ldd, n0; bf16_t* dst;
            if (j < CONV_JOBS_A) {
                const int strip = j >> 5, kt = j & 31; k0 = kt * 64; ldd = DM;
                if (strip < 65) { n0 = strip * 64; src = p.w_in + (size_t)l * DM * INW; ldsrc = INW; col0 = n1_to_src(n0); nvalid = strip < 64 ? 64 : 24; dst = (bf16_t*)(ws + WS_WT1) + (size_t)l * N1 * DM; }
                else if (strip < 89) { n0 = (strip - 65) * 64; src = p.w_in + (size_t)l * DM * INW; ldsrc = INW; col0 = nv_to_src(n0); nvalid = 64; dst = (bf16_t*)(ws + WS_WTV) + (size_t)l * NV * DM; }
                else if (strip < 121) { n0 = (strip - 89) * 64; src = p.w_out + (size_t)l * DM * DM; ldsrc = DM; col0 = n0; nvalid = 64; dst = (bf16_t*)(ws + WS_WTO) + (size_t)l * DM * DM; }
                else { n0 = (strip - 121) * 64; src = p.peer_wq + (size_t)l * DM * DM; ldsrc = DM; col0 = n0; nvalid = 64; dst = (bf16_t*)(ws + WS_WTQ) + (size_t)l * DM * DM; }
            } else {
                const int jj = j - CONV_JOBS_A, strip = jj >> 6, kt = jj & 63, kv = strip >> 1; k0 = kt * 64; n0 = (strip & 1) * 64; ldd = 4096;
                src = p.cmp_w + ((size_t)l * 2 + kv) * 4096 * 128; ldsrc = 128; col0 = n0; nvalid = 64; dst = (bf16_t*)(ws + WS_WCT) + ((size_t)l * 2 + kv) * 128 * 4096;
            }
            sp = src + (size_t)(k0 + lr) * ldsrc + col0 + lc4; ld = (size_t)32 * ldsrc; okk = lc4 < nvalid;
            dp = dst + (size_t)(n0 + sn) * ldd + k0 + skc;
        };
        int job = c.bid;
        if (job < njobs) { decode(job, s0, srow, ok, d0); if (ok) { va = gld<f32x4>(s0); vb = gld<f32x4>(s0 + srow); } }
        for (int it = 0; job < njobs; job += c.G, ++it) {
            LAS float* tile = (LAS float*)(c.lds + (it & 1) * 16896);
            bf16_t* dcur = d0;
            const f32x4 ca = va, cb = vb;
            const int nj = job + c.G;
            if (nj < njobs) { decode(nj, s0, srow, ok, d0); va = (f32x4){0.f, 0.f, 0.f, 0.f}; vb = va; if (ok) { va = gld<f32x4>(s0); vb = gld<f32x4>(s0 + srow); } }
            tile[lr * 65 + lc4 + 0] = ca[0]; tile[lr * 65 + lc4 + 1] = ca[1]; tile[lr * 65 + lc4 + 2] = ca[2]; tile[lr * 65 + lc4 + 3] = ca[3];
            tile[(lr + 32) * 65 + lc4 + 0] = cb[0]; tile[(lr + 32) * 65 + lc4 + 1] = cb[1]; tile[(lr + 32) * 65 + lc4 + 2] = cb[2]; tile[(lr + 32) * 65 + lc4 + 3] = cb[3];
            __syncthreads();
            float v[8];
#pragma unroll
            for (int jx = 0; jx < 8; ++jx) v[jx] = tile[(skc + jx) * 65 + sn];
            u32x4 w; w.x = cvt_pk_bf16(v[0], v[1]); w.y = cvt_pk_bf16(v[2], v[3]); w.z = cvt_pk_bf16(v[4], v[5]); w.w = cvt_pk_bf16(v[6], v[7]);
            gst<u32x4>(dcur, w);
        }
        __syncthreads();
    }
    const size_t gtid = (size_t)c.bid * 512 + c.tid, gthreads = (size_t)c.G * 512;
    for (size_t i = gtid; i < (size_t)DEPTH * 192 * DM / 8; i += gthreads) {
        const size_t l = i / (192 * DM / 8), r = i % (192 * DM / 8);
        gst<u32x4>((bf16_t*)(ws + WS_WT1) + (l * N1 + 4160) * DM + r * 8, (u32x4){0u, 0u, 0u, 0u});
    }
    {
        const int gw = c.bid * 8 + c.wave, nw = c.G * 8, lane = c.lane;
        for (int row = gw; row < 2 * DEPTH * 16384; row += nw) {
            const int tab = row / (DEPTH * 16384), rr = row % (DEPTH * 16384);
            const float* src = (tab ? p.peer_v : p.peer_u) + (size_t)rr * DM + lane * 32;
            float y[32]; float am = 0.f;
#pragma unroll
            for (int i = 0; i < 8; ++i) { const f32x4 v = gld<f32x4>(src + i * 4); y[4 * i] = v[0]; y[4 * i + 1] = v[1]; y[4 * i + 2] = v[2]; y[4 * i + 3] = v[3];
                am = fmaxf(am, fmaxf(fmaxf(fabsf(v[0]), fabsf(v[1])), fmaxf(fabsf(v[2]), fabsf(v[3])))); }
            am = wave_max(am);
            const float mx = tab ? PeerFmt<PEER_FMT_V>::MAXV : PeerFmt<PEER_FMT_U>::MAXV;
            const float sc = am > 0.f ? mx / am : 1.0f;
            if (lane == 0) ((float*)(ws + (tab ? WS_SCV : WS_SCU)))[rr] = am > 0.f ? am / mx : 1.0f;
#pragma unroll
            for (int i = 0; i < 32; ++i) y[i] *= sc;
            unsigned w[6];
            if (tab) {
                enc32<PEER_FMT_V>(y, w);
                unsigned char* dst = ws + WS_VB + (size_t)rr * PeerFmt<PEER_FMT_V>::ROWB + lane * PeerFmt<PEER_FMT_V>::LANEB;
                if (PEER_FMT_V == 4) gst<u32x4>(dst, (u32x4){w[0], w[1], w[2], w[3]});
                else { gst<u32x2>(dst, (u32x2){w[0], w[1]}); gst<u32x2>(dst + 8, (u32x2){w[2], w[3]}); gst<u32x2>(dst + 16, (u32x2){w[4], w[5]}); }
            } else {
                enc32<PEER_FMT_U>(y, w);
                unsigned char* dst = ws + WS_UB + (size_t)rr * PeerFmt<PEER_FMT_U>::ROWB + lane * PeerFmt<PEER_FMT_U>::LANEB;
                if (PEER_FMT_U == 4) gst<u32x4>(dst, (u32x4){w[0], w[1], w[2], w[3]});
                else {
                    unsigned char* d6 = ws + WS_UB + (size_t)rr * PeerFmt<PEER_FMT_U>::ROWB + (lane >> 3) * 192;
                    gst<u32x4>(d6 + (lane & 7) * 16, (u32x4){w[0], w[1], w[2], w[3]}); gst<u32x2>(d6 + 128 + (lane & 7) * 8, (u32x2){w[4], w[5]});
                }
            }
        }
        const size_t m8 = (size_t)DEPTH * 8 * 2 * 128 * 128 / 8;
        const float* ss = p.peer_subkeys; bf16_t* ds = (bf16_t*)(ws + WS_SKB);
        for (size_t i = gtid; i < m8; i += gthreads) {
            const f32x4 a = gld<f32x4>(ss + i * 8), b = gld<f32x4>(ss + i * 8 + 4);
            u32x4 w; w.x = cvt_pk_bf16(a[0], a[1]); w.y = cvt_pk_bf16(a[2], a[3]); w.z = cvt_pk_bf16(b[0], b[1]); w.w = cvt_pk_bf16(b[2], b[3]);
            gst<u32x4>(ds + i * 8, w);
        }
    }
    if (c.bid >= c.G - 4) {
        const int lk = c.bid - (c.G - 4), e = c.tid & 127, kq = c.tid >> 7;
        const float* pos = p.cmp_pos + (size_t)lk * 4096 + kq * 1024;
        const float* w = p.cmp_w + (size_t)lk * 4096 * 128 + (size_t)kq * 1024 * 128 + e;
        float s = 0.f;
#pragma unroll 8
        for (int k = 0; k < 1024; ++k) s = fmaf(pos[k], w[(size_t)k * 128], s);
        LAS float* red = (LAS float*)(c.lds + 32768);
        red[c.tid] = s;
        __syncthreads();
        if (c.tid < 128) ((float*)(ws + WS_CB))[lk * 128 + c.tid] = (red[c.tid] + red[128 + c.tid]) + (red[256 + c.tid] + red[384 + c.tid]);
    }
    if (c.bid == 0) {
        float* bt = (float*)(ws + WS_BIAS);
        for (int i = c.tid; i < 16 * 132; i += 512) {
            const int h = i / 132, d = i % 132;
            const int bucket = d < 128 ? (int)T5B[d] : 31;
            bt[i] = p.rel_bias[bucket * 16 + h] * LOG2E;
        }
        if (c.tid < DEPTH) {
            const float* lp = p.diff_lambda + (size_t)c.tid * 4 * 64;
            float s1 = 0.f, s2 = 0.f;
            for (int i = 0; i < 64; ++i) { s1 += lp[i] * lp[64 + i]; s2 += lp[128 + i] * lp[192 + i]; }
            const float lam_init = 0.8f - 0.6f * expf(-0.3f * (float)c.tid);
            ((float*)(ws + WS_LAM))[c.tid] = expf(s1) - expf(s2) + lam_init;
        }
    }
}

__device__ __forceinline__ void phase_rmsnorm_bf16(const Ctx& c, const float* x, const float* gain, bf16_t* out) {
    const int gw = c.bid * 8 + c.wave, nw = c.G * 8, lane = c.lane;
    f32x4 g[8];
#pragma unroll
    for (int i = 0; i < 8; ++i) g[i] = gld<f32x4>(gain + i * 256 + lane * 4);
    for (int row = gw; row < T_TOK; row += nw) {
        const float* xr = x + (size_t)row * DM;
        f32x4 v[8]; float ss = 0.f;
#pragma unroll
        for (int i = 0; i < 8; ++i) { v[i] = gld<f32x4>(xr + i * 256 + lane * 4); ss += v[i][0] * v[i][0] + v[i][1] * v[i][1] + v[i][2] * v[i][2] + v[i][3] * v[i][3]; }
        ss = wave_sum(ss);
        const float rstd = rsqrtf(ss * (1.0f / DM) + 1e-6f);
        bf16_t* orow = out + (size_t)row * DM;
#pragma unroll
        for (int i = 0; i < 8; ++i) {
            u32x2 w; w.x = cvt_pk_bf16(v[i][0] * rstd * g[i][0], v[i][1] * rstd * g[i][1]); w.y = cvt_pk_bf16(v[i][2] * rstd * g[i][2], v[i][3] * rstd * g[i][3]);
            gst<u32x2>(orow + i * 256 + lane * 4, w);
        }
    }
}
__device__ __forceinline__ void phase_rmsnorm_f32(const Ctx& c, const float* x, const float* gain, float* out) {
    const int gw = c.bid * 8 + c.wave, nw = c.G * 8, lane = c.lane;
    f32x4 g[8];
#pragma unroll
    for (int i = 0; i < 8; ++i) g[i] = gld<f32x4>(gain + i * 256 + lane * 4);
    for (int row = gw; row < T_TOK; row += nw) {
        const float* xr = x + (size_t)row * DM;
        f32x4 v[8]; float ss = 0.f;
#pragma unroll
        for (int i = 0; i < 8; ++i) { v[i] = gld<f32x4>(xr + i * 256 + lane * 4); ss += v[i][0] * v[i][0] + v[i][1] * v[i][1] + v[i][2] * v[i][2] + v[i][3] * v[i][3]; }
        ss = wave_sum(ss);
        const float rstd = rsqrtf(ss * (1.0f / DM) + 1e-6f);
        float* orow = out + (size_t)row * DM;
#pragma unroll
        for (int i = 0; i < 8; ++i) gst<f32x4>(orow + i * 256 + lane * 4, v[i] * rstd * g[i]);
    }
}
constexpr int A_KP = 272, A_VP = 144;
constexpr int A_KBUF = 64 * A_KP;
constexpr int A_VBUF = 128 * A_VP;
constexpr int A_K0 = 0, A_V0 = 2 * A_KBUF;
constexpr int A_BIAS = A_V0 + 2 * A_VBUF;
constexpr int A_TLIST = A_BIAS + 4 * 132 * 4;
constexpr int A_MISCW = A_TLIST + 160 * 4;
constexpr int A_IMP = 75776;
constexpr int A_SELM = A_IMP + 64 * 65 * 4;
constexpr int A_END = A_SELM + 64 * 8;
constexpr int A_Q = 93184;
static_assert(A_MISCW + 256 <= A_IMP && A_END <= A_Q && A_Q + 8 * 8192 <= LDS_MISC, "attention LDS map");

struct TileSrc { const unsigned char* kbase; int kpitch; const unsigned char* vbase; int vpitch; };

struct TileRegs { u32x4 k[2]; u32x4 v[2]; };
__device__ __forceinline__ void tile_load(TileRegs& r, const TileSrc& s, int key0, int tid) {
#pragma unroll
    for (int i = 0; i < 2; ++i) {
        const int ck = tid + 512 * i;
        r.k[i] = gld<u32x4>(s.kbase + (size_t)(key0 + (ck >> 4)) * s.kpitch + (ck & 15) * 16);
        r.v[i] = gld<u32x4>(s.vbase + (size_t)(ck >> 3) * s.vpitch + (size_t)key0 * 2 + (ck & 7) * 16);
    }
}
__device__ __forceinline__ void tile_store(const TileRegs& r, LAS unsigned char* lds, int buf, int tid) {
#pragma unroll
    for (int i = 0; i < 2; ++i) {
        const int ck = tid + 512 * i;
        *(LAS u32x4*)(lds + A_K0 + buf * A_KBUF + (ck >> 4) * A_KP + (ck & 15) * 16) = r.k[i];
        LAS unsigned char* vp = lds + A_V0 + buf * A_VBUF + (ck >> 3) * A_VP + ((ck & 7) >> 1) * 32 + (ck & 1) * 8;
        *(LAS u32x2*)(vp) = (u32x2){r.v[i].x, r.v[i].y};
        *(LAS u32x2*)(vp + 16) = (u32x2){r.v[i].z, r.v[i].w};
    }
}

struct SoftState { float m, l; };
#ifndef ATT_THR
#define ATT_THR 11.0f
#endif

template <int NKS, bool USE_BIAS, bool BINS>
__device__ __forceinline__ void attn_tile_core(LAS unsigned char* lds, int buf, int kcol, const LAS unsigned char* qf, f32x16 (&O)[4], SoftState& st, int lane,
                                          float cs, bool far, float bconst, int dq, unsigned W, bool okq, const LAS float* btab, float (&gs)[8], float (&gl)[8]) {
    const int r = lane & 31, h = lane >> 5;
    const LAS unsigned char* Kl = lds + A_K0 + buf * A_KBUF + r * A_KP + kcol + h * 16;
    f32x16 s0, s1;
#pragma unroll
    for (int i = 0; i < 16; ++i) { s0[i] = 0.f; s1[i] = 0.f; }
#pragma unroll
    for (int ks = 0; ks < NKS; ++ks) {
        const bf16x8 k0 = *(const LAS bf16x8*)(Kl + ks * 32);
        const bf16x8 k1 = *(const LAS bf16x8*)(Kl + 32 * A_KP + ks * 32);
        const bf16x8 qv = *(const LAS bf16x8*)(qf + ks * 1024);
        s0 = __builtin_amdgcn_mfma_f32_32x32x16_bf16(k0, qv, s0, 0, 0, 0);
        s1 = __builtin_amdgcn_mfma_f32_32x32x16_bf16(k1, qv, s1, 0, 0, 0);
    }
    const float NEG = -__builtin_inff();
    float tmax = NEG;
    if (far) {
#pragma unroll
        for (int i = 0; i < 16; ++i) {
            s0[i] = okq ? fmaf(s0[i], cs, bconst) : NEG; s1[i] = okq ? fmaf(s1[i], cs, bconst) : NEG;
            tmax = fmaxf(tmax, fmaxf(s0[i], s1[i]));
        }
    } else {
#pragma unroll
        for (int i = 0; i < 16; ++i) {
            const int c0 = (i & 3) + 8 * (i >> 2);
            const int d0 = dq - c0, d1 = dq - c0 - 32;
            float b0 = 0.f, b1 = 0.f;
            if (USE_BIAS) { b0 = btab[min(max(d0, 0), 128)]; b1 = btab[min(max(d1, 0), 128)]; }
            s0[i] = (okq && (unsigned)d0 < W) ? fmaf(s0[i], cs, b0) : NEG;
            s1[i] = (okq && (unsigned)d1 < W) ? fmaf(s1[i], cs, b1) : NEG;
            tmax = fmaxf(tmax, fmaxf(s0[i], s1[i]));
        }
    }
    tmax = pmax32(tmax);
    const float mn = fmaxf(st.m, tmax);
    const float alpha = __builtin_amdgcn_exp2f(st.m - mn);
    st.m = mn;
    float ps = 0.f;
#pragma unroll
    for (int i = 0; i < 16; ++i) { s0[i] = __builtin_amdgcn_exp2f(s0[i] - mn); s1[i] = __builtin_amdgcn_exp2f(s1[i] - mn); ps += s0[i] + s1[i]; }
    st.l = st.l * alpha + ps;
    if (BINS) {
#pragma unroll
        for (int gq = 0; gq < 4; ++gq) {
            gs[gq] = (s0[4 * gq] + s0[4 * gq + 1]) + (s0[4 * gq + 2] + s0[4 * gq + 3]); gl[gq] = s0[4 * gq + 3];
            gs[4 + gq] = (s1[4 * gq] + s1[4 * gq + 1]) + (s1[4 * gq + 2] + s1[4 * gq + 3]); gl[4 + gq] = s1[4 * gq + 3];
        }
    }
    if (!__all(alpha == 1.0f)) {
#pragma unroll
        for (int db = 0; db < 4; ++db)
#pragma unroll
            for (int i = 0; i < 16; ++i) O[db][i] *= alpha;
    }
    bf16x8 pf[4];
    {
        u32x4 w;
        w.x = cvt_pk_bf16(s0[0], s0[1]); w.y = cvt_pk_bf16(s0[2], s0[3]); w.z = cvt_pk_bf16(s0[4], s0[5]); w.w = cvt_pk_bf16(s0[6], s0[7]); pf[0] = __builtin_bit_cast(bf16x8, w);
        w.x = cvt_pk_bf16(s0[8], s0[9]); w.y = cvt_pk_bf16(s0[10], s0[11]); w.z = cvt_pk_bf16(s0[12], s0[13]); w.w = cvt_pk_bf16(s0[14], s0[15]); pf[1] = __builtin_bit_cast(bf16x8, w);
        w.x = cvt_pk_bf16(s1[0], s1[1]); w.y = cvt_pk_bf16(s1[2], s1[3]); w.z = cvt_pk_bf16(s1[4], s1[5]); w.w = cvt_pk_bf16(s1[6], s1[7]); pf[2] = __builtin_bit_cast(bf16x8, w);
        w.x = cvt_pk_bf16(s1[8], s1[9]); w.y = cvt_pk_bf16(s1[10], s1[11]); w.z = cvt_pk_bf16(s1[12], s1[13]); w.w = cvt_pk_bf16(s1[14], s1[15]); pf[3] = __builtin_bit_cast(bf16x8, w);
    }
    const LAS unsigned char* Vl = lds + A_V0 + buf * A_VBUF + r * A_VP + h * 16;
    bf16x8 v0 = *(const LAS bf16x8*)(Vl), v1 = *(const LAS bf16x8*)(Vl + 32);
#pragma unroll
    for (int idx = 0; idx < 16; ++idx) {
        bf16x8 vn = v1;
        if (idx + 2 < 16) vn = *(const LAS bf16x8*)(Vl + ((idx + 2) >> 2) * 32 * A_VP + ((idx + 2) & 3) * 32);
        O[idx >> 2] = __builtin_amdgcn_mfma_f32_32x32x16_bf16(v0, pf[idx & 3], O[idx >> 2], 0, 0, 0);
        v0 = v1; v1 = vn;
    }
}
template <int NKS, bool USE_BIAS>
__device__ __forceinline__ void attn_tile(LAS unsigned char* lds, int buf, int kcol, const LAS unsigned char* qf, f32x16 (&O)[4], SoftState& st, int lane,
                                          float cs, bool far, float bconst, int dq, unsigned W, bool okq, const LAS float* btab) {
    float gs[8], gl[8];
    attn_tile_core<NKS, USE_BIAS, false>(lds, buf, kcol, qf, O, st, lane, cs, far, bconst, dq, W, okq, btab, gs, gl);
}
template <int NKS>
__device__ __forceinline__ void attn_tile_p(LAS unsigned char* lds, int buf, const LAS unsigned char* qf, f32x16 (&O)[4], SoftState& st, int lane, float cs, int dq, float (&gs)[8], float (&gl)[8]) {
    attn_tile_core<NKS, false, true>(lds, buf, 0, qf, O, st, lane, cs, false, 0.f, dq, 0x80000000u, true, nullptr, gs, gl);
}

template <int NKS, bool USE_BIAS>
__device__ __forceinline__ void attn_qk_sm(LAS unsigned char* lds, int buf, int kcol, const LAS unsigned char* qf, f32x16 (&O)[4], SoftState& st, int lane,
                                           float cs, bool far, float bconst, int dq, unsigned W, bool okq, const LAS float* btab, bf16x8 (&pf)[4]) {
    const int r = lane & 31, h = lane >> 5;
    const LAS unsigned char* Kl = lds + A_K0 + buf * A_KBUF + r * A_KP + kcol + h * 16;
    f32x16 s0, s1;
#pragma unroll
    for (int i = 0; i < 16; ++i) { s0[i] = 0.f; s1[i] = 0.f; }
#pragma unroll
    for (int ks = 0; ks < NKS; ++ks) {
        const bf16x8 k0 = *(const LAS bf16x8*)(Kl + ks * 32);
        const bf16x8 k1 = *(const LAS bf16x8*)(Kl + 32 * A_KP + ks * 32);
        const bf16x8 qv = *(const LAS bf16x8*)(qf + ks * 1024);
        s0 = __builtin_amdgcn_mfma_f32_32x32x16_bf16(k0, qv, s0, 0, 0, 0);
        s1 = __builtin_amdgcn_mfma_f32_32x32x16_bf16(k1, qv, s1, 0, 0, 0);
    }
    const float NEG = -__builtin_inff();
    float ps = 0.f, alpha;
    bool resc = false;
    if (far) {
        float rmax = fmaxf(s0[0], s1[0]);
#pragma unroll
        for (int i = 1; i < 16; ++i) rmax = fmaxf(rmax, fmaxf(s0[i], s1[i]));
        float tmax = okq ? fmaf(rmax, cs, bconst) : NEG;
        tmax = pmax32(tmax);
        float mn = st.m; alpha = 1.0f;
        if (!__all(tmax - mn <= ATT_THR)) { mn = fmaxf(st.m, tmax); alpha = __builtin_amdgcn_exp2f(st.m - mn); st.m = mn; resc = true; }
        const float off = okq ? bconst - mn : NEG;
#pragma unroll
        for (int i = 0; i < 16; ++i) { s0[i] = __builtin_amdgcn_exp2f(fmaf(s0[i], cs, off)); s1[i] = __builtin_amdgcn_exp2f(fmaf(s1[i], cs, off)); ps += s0[i] + s1[i]; }
    } else {
        float tmax = NEG;
#pragma unroll
        for (int i = 0; i < 16; ++i) {
            const int d0 = dq - ((i & 3) + 8 * (i >> 2));
            float b0 = 0.f;
            if (USE_BIAS) b0 = btab[min(max(d0, 0), 128)];
            s0[i] = (okq && (unsigned)d0 < W) ? fmaf(s0[i], cs, b0) : NEG;
            tmax = fmaxf(tmax, s0[i]);
        }
        __builtin_amdgcn_sched_barrier(0);
#pragma unroll
        for (int i = 0; i < 16; ++i) {
            const int d1 = dq - ((i & 3) + 8 * (i >> 2)) - 32;
            float b1 = 0.f;
            if (USE_BIAS) b1 = btab[min(max(d1, 0), 128)];
            s1[i] = (okq && (unsigned)d1 < W) ? fmaf(s1[i], cs, b1) : NEG;
            tmax = fmaxf(tmax, s1[i]);
        }
        tmax = pmax32(tmax);
        float mn = st.m; alpha = 1.0f;
        if (!__all(tmax - mn <= ATT_THR)) { mn = fmaxf(st.m, tmax); alpha = __builtin_amdgcn_exp2f(st.m - mn); st.m = mn; resc = true; }
#pragma unroll
        for (int i = 0; i < 16; ++i) { s0[i] = __builtin_amdgcn_exp2f(s0[i] - mn); s1[i] = __builtin_amdgcn_exp2f(s1[i] - mn); ps += s0[i] + s1[i]; }
    }
    st.l = st.l * alpha + ps;
    if (resc) {
#pragma unroll
        for (int db = 0; db < 4; ++db)
#pragma unroll
            for (int i = 0; i < 16; ++i) O[db][i] *= alpha;
    }
    u32x4 w;
    w.x = cvt_pk_bf16(s0[0], s0[1]); w.y = cvt_pk_bf16(s0[2], s0[3]); w.z = cvt_pk_bf16(s0[4], s0[5]); w.w = cvt_pk_bf16(s0[6], s0[7]); pf[0] = __builtin_bit_cast(bf16x8, w);
    w.x = cvt_pk_bf16(s0[8], s0[9]); w.y = cvt_pk_bf16(s0[10], s0[11]); w.z = cvt_pk_bf16(s0[12], s0[13]); w.w = cvt_pk_bf16(s0[14], s0[15]); pf[1] = __builtin_bit_cast(bf16x8, w);
    w.x = cvt_pk_bf16(s1[0], s1[1]); w.y = cvt_pk_bf16(s1[2], s1[3]); w.z = cvt_pk_bf16(s1[4], s1[5]); w.w = cvt_pk_bf16(s1[6], s1[7]); pf[2] = __builtin_bit_cast(bf16x8, w);
    w.x = cvt_pk_bf16(s1[8], s1[9]); w.y = cvt_pk_bf16(s1[10], s1[11]); w.z = cvt_pk_bf16(s1[12], s1[13]); w.w = cvt_pk_bf16(s1[14], s1[15]); pf[3] = __builtin_bit_cast(bf16x8, w);
}
template <int NKS>
__device__ __forceinline__ void attn_qk_only(LAS unsigned char* lds, int buf, int kcol, const LAS unsigned char* qf, f32x16 (&O)[4], int lane, bf16x8 (&pf)[4]) {
    const int r = lane & 31, h = lane >> 5;
    const LAS unsigned char* Kl = lds + A_K0 + buf * A_KBUF + r * A_KP + kcol + h * 16;
    f32x16 s0, s1;
#pragma unroll
    for (int i = 0; i < 16; ++i) { s0[i] = 0.f; s1[i] = 0.f; }
#pragma unroll
    for (int ks = 0; ks < NKS; ++ks) {
        const bf16x8 k0 = *(const LAS bf16x8*)(Kl + ks * 32);
        const bf16x8 k1 = *(const LAS bf16x8*)(Kl + 32 * A_KP + ks * 32);
        const bf16x8 qv = *(const LAS bf16x8*)(qf + ks * 1024);
        s0 = __builtin_amdgcn_mfma_f32_32x32x16_bf16(k0, qv, s0, 0, 0, 0);
        s1 = __builtin_amdgcn_mfma_f32_32x32x16_bf16(k1, qv, s1, 0, 0, 0);
    }
    u32x4 w;
    w.x = __float_as_uint(s0[0]); w.y = __float_as_uint(s0[5]); w.z = __float_as_uint(s0[10]); w.w = __float_as_uint(s0[15]); pf[0] = __builtin_bit_cast(bf16x8, w);
    w.x = __float_as_uint(s0[1]); w.y = __float_as_uint(s0[6]); w.z = __float_as_uint(s0[11]); w.w = __float_as_uint(s0[12]); pf[1] = __builtin_bit_cast(bf16x8, w);
    w.x = __float_as_uint(s1[0]); w.y = __float_as_uint(s1[5]); w.z = __float_as_uint(s1[10]); w.w = __float_as_uint(s1[15]); pf[2] = __builtin_bit_cast(bf16x8, w);
    w.x = __float_as_uint(s1[1]); w.y = __float_as_uint(s1[6]); w.z = __float_as_uint(s1[11]); w.w = __float_as_uint(s1[12]); pf[3] = __builtin_bit_cast(bf16x8, w);
}
__device__ __forceinline__ void attn_pv(LAS unsigned char* lds, int buf, const bf16x8 (&pf)[4], f32x16 (&O)[4], int lane) {
    const int r = lane & 31, h = lane >> 5;
    const LAS unsigned char* Vl = lds + A_V0 + buf * A_VBUF + r * A_VP + h * 16;
    constexpr int PD = 8;
    bf16x8 vq[16];
#pragma unroll
    for (int i = 0; i < PD; ++i) vq[i] = *(const LAS bf16x8*)(Vl + (i >> 2) * 32 * A_VP + (i & 3) * 32);
#pragma unroll
    for (int idx = 0; idx < 16; ++idx) {
        if (idx + PD < 16) vq[idx + PD] = *(const LAS bf16x8*)(Vl + ((idx + PD) >> 2) * 32 * A_VP + ((idx + PD) & 3) * 32);
        O[idx >> 2] = __builtin_amdgcn_mfma_f32_32x32x16_bf16(vq[idx], pf[idx & 3], O[idx >> 2], 0, 0, 0);
    }
}

template <int NKS>
__device__ __forceinline__ void attn_tile_stats(LAS unsigned char* lds, int buf, const LAS unsigned char* qf, SoftState& st, int lane, float cs, int dq) {
    const int r = lane & 31, h = lane >> 5;
    const LAS unsigned char* Kl = lds + A_K0 + buf * A_KBUF + r * A_KP + h * 16;
    f32x16 s0, s1;
#pragma unroll
    for (int i = 0; i < 16; ++i) { s0[i] = 0.f; s1[i] = 0.f; }
#pragma unroll
    for (int ks = 0; ks < NKS; ++ks) {
        const bf16x8 k0 = *(const LAS bf16x8*)(Kl + ks * 32);
        const bf16x8 k1 = *(const LAS bf16x8*)(Kl + 32 * A_KP + ks * 32);
        const bf16x8 qv = *(const LAS bf16x8*)(qf + ks * 1024);
        s0 = __builtin_amdgcn_mfma_f32_32x32x16_bf16(k0, qv, s0, 0, 0, 0);
        s1 = __builtin_amdgcn_mfma_f32_32x32x16_bf16(k1, qv, s1, 0, 0, 0);
    }
    const float NEG = -__builtin_inff();
    float tmax = NEG;
#pragma unroll
    for (int i = 0; i < 16; ++i) {
        const int c0 = (i & 3) + 8 * (i >> 2);
        s0[i] = (dq - c0 >= 0) ? s0[i] * cs : NEG; s1[i] = (dq - c0 - 32 >= 0) ? s1[i] * cs : NEG;
        tmax = fmaxf(tmax, fmaxf(s0[i], s1[i]));
    }
    tmax = pmax32(tmax);
    const float mn = fmaxf(st.m, tmax);
    const float alpha = __builtin_amdgcn_exp2f(st.m - mn);
    st.m = mn;
    float ps = 0.f;
#pragma unroll
    for (int i = 0; i < 16; ++i) ps += __builtin_amdgcn_exp2f(s0[i] - mn) + __builtin_amdgcn_exp2f(s1[i] - mn);
    st.l = st.l * alpha + ps;
}

template <int NKS>
__device__ __forceinline__ const LAS unsigned char* load_qfrags(const Ctx& c, const bf16_t* qrow0, int pitch_elems) {
    const int lane = c.lane;
    const bf16_t* pq = qrow0 + (size_t)(lane & 31) * pitch_elems + (lane >> 5) * 8;
    LAS unsigned char* dst = c.lds + A_Q + c.wave * 8192 + lane * 16;
#pragma unroll
    for (int ks = 0; ks < NKS; ++ks) *(LAS bf16x8*)(dst + ks * 1024) = gld<bf16x8>(pq + ks * 16);
    return dst;
}

__device__ __forceinline__ void store_o_bf16(const f32x16 (&O)[4], float scale, bf16_t* orow, int lane) {
    const int h = lane >> 5;
#pragma unroll
    for (int db = 0; db < 4; ++db)
#pragma unroll
        for (int g = 0; g < 4; ++g) {
            u32x2 w; w.x = cvt_pk_bf16(O[db][4 * g] * scale, O[db][4 * g + 1] * scale); w.y = cvt_pk_bf16(O[db][4 * g + 2] * scale, O[db][4 * g + 3] * scale);
            gst<u32x2>(orow + db * 32 + g * 8 + h * 4, w);
        }
}

__device__ __forceinline__ int next_item(const Ctx& c, int q) {
    volatile LAS int* slot = (volatile LAS int*)(c.lds + LDS_MISC + 64);
    __syncthreads();
    if (c.tid == 0) *slot = (int)__hip_atomic_fetch_add(c.ctl + CWQ(q), 1u, __ATOMIC_RELAXED, __HIP_MEMORY_SCOPE_AGENT);
    __syncthreads();
    return *slot;
}

#define ATTN_LOOP_BEGIN(ntiles, src)                                                          \
    {   TileRegs tr_;                                                                          \
        const volatile LAS int* tl_ = (const volatile LAS int*)(c.lds + A_TLIST);              \
        const int nt_ = (ntiles);                                                              \
        if (nt_ > 0) { tile_load(tr_, (src), tl_[0], c.tid); tile_store(tr_, c.lds, 0, c.tid); } \
        __syncthreads();                                                                       \
        for (int ti_ = 0; ti_ < nt_; ++ti_) {                                                  \
            const int buf_ = ti_ & 1; const int key0 = tl_[ti_];                               \
            if (ti_ + 1 < nt_) tile_load(tr_, (src), tl_[ti_ + 1], c.tid);
#define ATTN_LOOP_END()                                                                        \
            if (ti_ + 1 < nt_) tile_store(tr_, c.lds, buf_ ^ 1, c.tid);                        \
            __syncthreads();                                                                   \
        }                                                                                      \
    }
#ifndef ATTN_STAGGER
#define ATTN_STAGGER 0
#endif
#if ATTN_STAGGER
#define ATTN_LOOP2(ntiles, src)                                                                \
    {   TileRegs tr_;                                                                          \
        const volatile LAS int* tl_ = (const volatile LAS int*)(c.lds + A_TLIST);              \
        const int nt_ = (ntiles);                                                              \
        bf16x8 pf_[4]; bool hasp_ = false;                                                     \
        if (nt_ > 0) { tile_load(tr_, (src), tl_[0], c.tid); tile_store(tr_, c.lds, 0, c.tid); } \
        __syncthreads();                                                                       \
        if ((c.wave >> 2) == 0) {                                                              \
            for (int ti_ = 0; ti_ < nt_; ++ti_) {                                              \
                const int buf_ = ti_ & 1; const int key0 = tl_[ti_];                           \
                if (ti_ + 1 < nt_) tile_load(tr_, (src), tl_[ti_ + 1], c.tid);                 \
                hasp_ = false;                                                                 \
                { ATTN_QKSM }                                                                  \
                __syncthreads();                                                               \
                if (hasp_) attn_pv(c.lds, buf_, pf_, O, lane);                                 \
                if (ti_ + 1 < nt_) tile_store(tr_, c.lds, buf_ ^ 1, c.tid);                    \
                __syncthreads();                                                               \
            }                                                                                  \
            __syncthreads();                                                                   \
        } else {                                                                               \
            for (int ti_ = 0; ti_ < nt_; ++ti_) {                                              \
                const int buf_ = ti_ & 1; const int key0 = tl_[ti_];                           \
                if (ti_ + 1 < nt_) tile_load(tr_, (src), tl_[ti_ + 1], c.tid);                 \
                if (hasp_) attn_pv(c.lds, buf_ ^ 1, pf_, O, lane);                             \
                __syncthreads();                                                               \
                hasp_ = false;                                                                 \
                { ATTN_QKSM }                                                                  \
                if (ti_ + 1 < nt_) tile_store(tr_, c.lds, buf_ ^ 1, c.tid);                    \
                __syncthreads();                                                               \
            }                                                                                  \
            if (hasp_) attn_pv(c.lds, (nt_ - 1) & 1, pf_, O, lane);                            \
            __syncthreads();                                                                   \
        }                                                                                      \
    }
#else
#define ATTN_TL0 0
#define ATTN_LOOP2(ntiles, src)                                                                \
    {   TileRegs tr_;                                                                          \
        const volatile LAS int* tl_ = (const volatile LAS int*)(c.lds + A_TLIST) + (ATTN_TL0); \
        const int nt_ = (ntiles);                                                              \
        bf16x8 pf_[4]; bool hasp_ = false;                                                     \
        if (nt_ > 0) { tile_load(tr_, (src), tl_[0], c.tid); tile_store(tr_, c.lds, 0, c.tid); } \
        __syncthreads();                                                                       \
        for (int ti_ = 0; ti_ < nt_; ++ti_) {                                                  \
            const int buf_ = ti_ & 1; const int key0 = tl_[ti_];                               \
            if (ti_ + 1 < nt_) tile_load(tr_, (src), tl_[ti_ + 1], c.tid);                     \
            hasp_ = false;                                                                     \
            { ATTN_QKSM }                                                                      \
            if (ti_ + 1 < nt_) tile_store(tr_, c.lds, buf_ ^ 1, c.tid);                        \
            if (hasp_) attn_pv(c.lds, buf_, pf_, O, lane);                                     \
            __syncthreads();                                                                   \
        }                                                                                      \
    }
#endif


__device__ __forceinline__ void tile_load_k(TileRegs& r, const TileSrc& s, int key0, int tid) {
#pragma unroll
    for (int i = 0; i < 2; ++i) { const int ck = tid + 512 * i; r.k[i] = gld<u32x4>(s.kbase + (size_t)(key0 + (ck >> 4)) * s.kpitch + (ck & 15) * 16); }
}
__device__ __forceinline__ void tile_load_v(TileRegs& r, const TileSrc& s, int key0, int tid) {
#pragma unroll
    for (int i = 0; i < 2; ++i) { const int ck = tid + 512 * i; r.v[i] = gld<u32x4>(s.vbase + (size_t)(ck >> 3) * s.vpitch + (size_t)key0 * 2 + (ck & 7) * 16); }
}
__device__ __forceinline__ void tile_store_k(const TileRegs& r, LAS unsigned char* lds, int buf, int tid) {
#pragma unroll
    for (int i = 0; i < 2; ++i) { const int ck = tid + 512 * i; *(LAS u32x4*)(lds + A_K0 + buf * A_KBUF + (ck >> 4) * A_KP + (ck & 15) * 16) = r.k[i]; }
}
__device__ __forceinline__ void tile_store_v(const TileRegs& r, LAS unsigned char* lds, int buf, int tid) {
#pragma unroll
    for (int i = 0; i < 2; ++i) {
        const int ck = tid + 512 * i;
        LAS unsigned char* vp = lds + A_V0 + buf * A_VBUF + (ck >> 3) * A_VP + ((ck & 7) >> 1) * 32 + (ck & 1) * 8;
        *(LAS u32x2*)(vp) = (u32x2){r.v[i].x, r.v[i].y};
        *(LAS u32x2*)(vp + 16) = (u32x2){r.v[i].z, r.v[i].w};
    }
}
typedef float f2v_t __attribute__((ext_vector_type(2)));
__device__ __forceinline__ unsigned cvt_pk_bf16x(float lo, float hi) { f2v_t f; f.x = lo; f.y = hi; const bf2_t v = __builtin_convertvector(f, bf2_t); return __builtin_bit_cast(unsigned, v); }
template <int NKS>
__device__ __forceinline__ void attf_qk(LAS unsigned char* lds, int buf, int kcol, const LAS unsigned char* qf, int lane, f32x16& s0, f32x16& s1) {
    const int r = lane & 31, h = lane >> 5;
    const LAS unsigned char* Kl = lds + A_K0 + buf * A_KBUF + r * A_KP + kcol + h * 16;
#pragma unroll
    for (int i = 0; i < 16; ++i) { s0[i] = 0.f; s1[i] = 0.f; }
#pragma unroll
    for (int ks = 0; ks < NKS; ++ks) {
        const bf16x8 k0 = *(const LAS bf16x8*)(Kl + ks * 32);
        const bf16x8 k1 = *(const LAS bf16x8*)(Kl + 32 * A_KP + ks * 32);
        const bf16x8 qv = *(const LAS bf16x8*)(qf + ks * 1024);
        s0 = __builtin_amdgcn_mfma_f32_32x32x16_bf16(k0, qv, s0, 0, 0, 0);
        s1 = __builtin_amdgcn_mfma_f32_32x32x16_bf16(k1, qv, s1, 0, 0, 0);
    }
}
__device__ __forceinline__ void attf_p1(const f32x16& s0, const f32x16& s1, f32x16 (&O)[4], SoftState& st, float& off, float cs, float bconst, bool okq) {
    const float NEG = -__builtin_inff();
    float rmax = fmaxf(s0[0], s1[0]);
#pragma unroll
    for (int i = 1; i < 16; ++i) rmax = fmaxf(rmax, fmaxf(s0[i], s1[i]));
    float tmax = okq ? fmaf(rmax, cs, bconst) : NEG;
    tmax = pmax32(tmax);
    float mn = st.m;
    if (!__all(tmax - mn <= ATT_THR)) {
        mn = fmaxf(st.m, tmax);
        const float alpha = __builtin_amdgcn_exp2f(st.m - mn);
        st.m = mn; st.l *= alpha;
#pragma unroll
        for (int db = 0; db < 4; ++db)
#pragma unroll
            for (int i = 0; i < 16; ++i) O[db][i] *= alpha;
    }
    off = okq ? bconst - mn : NEG;
}
__device__ __forceinline__ void attf_fin(const f32x16& s0, const f32x16& s1, SoftState& st, float cs, float off, bf16x8 (&pf)[4]) {
    float ps = 0.f;
    unsigned pw[16];
#pragma unroll
    for (int i = 0; i < 8; ++i) {
        const float a0 = __builtin_amdgcn_exp2f(fmaf(s0[2 * i], cs, off)), a1 = __builtin_amdgcn_exp2f(fmaf(s0[2 * i + 1], cs, off));
        const float b0 = __builtin_amdgcn_exp2f(fmaf(s1[2 * i], cs, off)), b1 = __builtin_amdgcn_exp2f(fmaf(s1[2 * i + 1], cs, off));
        ps += (a0 + a1) + (b0 + b1);
        pw[i] = cvt_pk_bf16x(a0, a1); pw[8 + i] = cvt_pk_bf16x(b0, b1);
    }
    st.l += ps;
#pragma unroll
    for (int f = 0; f < 4; ++f) { u32x4 w; w.x = pw[4 * f]; w.y = pw[4 * f + 1]; w.z = pw[4 * f + 2]; w.w = pw[4 * f + 3]; pf[f] = __builtin_bit_cast(bf16x8, w); }
}
#define ATTF_SBAR __builtin_amdgcn_sched_barrier(0)
#define ATTF_STAGE(SRC)                                                                         \
        if (j_ + 1 < nt_) tile_store_k(tr_, c.lds, buf_ ^ 1, c.tid);                            \
        tile_store_v(tr_, c.lds, buf_, c.tid);                                                  \
        if (j_ + 2 < nt_) tile_load_k(tr_, (SRC), tl_[j_ + 2], c.tid);                          \
        if (j_ + 1 < nt_) tile_load_v(tr_, (SRC), tl_[j_ + 1], c.tid);
#define ATTF_STEP(J, N, P, SRC)                                                                 \
    {   const int j_ = (J); const int key0 = tl_[j_]; const int buf_ = j_ & 1;                  \
        ATTF_STAGE(SRC)                                                                         \
        ATTF_SBAR; ATTF_QK(s##N##0_, s##N##1_); attf_fin(s##P##0_, s##P##1_, st, ATTF_CS, off##P##_, pf_); ATTF_SBAR; \
        attn_pv(c.lds, buf_ ^ 1, pf_, O, lane); attf_p1(s##N##0_, s##N##1_, O, st, off##N##_, ATTF_CS, bconst, (ATTF_OKQ)); ATTF_SBAR; \
        __syncthreads();                                                                        \
    }
#define ATTN_LOOPF(ntiles, src)                                                                \
    {   TileRegs tr_;                                                                          \
        const volatile LAS int* tl_ = (const volatile LAS int*)(c.lds + A_TLIST);              \
        const int nt_ = (ntiles);                                                              \
        if (nt_ > 0) {                                                                         \
            bf16x8 pf_[4]; f32x16 sA0_, sA1_, sB0_, sB1_; float offA_, offB_;                  \
            tile_load_k(tr_, (src), tl_[0], c.tid); tile_store_k(tr_, c.lds, 0, c.tid);        \
            if (nt_ > 1) tile_load_k(tr_, (src), tl_[1], c.tid);                               \
            tile_load_v(tr_, (src), tl_[0], c.tid);                                            \
            __syncthreads();                                                                   \
            {   const int j_ = 0; const int key0 = tl_[0]; const int buf_ = 0;                 \
                ATTF_STAGE(src)                                                                \
                ATTF_QK(sA0_, sA1_); attf_p1(sA0_, sA1_, O, st, offA_, ATTF_CS, bconst, (ATTF_OKQ)); \
                __syncthreads();                                                               \
            }                                                                                  \
            int jj_ = 1;                                                                       \
            for (; jj_ + 1 < nt_; jj_ += 2) { ATTF_STEP(jj_, B, A, src) ATTF_STEP(jj_ + 1, A, B, src) } \
            if (jj_ < nt_) {                                                                   \
                ATTF_STEP(jj_, B, A, src)                                                      \
                attf_fin(sB0_, sB1_, st, ATTF_CS, offB_, pf_); attn_pv(c.lds, (nt_ - 1) & 1, pf_, O, lane); \
            } else {                                                                           \
                attf_fin(sA0_, sA1_, st, ATTF_CS, offA_, pf_); attn_pv(c.lds, (nt_ - 1) & 1, pf_, O, lane); \
            }                                                                                  \
            __syncthreads();                                                                   \
        }                                                                                      \
    }

__device__ __forceinline__ void phase_prep(const Ctx& c, const Params& p, int l) {
    unsigned char* ws = p.ws;
    const bf16_t* PROJ = (const bf16_t*)(ws + WS_PROJ);
    const int gw = c.bid * 8 + c.wave, nw = c.G * 8, lane = c.lane;
    for (int it = c.bid; it < 256; it += c.G) {
        const int bh = it >> 4, blk = it & 15, b = bh >> 2, hh = bh & 3;
        const bf16_t* src = PROJ + (size_t)(b * SEQ + blk * 256 + c.wave * 32 + (lane >> 4)) * N1 + C_MK + hh * 128 + (lane & 15) * 8;
        float s8[8];
#pragma unroll
        for (int i = 0; i < 8; ++i) s8[i] = 0.f;
#pragma unroll
        for (int k = 0; k < 8; ++k) {
            const u32x4 v = gld<u32x4>(src + (size_t)k * 4 * N1);
            s8[0] += bf_lo(v.x); s8[1] += bf_hi(v.x); s8[2] += bf_lo(v.y); s8[3] += bf_hi(v.y); s8[4] += bf_lo(v.z); s8[5] += bf_hi(v.z); s8[6] += bf_lo(v.w); s8[7] += bf_hi(v.w);
        }
#pragma unroll
        for (int i = 0; i < 8; ++i) { s8[i] += swz_xor<16>(s8[i]); s8[i] = psum32(s8[i]); }
        LAS float* red = (LAS float*)c.lds;
        __syncthreads();
        if (lane < 16) {
#pragma unroll
            for (int i = 0; i < 8; ++i) red[c.wave * 128 + lane * 8 + i] = s8[i];
        }
        __syncthreads();
        if (c.tid < 64) {
            float a0 = 0.f, a1 = 0.f;
#pragma unroll
            for (int w = 0; w < 8; ++w) { a0 += red[w * 128 + 2 * c.tid]; a1 += red[w * 128 + 2 * c.tid + 1]; }
            gst<unsigned>((bf16_t*)(ws + WS_KMEAN) + (size_t)it * 128 + 2 * c.tid, cvt_pk_bf16(a0 * (1.0f / 256.0f), a1 * (1.0f / 256.0f)));
        }
    }
    for (int it = c.bid; it < 256; it += c.G) {
        const int ep = it & 1, nt = (it >> 1) & 7, bg = (it >> 4) & 7, kv = it >> 7;
        const int b = bg >> 1, g = bg & 1;
        const int r = lane & 31, h = lane >> 5;
        const int et = ep * 2 + (c.wave & 1), kq = c.wave >> 1;
        int n = nt * 32 + r; if (n > 254) n = 254;
        const bf16_t* arow = PROJ + (size_t)(b * SEQ + 16 * n) * N1 + (kv ? C_VC : C_KC) + g * 128;
        const bf16_t* wrow = (const bf16_t*)(ws + WS_WCT) + (((size_t)l * 2 + kv) * 128 + et * 32 + r) * 4096;
        f32x16 acc;
#pragma unroll
        for (int i = 0; i < 16; ++i) acc[i] = 0.f;
#pragma unroll 1
        for (int b8 = 0; b8 < 8; ++b8) {
            bf16x8 av[8], bw[8];
#pragma unroll
            for (int i = 0; i < 8; ++i) { const int k = (kq * 64 + b8 * 8 + i) * 16 + h * 8; av[i] = gld<bf16x8>(arow + (size_t)(k >> 7) * N1 + (k & 127)); bw[i] = gld<bf16x8>(wrow + k); }
            __builtin_amdgcn_sched_barrier(0);
#pragma unroll
            for (int i = 0; i < 8; ++i) acc = __builtin_amdgcn_mfma_f32_32x32x16_bf16(av[i], bw[i], acc, 0, 0, 0);
        }
        LAS float* red = (LAS float*)c.lds;
        __syncthreads();
        if (kq != 0) {
#pragma unroll
            for (int i = 0; i < 16; ++i) red[(c.wave * 16 + i) * 64 + lane] = acc[i];
        }
        __syncthreads();
        if (kq == 0) {
            const int e = et * 32 + r;
            const float cb = ((const float*)(ws + WS_CB))[(l * 2 + kv) * 128 + e];
#pragma unroll
            for (int i = 0; i < 16; ++i) acc[i] += cb + (red[((c.wave + 2) * 16 + i) * 64 + lane] + red[((c.wave + 4) * 16 + i) * 64 + lane]) + red[((c.wave + 6) * 16 + i) * 64 + lane];
            if (kv == 0) {
                bf16_t* dst = (bf16_t*)(ws + WS_KCMP) + (size_t)bg * 256 * 128;
#pragma unroll
                for (int i = 0; i < 16; ++i) {
                    const int nn = nt * 32 + (i & 3) + 8 * (i >> 2) + 4 * h;
                    dst[(size_t)nn * 128 + e] = nn < 255 ? (bf16_t)(cvt_pk_bf16(acc[i], 0.f) & 0xffffu) : (bf16_t)0;
                }
            } else {
                bf16_t* dst = (bf16_t*)(ws + WS_VCMPT) + (size_t)bg * 128 * 256 + (size_t)e * 256;
#pragma unroll
                for (int g4 = 0; g4 < 4; ++g4) {
                    const int nn = nt * 32 + 8 * g4 + 4 * h;
                    u32x2 w; w.x = cvt_pk_bf16(acc[4 * g4], acc[4 * g4 + 1]); w.y = cvt_pk_bf16(acc[4 * g4 + 2], nn + 3 < 255 ? acc[4 * g4 + 3] : 0.f);
                    gst<u32x2>(dst + nn, w);
                }
            }
        }
    }
}
#ifndef ATTF_DIFF
#define ATTF_DIFF 1
#endif
#ifndef ATTF_SEL
#define ATTF_SEL 1
#endif
#ifndef ATTF_MOBA
#define ATTF_MOBA 1
#endif
__device__ __forceinline__ unsigned wave_or(unsigned v) {
    v = por32(v); v |= swz_xor_u<16>(v); v |= swz_xor_u<8>(v); v |= swz_xor_u<4>(v); v |= swz_xor_u<2>(v); v |= swz_xor_u<1>(v);
    return (unsigned)__builtin_amdgcn_readfirstlane((int)v);
}
__device__ __forceinline__ float sigmoidf_(float x) { return 1.0f / (1.0f + __expf(-x)); }
__device__ __forceinline__ void zero_o(f32x16 (&O)[4]) {
#pragma unroll
    for (int db = 0; db < 4; ++db)
#pragma unroll
        for (int i = 0; i < 16; ++i) O[db][i] = 0.f;
}
__device__ __forceinline__ void load_bias_tab(const Ctx& c, const Params& p, int head0, int nheads) {
    LAS float* bt = (LAS float*)(c.lds + A_BIAS);
    const float* src = (const float*)(p.ws + WS_BIAS) + head0 * 132;
    for (int i = c.tid; i < nheads * 132; i += 512) bt[i] = src[i];
}

__device__ __forceinline__ void item_moba(const Ctx& c0, const Params& p, int b, int hh, int own) {
    Ctx c = c0; asm volatile("" : "+v"(c.tid), "+v"(c.lane));
    unsigned char* ws = p.ws;
    const bf16_t* PROJ = (const bf16_t*)(ws + WS_PROJ);
    const int lane = c.lane, r = lane & 31, h = lane >> 5, tok0 = b * SEQ;
    const int qw0 = own * 256 + 32 * c.wave, qpos = qw0 + r;
    volatile LAS unsigned* mw = (volatile LAS unsigned*)(c.lds + A_MISCW);
    volatile LAS int* tl = (volatile LAS int*)(c.lds + A_TLIST);
    if (c.tid == 0) mw[0] = 0u;
    load_bias_tab(c, p, hh, 1);
    const LAS unsigned char* qf = load_qfrags<8>(c, PROJ + (size_t)(tok0 + qw0) * N1 + C_MQ + hh * 128, N1);
    __syncthreads();
    unsigned sel = 0u;
    {
        const bf16_t* km = (const bf16_t*)(ws + WS_KMEAN) + ((size_t)(b * 4 + hh) * 16 + (r < 16 ? r : 15)) * 128 + h * 8;
        f32x16 gsc;
#pragma unroll
        for (int i = 0; i < 16; ++i) gsc[i] = 0.f;
        bf16x8 kmf[8];
#pragma unroll
        for (int ks = 0; ks < 8; ++ks) kmf[ks] = gld<bf16x8>(km + ks * 16);
        __builtin_amdgcn_sched_barrier(0);
#pragma unroll
        for (int ks = 0; ks < 8; ++ks) gsc = __builtin_amdgcn_mfma_f32_32x32x16_bf16(kmf[ks], *(const LAS bf16x8*)(qf + ks * 1024), gsc, 0, 0, 0);
        const float NEG = -__builtin_inff();
        float v[8];
#pragma unroll
        for (int i = 0; i < 8; ++i) {
            const int blk = (i & 3) + 8 * (i >> 2) + 4 * h;
            v[i] = blk < own ? __uint_as_float((__float_as_uint(gsc[i]) & ~15u) | (unsigned)(15 - blk)) : NEG;
        }
#pragma unroll
        for (int it = 0; it < 3; ++it) {
            float lm = v[0];
#pragma unroll
            for (int i = 1; i < 8; ++i) lm = fmaxf(lm, v[i]);
            const float pm = pmax32(lm);
            if (pm > NEG) sel |= 1u << (15u - (__float_as_uint(pm) & 15u));
#pragma unroll
            for (int i = 0; i < 8; ++i) v[i] = (v[i] == pm) ? NEG : v[i];
        }
    }
    const unsigned wsel = wave_or(sel);
    if (lane == 0 && wsel) __hip_atomic_fetch_or((LAS unsigned*)(c.lds + A_MISCW), wsel, __ATOMIC_RELAXED, __HIP_MEMORY_SCOPE_WORKGROUP);
    __syncthreads();
    const unsigned bsel = mw[0];
    if (c.tid == 0) {
        int n = 0;
        for (int j = 0; j < own; ++j) if ((bsel >> j) & 1u) { for (int t = 0; t < 4; ++t) tl[n++] = j * 256 + t * 64; }
        for (int t = 0; t < 4; ++t) tl[n++] = own * 256 + t * 64;
        mw[1] = (unsigned)n;
        mw[2] = (unsigned)(n - 4 - ((own >= 1 && ((bsel >> (own - 1)) & 1u)) ? 2 : 0));
    }
    __syncthreads();
    const int ntiles = (int)mw[1];
    const int nfar = ATTF_MOBA ? (int)mw[2] : 0;
    TileSrc src;
    src.kbase = (const unsigned char*)(PROJ + (size_t)tok0 * N1 + C_MK + hh * 128); src.kpitch = N1 * 2;
    src.vbase = (const unsigned char*)((const bf16_t*)(ws + WS_VT) + (size_t)(R_MV + hh * 128) * T_TOK + tok0); src.vpitch = T_TOK * 2;
    f32x16 O[4]; zero_o(O);
    SoftState st; st.m = -1e30f; st.l = 0.f;
    const LAS float* bt = (const LAS float*)(c.lds + A_BIAS);
    const float bconst = bt[128];
#define ATTN_QKSM \
        const int blk = key0 >> 8; \
        const bool past = blk < own; \
        const bool need = past ? (((wsel >> blk) & 1u) != 0u) : (key0 <= qw0 + 31); \
        if (need) { \
            const bool okq = past ? (((sel >> blk) & 1u) != 0u) : true; \
            const bool far = (qw0 - (key0 + 63)) >= 128; \
            attn_qk_sm<8, true>(c.lds, buf_, 0, qf, O, st, lane, ATT_C128, far, bconst, qpos - key0 - 4 * h, 0x80000000u, okq, bt, pf_); \
            hasp_ = true; \
        }
#if ATTF_MOBA
#define ATTF_QK(S0, S1) attf_qk<8>(c.lds, buf_, 0, qf, lane, S0, S1)
#define ATTF_OKQ (((sel >> (key0 >> 8)) & 1u) != 0u)
#define ATTF_CS ATT_C128
    ATTN_LOOPF(nfar, src)
#undef ATTF_QK
#undef ATTF_OKQ
#undef ATTF_CS
#undef ATTN_TL0
#define ATTN_TL0 nfar
    ATTN_LOOP2(ntiles - nfar, src)
#undef ATTN_TL0
#define ATTN_TL0 0
#else
    ATTN_LOOP2(ntiles, src)
#endif
#undef ATTN_QKSM
    const float lt = psum32(st.l);
    const float inv = lt > 0.f ? 1.0f / lt : 0.f;
#ifdef ABL_MOBA
    store_o_bf16(O, 0.f, (bf16_t*)(ws + WS_OMIX) + (size_t)(tok0 + qpos) * DM + hh * 128, lane);
#else
    store_o_bf16(O, inv, (bf16_t*)(ws + WS_OMIX) + (size_t)(tok0 + qpos) * DM + hh * 128, lane);
#endif
}

template <int XM>
__device__ __forceinline__ void item_diff(const Ctx& c0, const Params& p, int l, int b, int hh, int qb) {
    Ctx c = c0; asm volatile("" : "+v"(c.tid), "+v"(c.lane));
    unsigned char* ws = p.ws;
    const bf16_t* PROJ = (const bf16_t*)(ws + WS_PROJ);
    const int lane = c.lane, r = lane & 31, h = lane >> 5, tok0 = b * SEQ;
    const int map = c.wave >> 2, sub = c.wave & 3;
    const int qw0 = qb * 128 + 32 * sub, qpos = qw0 + r;
    volatile LAS int* tl = (volatile LAS int*)(c.lds + A_TLIST);
    const int ntiles = 2 * qb + 2;
    for (int i = c.tid; i < ntiles; i += 512) tl[i] = i * 64;
    load_bias_tab(c, p, 4 + hh, 1);
    const LAS unsigned char* qf = load_qfrags<4>(c, PROJ + (size_t)(tok0 + qw0) * N1 + C_DQ + hh * 128 + map * 64, N1);
    TileSrc src;
    src.kbase = (const unsigned char*)(PROJ + (size_t)tok0 * N1 + C_DK + hh * 128); src.kpitch = N1 * 2;
    src.vbase = (const unsigned char*)((const bf16_t*)(ws + WS_VT) + (size_t)(R_DV + hh * 128) * T_TOK + tok0); src.vpitch = T_TOK * 2;
    f32x16 O[4]; zero_o(O);
    SoftState st; st.m = -1e30f; st.l = 0.f;
    const LAS float* bt = (const LAS float*)(c.lds + A_BIAS);
    __syncthreads();
    const float bconst = bt[128];
#define ATTN_QKSM \
        if (XM != 3 && key0 <= qw0 + 31) { \
            const bool far = (qw0 - (key0 + 63)) >= 128; \
            if (XM == 4) attn_qk_only<4>(c.lds, buf_, map * 128, qf, O, lane, pf_); \
            else attn_qk_sm<4, true>(c.lds, buf_, map * 128, qf, O, st, lane, ATT_C64, far, bconst, qpos - key0 - 4 * h, 0x80000000u, true, bt, pf_); \
            hasp_ = (XM != 2); \
        }
#if ATTF_DIFF
    const int nfar = qb >= 1 ? 2 * qb - 2 : 0;
#define ATTF_QK(S0, S1) attf_qk<4>(c.lds, buf_, map * 128, qf, lane, S0, S1)
#define ATTF_OKQ true
#define ATTF_CS ATT_C64
    ATTN_LOOPF(nfar, src)
#undef ATTF_QK
#undef ATTF_OKQ
#undef ATTF_CS
#undef ATTN_TL0
#define ATTN_TL0 nfar
    ATTN_LOOP2(ntiles - nfar, src)
#undef ATTN_TL0
#define ATTN_TL0 0
#else
    ATTN_LOOP2(ntiles, src)
#endif
#undef ATTN_QKSM
    const float lt = psum32(st.l);
    const float inv = lt > 0.f ? 1.0f / lt : 0.f;
    LAS float* ex = (LAS float*)c.lds;
    if (map == 1) {
#pragma unroll
        for (int db = 0; db < 4; ++db)
#pragma unroll
            for (int g = 0; g < 4; ++g)
                *(LAS f32x4*)(ex + (sub * 32 + r) * 132 + db * 32 + g * 8 + h * 4) = (f32x4){O[db][4 * g] * inv, O[db][4 * g + 1] * inv, O[db][4 * g + 2] * inv, O[db][4 * g + 3] * inv};
    }
    __syncthreads();
    if (map == 0) {
        const float lam = ((const float*)(ws + WS_LAM))[l];
        const float lam_init = 0.8f - 0.6f * expf(-0.3f * (float)l);
        float ss = 0.f;
#pragma unroll
        for (int db = 0; db < 4; ++db)
#pragma unroll
            for (int g = 0; g < 4; ++g) {
                const f32x4 o2 = *(const LAS f32x4*)(ex + (sub * 32 + r) * 132 + db * 32 + g * 8 + h * 4);
#pragma unroll
                for (int j = 0; j < 4; ++j) { const float o = O[db][4 * g + j] * inv - lam * o2[j]; O[db][4 * g + j] = o; ss += o * o; }
            }
        ss = psum32(ss);
#ifdef ABL_DIFF
        const float rr = 0.f;
#else
        const float rr = rsqrtf(ss * (1.0f / 128.0f) + 1e-5f) * (1.0f - lam_init);
#endif
        const float* sg = p.diff_subln + (size_t)l * 128;
        bf16_t* orow = (bf16_t*)(ws + (XM ? WS_OC : WS_OMIX)) + (size_t)(tok0 + qpos) * DM + 512 + hh * 128;
#pragma unroll
        for (int db = 0; db < 4; ++db)
#pragma unroll
            for (int g = 0; g < 4; ++g) {
                const int d = db * 32 + g * 8 + h * 4;
                const f32x4 gg = gld<f32x4>(sg + d);
                u32x2 w; w.x = cvt_pk_bf16(O[db][4 * g] * rr * gg[0], O[db][4 * g + 1] * rr * gg[1]); w.y = cvt_pk_bf16(O[db][4 * g + 2] * rr * gg[2], O[db][4 * g + 3] * rr * gg[3]);
                gst<u32x2>(orow + d, w);
            }
    }
}

__device__ __forceinline__ void item_nsa_win(const Ctx& c0, const Params& p, int b, int g, int qb) {
    Ctx c = c0; asm volatile("" : "+v"(c.tid), "+v"(c.lane));
    unsigned char* ws = p.ws;
    const bf16_t* PROJ = (const bf16_t*)(ws + WS_PROJ);
    const int lane = c.lane, r = lane & 31, h = lane >> 5, tok0 = b * SEQ;
    const int r4 = c.wave & 3, sub = c.wave >> 2, hn = g * 4 + r4;
    const int qw0 = qb * 64 + 32 * sub, qpos = qw0 + r;
    volatile LAS int* tl = (volatile LAS int*)(c.lds + A_TLIST);
    const int t_lo = qb >= 8 ? qb - 8 : 0, ntiles = qb - t_lo + 1;
    for (int i = c.tid; i < ntiles; i += 512) tl[i] = (t_lo + i) * 64;
    load_bias_tab(c, p, 8 + g * 4, 4);
    const LAS unsigned char* qf = load_qfrags<8>(c, PROJ + (size_t)(tok0 + qw0) * N1 + C_NQ + hn * 128, N1);
    TileSrc src;
    src.kbase = (const unsigned char*)(PROJ + (size_t)tok0 * N1 + C_KW + g * 128); src.kpitch = N1 * 2;
    src.vbase = (const unsigned char*)((const bf16_t*)(ws + WS_VT) + (size_t)(R_VW + g * 128) * T_TOK + tok0); src.vpitch = T_TOK * 2;
    f32x16 O[4]; zero_o(O);
    SoftState st; st.m = -1e30f; st.l = 0.f;
    const LAS float* bt = (const LAS float*)(c.lds + A_BIAS) + r4 * 132;
    __syncthreads();
    const float bconst = bt[128];
#define ATTN_QKSM \
        if (key0 <= qw0 + 31 && key0 + 63 >= qw0 - 511) { \
            const bool far = (qw0 - (key0 + 63)) >= 128 && (qw0 + 31 - key0) < 512; \
            attn_qk_sm<8, true>(c.lds, buf_, 0, qf, O, st, lane, ATT_C128, far, bconst, qpos - key0 - 4 * h, 512u, true, bt, pf_); \
            hasp_ = true; \
        }
    ATTN_LOOP2(ntiles, src)
#undef ATTN_QKSM
    const float lt = psum32(st.l);
    const float gate = sigmoidf_(bf_lo((unsigned)((const GAS bf16_t*)PROJ)[(size_t)(tok0 + qpos) * N1 + C_GATE + hn * 3 + 2]));
#ifdef ABL_WIN
    const float sc = 0.f;
#else
    const float sc = lt > 0.f ? gate / lt : 0.f;
#endif
    store_o_bf16(O, sc, (bf16_t*)(ws + WS_OW) + (size_t)(tok0 + qpos) * 1024 + hn * 128, lane);
}

__device__ __forceinline__ void item_nsa_cmp(const Ctx& c0, const Params& p, int b, int g, int qb) {
    Ctx c = c0; asm volatile("" : "+v"(c.tid), "+v"(c.lane));
    unsigned char* ws = p.ws;
    const bf16_t* PROJ = (const bf16_t*)(ws + WS_PROJ);
    const int lane = c.lane, r = lane & 31, h = lane >> 5, tok0 = b * SEQ, bg = b * 2 + g;
    const int r4 = c.wave & 3, sub = c.wave >> 2, hn = g * 4 + r4;
    const int qw0 = qb * 64 + 32 * sub, qpos = qw0 + r, ql = 32 * sub + r;
    volatile LAS int* tl = (volatile LAS int*)(c.lds + A_TLIST);
    LAS float* imp = (LAS float*)(c.lds + A_IMP);
    LAS unsigned* selm = (LAS unsigned*)(c.lds + A_SELM);
    const int nmax_blk = (qb * 64 + 63 - 31) >> 4;
    const int nt = (nmax_blk >> 6) + 1;
    for (int i = c.tid; i < nt; i += 512) tl[i] = i * 64;
    for (int i = c.tid; i < 64 * 65; i += 512) imp[i] = 0.f;
    for (int i = c.tid; i < 128; i += 512) selm[i] = 0u;
    const LAS unsigned char* qf = load_qfrags<8>(c, PROJ + (size_t)(tok0 + qw0) * N1 + C_NQ + hn * 128, N1);
    TileSrc src;
    src.kbase = ws + WS_KCMP + (size_t)bg * 256 * 128 * 2; src.kpitch = 256;
    src.vbase = ws + WS_VCMPT + (size_t)bg * 128 * 256 * 2; src.vpitch = 512;
    const int nmax_q = qpos >= 31 ? (qpos - 31) >> 4 : -1;
    const int nmax_w = (qw0 + 31) >= 31 ? (qw0 + 31 - 31) >> 4 : -1;
    f32x16 O[4]; zero_o(O);
    SoftState st; st.m = -1e30f; st.l = 0.f;
    float inv = 0.f;
    __syncthreads();
    ATTN_LOOP_BEGIN(nt, src)
        if (key0 <= nmax_w) attn_tile_stats<8>(c.lds, buf_, qf, st, lane, ATT_C128, nmax_q - key0 - 4 * h);
    ATTN_LOOP_END()
    {
        const float lt = psum32(st.l);
        inv = lt > 0.f ? 1.0f / lt : 0.f;
        st.l = 0.f;
    }
    ATTN_LOOP_BEGIN(nt, src)
        if (key0 <= nmax_w) {
            float gs[8], gl[8];
            attn_tile_p<8>(c.lds, buf_, qf, O, st, lane, ATT_C128, nmax_q - key0 - 4 * h, gs, gl);
#pragma unroll
            for (int kb = 0; kb < 2; ++kb)
#pragma unroll
                for (int gq = 0; gq < 4; ++gq) {
                    const int m = (key0 >> 2) + 8 * kb + 2 * gq + h;
                    __hip_atomic_fetch_add(imp + ql * 65 + m, gs[4 * kb + gq] * inv, __ATOMIC_RELAXED, __HIP_MEMORY_SCOPE_WORKGROUP);
                    __hip_atomic_fetch_add(imp + ql * 65 + m + 1, gl[4 * kb + gq] * inv, __ATOMIC_RELAXED, __HIP_MEMORY_SCOPE_WORKGROUP);
                }
        }
    ATTN_LOOP_END()
    {
        const float gate = sigmoidf_(bf_lo((unsigned)((const GAS bf16_t*)PROJ)[(size_t)(tok0 + qpos) * N1 + C_GATE + hn * 3 + 0]));
#ifdef ABL_CMP
        const float cscale = 0.f;
#else
        const float cscale = inv * gate;
#endif
        store_o_bf16(O, cscale, (bf16_t*)(ws + WS_OC) + (size_t)(tok0 + qpos) * 1024 + hn * 128, lane);
    }
    {
        const int own = qb, q = c.tid >> 3, part = c.tid & 7;
        unsigned lo = 0u, hi = 0u;
        if (own + 1 <= 16) {
            if (part == 0) { lo = own >= 31 ? 0xffffffffu : ((2u << own) - 1u); }
        } else {
            if (part == 0) { lo = 1u; const int a = own - 1; if (a < 32) lo |= 1u << a; else hi |= 1u << (a - 32); if (own < 32) lo |= 1u << own; else hi |= 1u << (own - 32); }
            const LAS float* iq = imp + q * 65;
            for (int mm = part * 8; mm < part * 8 + 8; ++mm) {
                if (mm >= 1 && mm <= own - 2) {
                    const float vme = iq[mm];
                    int rank = 0;
                    for (int m2 = 1; m2 <= own - 2; ++m2) { const float v2 = iq[m2]; rank += (v2 > vme || (v2 == vme && m2 < mm)) ? 1 : 0; }
                    if (rank < 13) { if (mm < 32) lo |= 1u << mm; else hi |= 1u << (mm - 32); }
                }
            }
        }
        if (lo) __hip_atomic_fetch_or(selm + q * 2, lo, __ATOMIC_RELAXED, __HIP_MEMORY_SCOPE_WORKGROUP);
        if (hi) __hip_atomic_fetch_or(selm + q * 2 + 1, hi, __ATOMIC_RELAXED, __HIP_MEMORY_SCOPE_WORKGROUP);
        __syncthreads();
        if (c.tid < 64) {
            const volatile LAS unsigned* sv = (const volatile LAS unsigned*)selm;
            u32x2 w; w.x = sv[c.tid * 2]; w.y = sv[c.tid * 2 + 1];
            gst<u32x2>(ws + WS_SELM + ((size_t)bg * SEQ + qb * 64 + c.tid) * 8, w);
        }
    }
}

__device__ __forceinline__ void item_nsa_sel(const Ctx& c0, const Params& p, int b, int g, int qb) {
    Ctx c = c0; asm volatile("" : "+v"(c.tid), "+v"(c.lane));
    unsigned char* ws = p.ws;
    const bf16_t* PROJ = (const bf16_t*)(ws + WS_PROJ);
    const int lane = c.lane, r = lane & 31, h = lane >> 5, tok0 = b * SEQ, bg = b * 2 + g;
    const int r4 = c.wave & 3, sub = c.wave >> 2, hn = g * 4 + r4;
    const int qw0 = qb * 64 + 32 * sub, qpos = qw0 + r;
    volatile LAS unsigned* mw = (volatile LAS unsigned*)(c.lds + A_MISCW);
    volatile LAS int* tl = (volatile LAS int*)(c.lds + A_TLIST);
    if (c.tid == 0) { mw[0] = 0u; mw[1] = 0u; }
    load_bias_tab(c, p, 8 + g * 4, 4);
    const u32x2 mq = gld<u32x2>(ws + WS_SELM + ((size_t)bg * SEQ + qpos) * 8);
    const unsigned wlo = wave_or(mq.x), whi = wave_or(mq.y);
    const LAS unsigned char* qf = load_qfrags<8>(c, PROJ + (size_t)(tok0 + qw0) * N1 + C_NQ + hn * 128, N1);
    __syncthreads();
    if (lane == 0) {
        if (wlo) __hip_atomic_fetch_or((LAS unsigned*)(c.lds + A_MISCW), wlo, __ATOMIC_RELAXED, __HIP_MEMORY_SCOPE_WORKGROUP);
        if (whi) __hip_atomic_fetch_or((LAS unsigned*)(c.lds + A_MISCW) + 1, whi, __ATOMIC_RELAXED, __HIP_MEMORY_SCOPE_WORKGROUP);
    }
    __syncthreads();
    if (c.tid == 0) {
        const unsigned blo = mw[0], bhi = mw[1];
        int n = 0, nf = 0;
        for (int m = 0; m <= qb; ++m) { const unsigned bit = m < 32 ? (blo >> m) & 1u : (bhi >> (m - 32)) & 1u; if (bit) { tl[n++] = m * 64; if (m <= qb - 3) nf = n; } }
        mw[2] = (unsigned)n; mw[3] = (unsigned)nf;
    }
    __syncthreads();
    const int ntiles = (int)mw[2];
    const int nfar = ATTF_SEL ? (int)mw[3] : 0;
    TileSrc src;
    src.kbase = (const unsigned char*)(PROJ + (size_t)tok0 * N1 + C_KS + g * 128); src.kpitch = N1 * 2;
    src.vbase = (const unsigned char*)((const bf16_t*)(ws + WS_VT) + (size_t)(R_VS + g * 128) * T_TOK + tok0); src.vpitch = T_TOK * 2;
    f32x16 O[4]; zero_o(O);
    SoftState st; st.m = -1e30f; st.l = 0.f;
    const LAS float* bt = (const LAS float*)(c.lds + A_BIAS) + r4 * 132;
    const float bconst = bt[128];
#define ATTN_QKSM \
        const int m = key0 >> 6; \
        const bool need = (m < 32 ? (wlo >> m) & 1u : (whi >> (m - 32)) & 1u) != 0u; \
        if (need && key0 <= qw0 + 31) { \
            const bool okq = (m < 32 ? (mq.x >> m) & 1u : (mq.y >> (m - 32)) & 1u) != 0u; \
            const bool far = (qw0 - (key0 + 63)) >= 128; \
            attn_qk_sm<8, true>(c.lds, buf_, 0, qf, O, st, lane, ATT_C128, far, bconst, qpos - key0 - 4 * h, 0x80000000u, okq, bt, pf_); \
            hasp_ = true; \
        }
#if ATTF_SEL
#define ATTF_QK(S0, S1) attf_qk<8>(c.lds, buf_, 0, qf, lane, S0, S1)
#define ATTF_OKQ (((key0 >> 6) < 32 ? (mq.x >> (key0 >> 6)) & 1u : (mq.y >> ((key0 >> 6) - 32)) & 1u) != 0u)
#define ATTF_CS ATT_C128
    ATTN_LOOPF(nfar, src)
#undef ATTF_QK
#undef ATTF_OKQ
#undef ATTF_CS
#undef ATTN_TL0
#define ATTN_TL0 nfar
    ATTN_LOOP2(ntiles - nfar, src)
#undef ATTN_TL0
#define ATTN_TL0 0
#else
    ATTN_LOOP2(ntiles, src)
#endif
#undef ATTN_QKSM
    const float lt = psum32(st.l);
    const float gate = sigmoidf_(bf_lo((unsigned)((const GAS bf16_t*)PROJ)[(size_t)(tok0 + qpos) * N1 + C_GATE + hn * 3 + 1]));
#ifdef ABL_SEL
    const float sc = 0.f;
#else
    const float sc = lt > 0.f ? gate / lt : 0.f;
#endif
    unsigned lo1 = (unsigned)(r * 2048 + h * 8), lo2 = (unsigned)(r * 4096 + h * 8);
    asm volatile("" : "+v"(lo1), "+v"(lo2));
    const GAS unsigned char* ocb = (const GAS unsigned char*)(ws + WS_OC) + ((size_t)(tok0 + qw0) * 1024 + hn * 128) * 2 + lo1;
    const GAS unsigned char* owb = (const GAS unsigned char*)(ws + WS_OW) + ((size_t)(tok0 + qw0) * 1024 + hn * 128) * 2 + lo1;
    GAS unsigned char* orb = (GAS unsigned char*)(ws + WS_OMIX) + ((size_t)(tok0 + qw0) * DM + 1024 + hn * 128) * 2 + lo2;
#pragma unroll
    for (int db = 0; db < 4; ++db) {
#pragma unroll
        for (int gq = 0; gq < 4; ++gq) {
            const int off = (db * 32 + gq * 8) * 2;
            const u32x2 a = *(const GAS u32x2*)(ocb + off), bw = *(const GAS u32x2*)(owb + off);
            u32x2 w;
            w.x = cvt_pk_bf16(O[db][4 * gq] * sc + bf_lo(a.x) + bf_lo(bw.x), O[db][4 * gq + 1] * sc + bf_hi(a.x) + bf_hi(bw.x));
            w.y = cvt_pk_bf16(O[db][4 * gq + 2] * sc + bf_lo(a.y) + bf_lo(bw.y), O[db][4 * gq + 3] * sc + bf_hi(a.y) + bf_hi(bw.y));
            *(GAS u32x2*)(orb + off) = w;
        }
    }
}

#define CEX(a, b) do { const float _hi = fmaxf((a), (b)), _lo = fminf((a), (b)); (a) = _hi; (b) = _lo; } while (0)
__device__ __forceinline__ void sort16_desc(float (&v)[16]) {
#pragma unroll
    for (int k = 2; k <= 16; k <<= 1)
#pragma unroll
        for (int j = k >> 1; j > 0; j >>= 1)
#pragma unroll
            for (int i = 0; i < 16; ++i) {
                const int l = i ^ j;
                if (l > i) { if ((i & k) == 0) CEX(v[i], v[l]); else CEX(v[l], v[i]); }
            }
}
__device__ __forceinline__ void merge_top16(float (&a)[16], const float (&b)[16]) {
#pragma unroll
    for (int i = 0; i < 16; ++i) a[i] = fmaxf(a[i], b[15 - i]);
#pragma unroll
    for (int j = 8; j > 0; j >>= 1)
#pragma unroll
        for (int i = 0; i < 16; ++i) { const int l = i ^ j; if (l > i) CEX(a[i], a[l]); }
}

__device__ __forceinline__ float partner32(float v, int h) { const auto r = __builtin_amdgcn_permlane32_swap(__float_as_uint(v), __float_as_uint(v), false, false); return __uint_as_float(h ? r[0] : r[1]); }
__device__ __forceinline__ void top16_of_128(f32x16 (&sc)[4], int h, float (&top)[16]) {
    float g[4][16];
#pragma unroll
    for (int kb = 0; kb < 4; ++kb) {
#pragma unroll
        for (int i = 0; i < 16; ++i) {
            const int key = kb * 32 + (i & 3) + 8 * (i >> 2) + 4 * h;
            g[kb][i] = __uint_as_float((__float_as_uint(sc[kb][i]) & ~127u) | (unsigned)(127 - key));
        }
        sort16_desc(g[kb]);
    }
    merge_top16(g[0], g[1]); merge_top16(g[2], g[3]); merge_top16(g[0], g[2]);
    float pb[16];
#pragma unroll
    for (int i = 0; i < 16; ++i) pb[i] = partner32(g[0][i], h);
    merge_top16(g[0], pb);
#pragma unroll
    for (int i = 0; i < 16; ++i) top[i] = g[0][i];
}

__device__ __forceinline__ void phase_peer_topk(const Ctx& c, const Params& p, int l) {
    unsigned char* ws = p.ws;
    const bf16_t* QRY = (const bf16_t*)(ws + WS_PROJ);
    const int gw = c.bid * 8 + c.wave, nw = c.G * 8, lane = c.lane, r = lane & 31, h = lane >> 5;
    const float NEG = -__builtin_inff();
    for (int it = gw; it < 2048; it += nw) {
        const int tt = it >> 2, hp = it & 3;
#pragma unroll 1
        for (int hh = 0; hh < 2; ++hh) {
            const int hd = hp * 2 + hh;
            float s1[16], s2[16];
#pragma unroll
            for (int pp = 0; pp < 2; ++pp) {
                const bf16_t* sk = (const bf16_t*)(ws + WS_SKB) + ((((size_t)l * 8 + hd) * 2 + pp) * 128 + r) * 128 + h * 8;
                const bf16_t* qr = QRY + (size_t)(tt * 32 + r) * DM + hd * 256 + pp * 128 + h * 8;
                f32x16 sc[4];
#pragma unroll
                for (int kb = 0; kb < 4; ++kb)
#pragma unroll
                    for (int i = 0; i < 16; ++i) sc[kb][i] = 0.f;
                constexpr int TK_PD = 2;
                bf16x8 qv[8], kf[8][4];
#pragma unroll
                for (int ks = 0; ks < TK_PD; ++ks) {
                    qv[ks] = gld<bf16x8>(qr + ks * 16);
#pragma unroll
                    for (int kb = 0; kb < 4; ++kb) kf[ks][kb] = gld<bf16x8>(sk + (size_t)kb * 32 * 128 + ks * 16);
                }
#pragma unroll
                for (int ks = 0; ks < 8; ++ks) {
                    if (ks + TK_PD < 8) {
                        qv[ks + TK_PD] = gld<bf16x8>(qr + (ks + TK_PD) * 16);
#pragma unroll
                        for (int kb = 0; kb < 4; ++kb) kf[ks + TK_PD][kb] = gld<bf16x8>(sk + (size_t)kb * 32 * 128 + (ks + TK_PD) * 16);
                    }
                    __builtin_amdgcn_sched_barrier(0);
#pragma unroll
                    for (int kb = 0; kb < 4; ++kb) sc[kb] = __builtin_amdgcn_mfma_f32_32x32x16_bf16(kf[ks][kb], qv[ks], sc[kb], 0, 0, 0);
                    __builtin_amdgcn_sched_barrier(0);
                }
                if (pp == 0) top16_of_128(sc, h, s1); else top16_of_128(sc, h, s2);
            }
            float cg[4][16];
#pragma unroll
            for (int q = 0; q < 4; ++q)
#pragma unroll
                for (int i = 0; i < 16; ++i) cg[q][i] = NEG;
            {
                int n1 = 0, n2 = 0, n3 = 0;
#pragma unroll
                for (int a = 0; a < 16; ++a)
#pragma unroll
                    for (int b = 0; b < 16; ++b)
                        if ((a + 1) * (b + 1) <= 16) {
                            const unsigned eid = ((127u - (__float_as_uint(s1[a]) & 127u)) << 7) | (127u - (__float_as_uint(s2[b]) & 127u));
                            const float v = __uint_as_float((__float_as_uint(s1[a] + s2[b]) & ~0x3fffu) | eid);
                            if (a == 0) cg[0][b] = v; else if (a <= 2) cg[1][n1++] = v; else if (a <= 7) cg[2][n2++] = v; else cg[3][n3++] = v;
                        }
            }
            sort16_desc(cg[0]); sort16_desc(cg[1]); sort16_desc(cg[2]); sort16_desc(cg[3]);
            merge_top16(cg[0], cg[1]); merge_top16(cg[2], cg[3]); merge_top16(cg[0], cg[2]);
            float tv[16]; int te[16];
#pragma unroll
            for (int k = 0; k < 16; ++k) { tv[k] = cg[0][k]; te[k] = (int)(__float_as_uint(cg[0][k]) & 0x3fffu); }
            const float tmx = tv[0];
            float wsum = 0.f;
#pragma unroll
            for (int k = 0; k < 16; ++k) { tv[k] = __expf(tv[k] - tmx); wsum += tv[k]; }
            const float winv = 1.0f / wsum;
#pragma unroll
            for (int k = 0; k < 16; ++k) tv[k] *= winv;
            GAS int* ei = (GAS int*)(ws + WS_EIDX) + (size_t)(tt * 32 + r) * 128 + hd * 16 + h * 8;
            GAS float* eg = (GAS float*)(ws + WS_EGATE) + (size_t)(tt * 32 + r) * 128 + hd * 16 + h * 8;
#pragma unroll
            for (int j = 0; j < 8; ++j) { ei[j] = h ? te[8 + j] : te[j]; eg[j] = h ? tv[8 + j] : tv[j]; }
        }
    }
}

__device__ __forceinline__ void unpack_fp8x16(u32x4 q, f32x2 (&o)[8]) {
    o[0] = __builtin_amdgcn_cvt_pk_f32_fp8((int)q.x, false); o[1] = __builtin_amdgcn_cvt_pk_f32_fp8((int)q.x, true);
    o[2] = __builtin_amdgcn_cvt_pk_f32_fp8((int)q.y, false); o[3] = __builtin_amdgcn_cvt_pk_f32_fp8((int)q.y, true);
    o[4] = __builtin_amdgcn_cvt_pk_f32_fp8((int)q.z, false); o[5] = __builtin_amdgcn_cvt_pk_f32_fp8((int)q.z, true);
    o[6] = __builtin_amdgcn_cvt_pk_f32_fp8((int)q.w, false); o[7] = __builtin_amdgcn_cvt_pk_f32_fp8((int)q.w, true);
}
template <bool DRY>
__device__ __forceinline__ void phase_peer_gather(const Ctx& c, const Params& p, int l) {
    unsigned char* ws = p.ws;
    const int gw = c.bid * 8 + c.wave, nw = c.G * 8, lane = c.lane;
    bf16_t* HN = (bf16_t*)(ws + WS_HN);
    float* XW = (float*)(ws + WS_XW);
    const unsigned char* UB = ws + WS_UB + (size_t)l * 16384 * DM;
    const unsigned char* VB = ws + WS_VB + (size_t)l * 16384 * DM;
    const GAS float* SCU = (const GAS float*)(ws + WS_SCU) + (size_t)l * 16384;
    const GAS float* SCV = (const GAS float*)(ws + WS_SCV) + (size_t)l * 16384;
    const bool b5 = (lane & 32) != 0, b4 = (lane & 16) != 0, b3 = (lane & 8) != 0;
    for (int t = gw; t < T_TOK; t += nw) {
        f32x2 xf[2][8];
#pragma unroll
        for (int cc = 0; cc < 2; ++cc) {
            const u32x4 lo = gld<u32x4>(HN + (size_t)t * DM + cc * 1024 + lane * 16), hi = gld<u32x4>(HN + (size_t)t * DM + cc * 1024 + lane * 16 + 8);
            xf[cc][0] = (f32x2){bf_lo(lo.x), bf_hi(lo.x)}; xf[cc][1] = (f32x2){bf_lo(lo.y), bf_hi(lo.y)}; xf[cc][2] = (f32x2){bf_lo(lo.z), bf_hi(lo.z)}; xf[cc][3] = (f32x2){bf_lo(lo.w), bf_hi(lo.w)};
            xf[cc][4] = (f32x2){bf_lo(hi.x), bf_hi(hi.x)}; xf[cc][5] = (f32x2){bf_lo(hi.y), bf_hi(hi.y)}; xf[cc][6] = (f32x2){bf_lo(hi.z), bf_hi(hi.z)}; xf[cc][7] = (f32x2){bf_lo(hi.w), bf_hi(hi.w)};
        }
        const int e_lo = ((const GAS int*)(ws + WS_EIDX))[(size_t)t * 128 + lane], e_hi = ((const GAS int*)(ws + WS_EIDX))[(size_t)t * 128 + 64 + lane];
        const float g_lo = ((const GAS float*)(ws + WS_EGATE))[(size_t)t * 128 + lane], g_hi = ((const GAS float*)(ws + WS_EGATE))[(size_t)t * 128 + 64 + lane];
        const float su_lo = SCU[e_lo], su_hi = SCU[e_hi], sv_lo = SCV[e_lo], sv_hi = SCV[e_hi];
        float h_lo = 0.f, h_hi = 0.f;
#pragma unroll 1
        for (int bt = 0; bt < 16; ++bt) {
            const int ev = bt < 8 ? e_lo : e_hi;
            const int b8 = bt & 7;
            u32x4 rw[8][2];
#pragma unroll
            for (int j = 0; j < 8; ++j) {
                const int ek = __builtin_amdgcn_readlane(ev, b8 * 8 + j);
                const unsigned char* row = UB + (size_t)ek * DM + lane * 16;
                rw[j][0] = gld<u32x4>(row); rw[j][1] = gld<u32x4>(row + 1024);
            }
            float ps[8];
#pragma unroll
            for (int j = 0; j < 8; ++j) {
                f32x2 a2 = {0.f, 0.f};
#pragma unroll
                for (int cc = 0; cc < 2; ++cc) {
                    f32x2 uf[8]; unpack_fp8x16(rw[j][cc], uf);
#pragma unroll
                    for (int i = 0; i < 8; ++i) a2 = __builtin_elementwise_fma(uf[i], xf[cc][i], a2);
                }
                ps[j] = a2.x + a2.y;
            }
            float q4[4];
#pragma unroll
            for (int i = 0; i < 4; ++i) { const float keep = b5 ? ps[i + 4] : ps[i], give = b5 ? ps[i] : ps[i + 4]; q4[i] = keep + __shfl_xor(give, 32); }
            float q2[2];
#pragma unroll
            for (int i = 0; i < 2; ++i) { const float keep = b4 ? q4[i + 2] : q4[i], give = b4 ? q4[i] : q4[i + 2]; q2[i] = keep + __shfl_xor(give, 16); }
            float q1;
            { const float keep = b3 ? q2[1] : q2[0], give = b3 ? q2[0] : q2[1]; q1 = keep + __shfl_xor(give, 8); }
            q1 += __shfl_xor(q1, 4); q1 += __shfl_xor(q1, 2); q1 += __shfl_xor(q1, 1);
            const float mine = __shfl(q1, 8 * (lane & 7));
            if ((lane >> 3) == b8) { if (bt < 8) h_lo = mine; else h_hi = mine; }
        }
        h_lo *= su_lo; h_hi *= su_hi;
#ifdef ABL_PEER
        const float a_lo = 0.f, a_hi = 0.f;
#else
        const float a_lo = 0.5f * h_lo * (1.0f + erff(h_lo * 0.70710678118f)) * g_lo * sv_lo;
        const float a_hi = 0.5f * h_hi * (1.0f + erff(h_hi * 0.70710678118f)) * g_hi * sv_hi;
#endif
        f32x2 acc[2][8];
#pragma unroll
        for (int cc = 0; cc < 2; ++cc)
#pragma unroll
            for (int i = 0; i < 8; ++i) acc[cc][i] = (f32x2){0.f, 0.f};
#pragma unroll 1
        for (int bt = 0; bt < 16; ++bt) {
            const int ev = bt < 8 ? e_lo : e_hi;
            const float avv = bt < 8 ? a_lo : a_hi;
            const int b8 = (bt & 7) * 8;
            u32x4 rw[8][2];
#pragma unroll
            for (int j = 0; j < 8; ++j) {
                const int ek = __builtin_amdgcn_readlane(ev, b8 + j);
                const unsigned char* row = VB + (size_t)ek * DM + lane * 16;
                rw[j][0] = gld<u32x4>(row); rw[j][1] = gld<u32x4>(row + 1024);
            }
#pragma unroll
            for (int j = 0; j < 8; ++j) {
                const float a = __uint_as_float((unsigned)__builtin_amdgcn_readlane((int)__float_as_uint(avv), b8 + j));
                const f32x2 a2 = {a, a};
#pragma unroll
                for (int cc = 0; cc < 2; ++cc) {
                    f32x2 vf[8]; unpack_fp8x16(rw[j][cc], vf);
#pragma unroll
                    for (int i = 0; i < 8; ++i) acc[cc][i] = __builtin_elementwise_fma(vf[i], a2, acc[cc][i]);
                }
            }
        }
        float* xw = XW + (size_t)t * DM;
        float* xwo = DRY ? (float*)(ws + WS_OC) + (size_t)(t & 4095) * DM : xw;
        bf16_t* hno = DRY ? (bf16_t*)(ws + WS_OMIX) + (size_t)t * DM : HN + (size_t)t * DM;
        float ss = 0.f;
#pragma unroll
        for (int cc = 0; cc < 2; ++cc)
#pragma unroll
            for (int i = 0; i < 4; ++i) {
                const f32x4 a = gld<f32x4>(xw + cc * 1024 + lane * 16 + i * 4);
                acc[cc][2 * i].x += a[0]; acc[cc][2 * i].y += a[1]; acc[cc][2 * i + 1].x += a[2]; acc[cc][2 * i + 1].y += a[3];
                ss += acc[cc][2 * i].x * acc[cc][2 * i].x + acc[cc][2 * i].y * acc[cc][2 * i].y + acc[cc][2 * i + 1].x * acc[cc][2 * i + 1].x + acc[cc][2 * i + 1].y * acc[cc][2 * i + 1].y;
            }
        ss = wave_sum(ss);
        const float rstd = rsqrtf(ss * (1.0f / DM) + 1e-6f);
        if (l + 1 < DEPTH) {
            const float* gn = p.attn_norm + (size_t)(l + 1) * DM;
#pragma unroll
            for (int cc = 0; cc < 2; ++cc) {
                unsigned wv_[8];
#pragma unroll
                for (int i = 0; i < 4; ++i) {
                    gst<f32x4>(xwo + cc * 1024 + lane * 16 + i * 4, (f32x4){acc[cc][2 * i].x, acc[cc][2 * i].y, acc[cc][2 * i + 1].x, acc[cc][2 * i + 1].y});
                    const f32x4 g = gld<f32x4>(gn + cc * 1024 + lane * 16 + i * 4);
                    wv_[2 * i] = cvt_pk_bf16(acc[cc][2 * i].x * rstd * g[0], acc[cc][2 * i].y * rstd * g[1]);
                    wv_[2 * i + 1] = cvt_pk_bf16(acc[cc][2 * i + 1].x * rstd * g[2], acc[cc][2 * i + 1].y * rstd * g[3]);
                }
                gst<u32x4>(hno + cc * 1024 + lane * 16, (u32x4){wv_[0], wv_[1], wv_[2], wv_[3]});
                gst<u32x4>(hno + cc * 1024 + lane * 16 + 8, (u32x4){wv_[4], wv_[5], wv_[6], wv_[7]});
            }
        } else {
            const float* gn = p.final_norm;
            float* orow = DRY ? xwo : p.out + (size_t)t * DM;
#pragma unroll
            for (int cc = 0; cc < 2; ++cc)
#pragma unroll
                for (int i = 0; i < 4; ++i) {
                    const f32x4 g = gld<f32x4>(gn + cc * 1024 + lane * 16 + i * 4);
                    gst<f32x4>(orow + cc * 1024 + lane * 16 + i * 4, (f32x4){acc[cc][2 * i].x * rstd * g[0], acc[cc][2 * i].y * rstd * g[1], acc[cc][2 * i + 1].x * rstd * g[2], acc[cc][2 * i + 1].y * rstd * g[3]});
                }
        }
    }
}

template <int XU>
__device__ __forceinline__ void phase_peer_u(const Ctx& c, const Params& p, int l) {
    constexpr int FMT = PEER_FMT_U; typedef PeerFmt<FMT> F;
    unsigned char* ws = p.ws;
    const int lane = c.lane, li = lane & 7, rg = lane >> 3;
    const int slice = c.bid & 7, nblk = (c.G - slice + 7) >> 3;
    const int w0 = (c.bid >> 3) * 8 + c.wave, wstride = nblk * 8;
    const bf16_t* HN = (const bf16_t*)(ws + WS_HN) + slice * 256 + li * 32;
    const unsigned char* UB = ws + WS_UB + (size_t)l * 16384 * F::ROWB + slice * (F::ROWB / 8) + li * (FMT == 6 ? 16 : F::LANEB);
    const int d8 = 128 - 8 * li;
    GAS float* HP = (GAS float*)(ws + (XU ? WS_OMIX : WS_OC)) + (size_t)slice * T_TOK * 128;
    const GAS int* EI = (const GAS int*)(ws + WS_EIDX);
    const bool b2 = (lane & 4) != 0, b1 = (lane & 2) != 0, b0 = (lane & 1) != 0;
    const int bpa0 = rg * 4;
    int e_lo = 0, e_hi = 0; u32x4 xr[4] = {};
    if (w0 < T_TOK) { e_lo = EI[(size_t)w0 * 128 + lane]; e_hi = EI[(size_t)w0 * 128 + 64 + lane];
#pragma unroll
        for (int q = 0; q < 4; ++q) xr[q] = gld<u32x4>(HN + (size_t)w0 * DM + q * 8); }
    for (int t = w0; t < T_TOK; t += wstride) {
        int bpa = bpa0; asm volatile("" : "+v"(bpa));
        unsigned rw[16][6];
#pragma unroll
        for (int j = 0; j < 16; ++j) {
            const int ek = __builtin_amdgcn_ds_bpermute(bpa + 32 * (j & 7), j < 8 ? e_lo : e_hi);
            if (FMT == 6) ldrow_u6(UB + (size_t)ek * F::ROWB, d8, rw[j]); else ldrow<FMT>(UB + (size_t)ek * F::ROWB, rw[j]);
        }
        f32x2 xf[16];
#pragma unroll
        for (int q = 0; q < 4; ++q) { const u32x4 v = xr[q];
            xf[4 * q] = (f32x2){bf_lo(v.x), bf_hi(v.x)}; xf[4 * q + 1] = (f32x2){bf_lo(v.y), bf_hi(v.y)}; xf[4 * q + 2] = (f32x2){bf_lo(v.z), bf_hi(v.z)}; xf[4 * q + 3] = (f32x2){bf_lo(v.w), bf_hi(v.w)}; }
        const int tn = t + wstride;
        if (tn < T_TOK) { e_lo = EI[(size_t)tn * 128 + lane]; e_hi = EI[(size_t)tn * 128 + 64 + lane];
#pragma unroll
            for (int q = 0; q < 4; ++q) xr[q] = gld<u32x4>(HN + (size_t)tn * DM + q * 8); }
        __builtin_amdgcn_sched_barrier(0);
        float pv[16];
#pragma unroll
        for (int j = 0; j < 16; ++j) {
            f32x2 uf[16];
            if (XU == 2) {
#pragma unroll
                for (int i = 0; i < 16; ++i) uf[i] = (f32x2){__uint_as_float(rw[j][i % 6]), __uint_as_float(rw[j][(i + 1) % 6])};
            } else dec32<FMT>(rw[j], uf);
            f32x2 a2 = {0.f, 0.f}, a3 = {0.f, 0.f};
#pragma unroll
            for (int i = 0; i < (XU == 3 ? 1 : 8); ++i) { a2 = __builtin_elementwise_fma(uf[2 * i], xf[2 * i], a2); a3 = __builtin_elementwise_fma(uf[2 * i + 1], xf[2 * i + 1], a3); }
            pv[j] = (a2.x + a2.y) + (a3.x + a3.y);
            __builtin_amdgcn_sched_barrier(0);
        }
        float q8[8];
#pragma unroll
        for (int i = 0; i < 8; ++i) { const float keep = b2 ? pv[8 + i] : pv[i], give = b2 ? pv[i] : pv[8 + i]; q8[i] = keep + swz_xor<4>(give); }
        float q4[4];
#pragma unroll
        for (int i = 0; i < 4; ++i) { const float keep = b1 ? q8[4 + i] : q8[i], give = b1 ? q8[i] : q8[4 + i]; q4[i] = keep + swz_xor<2>(give); }
        float q2[2];
#pragma unroll
        for (int i = 0; i < 2; ++i) { const float keep = b0 ? q4[2 + i] : q4[i], give = b0 ? q4[i] : q4[2 + i]; q2[i] = keep + swz_xor<1>(give); }
        const int x0 = 2 * li, s0 = 64 * (x0 >> 3) + 8 * (x0 & 7) + rg;
        GAS float* hp = HP + (size_t)t * 128 + s0;
        hp[0] = q2[0]; hp[8] = q2[1];
    }
}

__device__ __forceinline__ void phase_peer_a(const Ctx& c, const Params& p, int l) {
    unsigned char* ws = p.ws;
    const int gw = c.bid * 8 + c.wave, nw = c.G * 8, lane = c.lane;
    const GAS float* HP = (const GAS float*)(ws + WS_OC);
    const GAS float* SCU = (const GAS float*)(ws + WS_SCU) + (size_t)l * 16384;
    const GAS float* SCV = (const GAS float*)(ws + WS_SCV) + (size_t)l * 16384;
    GAS float* EG = (GAS float*)(ws + WS_EGATE);
    for (int t = gw; t < T_TOK; t += nw) {
        const int e_lo = ((const GAS int*)(ws + WS_EIDX))[(size_t)t * 128 + lane], e_hi = ((const GAS int*)(ws + WS_EIDX))[(size_t)t * 128 + 64 + lane];
        const float g_lo = EG[(size_t)t * 128 + lane], g_hi = EG[(size_t)t * 128 + 64 + lane];
        float h_lo = 0.f, h_hi = 0.f;
#pragma unroll
        for (int s = 0; s < 8; ++s) { h_lo += HP[((size_t)s * T_TOK + t) * 128 + lane]; h_hi += HP[((size_t)s * T_TOK + t) * 128 + 64 + lane]; }
        h_lo *= SCU[e_lo]; h_hi *= SCU[e_hi];
#ifdef ABL_PEER
        const float a_lo = 0.f, a_hi = 0.f;
#else
        const float a_lo = 0.5f * h_lo * (1.0f + erff(h_lo * 0.70710678118f)) * g_lo * SCV[e_lo];
        const float a_hi = 0.5f * h_hi * (1.0f + erff(h_hi * 0.70710678118f)) * g_hi * SCV[e_hi];
#endif
        EG[(size_t)t * 128 + lane] = a_lo; EG[(size_t)t * 128 + 64 + lane] = a_hi;
    }
}
template <int XV>
__device__ __forceinline__ void phase_peer_v(const Ctx& c, const Params& p, int l) {
    constexpr int FMT = PEER_FMT_V; typedef PeerFmt<FMT> F;
    unsigned char* ws = p.ws;
    const int lane = c.lane, li = lane & 7, rg = lane >> 3;
    const int slice = c.bid & 7, nblk = (c.G - slice + 7) >> 3;
    const int w0 = (c.bid >> 3) * 8 + c.wave, wstride = nblk * 8;
    float* XW = (float*)(ws + WS_XW) + slice * 256 + li * 32 + rg * 4;
    const unsigned char* VB = ws + WS_VB + (size_t)l * 16384 * F::ROWB + slice * (F::ROWB / 8) + li * F::LANEB;
    const GAS int* EI = (const GAS int*)(ws + WS_EIDX);
    const GAS float* EA = (const GAS float*)(ws + WS_EGATE);
    const bool b5 = (lane & 32) != 0, b4 = (lane & 16) != 0, b3 = (lane & 8) != 0;
    const int bpa0 = rg * 4;
    int e_lo = 0, e_hi = 0; float a_lo = 0.f, a_hi = 0.f;
    if (w0 < T_TOK) { e_lo = EI[(size_t)w0 * 128 + lane]; e_hi = EI[(size_t)w0 * 128 + 64 + lane]; a_lo = EA[(size_t)w0 * 128 + lane]; a_hi = EA[(size_t)w0 * 128 + 64 + lane]; }
    for (int t = w0; t < T_TOK; t += wstride) {
        int bpa = bpa0; asm volatile("" : "+v"(bpa));
        unsigned rw[16][6]; float av[16];
#pragma unroll
        for (int j = 0; j < 16; ++j) {
            const int ek = __builtin_amdgcn_ds_bpermute(bpa + 32 * (j & 7), j < 8 ? e_lo : e_hi);
            av[j] = __int_as_float(__builtin_amdgcn_ds_bpermute(bpa + 32 * (j & 7), __float_as_int(j < 8 ? a_lo : a_hi)));
            ldrow<FMT>(VB + (size_t)ek * F::ROWB, rw[j]);
        }
        const f32x4 xo = gld<f32x4>(XW + (size_t)t * DM);
        const int tn = t + wstride;
        if (tn < T_TOK) { e_lo = EI[(size_t)tn * 128 + lane]; e_hi = EI[(size_t)tn * 128 + 64 + lane]; a_lo = EA[(size_t)tn * 128 + lane]; a_hi = EA[(size_t)tn * 128 + 64 + lane]; }
        __builtin_amdgcn_sched_barrier(0);
        f32x2 acc[16];
#pragma unroll
        for (int i = 0; i < 16; ++i) acc[i] = (f32x2){0.f, 0.f};
#pragma unroll
        for (int j = 0; j < 16; ++j) {
            f32x2 vf[16];
            if (XV == 2) {
#pragma unroll
                for (int i = 0; i < 16; ++i) vf[i] = (f32x2){__uint_as_float(rw[j][i & 3]), __uint_as_float(rw[j][(i + 1) & 3])};
            } else dec32<FMT>(rw[j], vf);
            const f32x2 a2 = {av[j], av[j]};
#pragma unroll
            for (int i = 0; i < 16; ++i) acc[i] = __builtin_elementwise_fma(vf[i], a2, acc[i]);
            __builtin_amdgcn_sched_barrier(0);
        }
        f32x2 r8[8];
#pragma unroll
        for (int i = 0; i < 8; ++i) {
            const f32x2 keep = b5 ? acc[8 + i] : acc[i], give = b5 ? acc[i] : acc[8 + i];
            const auto gx = __builtin_amdgcn_permlane32_swap(__float_as_uint(give.x), __float_as_uint(give.x), false, false);
            const auto gy = __builtin_amdgcn_permlane32_swap(__float_as_uint(give.y), __float_as_uint(give.y), false, false);
            r8[i] = (f32x2){keep.x + __uint_as_float(b5 ? gx[0] : gx[1]), keep.y + __uint_as_float(b5 ? gy[0] : gy[1])};
        }
        f32x2 r4[4];
#pragma unroll
        for (int i = 0; i < 4; ++i) { const f32x2 keep = b4 ? r8[4 + i] : r8[i], give = b4 ? r8[i] : r8[4 + i]; r4[i] = (f32x2){keep.x + swz_xor<16>(give.x), keep.y + swz_xor<16>(give.y)}; }
        f32x2 r2[2];
#pragma unroll
        for (int i = 0; i < 2; ++i) { const f32x2 keep = b3 ? r4[2 + i] : r4[i], give = b3 ? r4[i] : r4[2 + i]; r2[i] = (f32x2){keep.x + swz_xor<8>(give.x), keep.y + swz_xor<8>(give.y)}; }
        float* xp = XW + (size_t)t * DM;
        gst<f32x4>(XV ? (float*)(ws + WS_OMIX) + (size_t)(t & 8191) * DM + slice * 256 + li * 32 + rg * 4 : xp, (f32x4){xo[0] + r2[0].x, xo[1] + r2[0].y, xo[2] + r2[1].x, xo[3] + r2[1].y});
    }
}
constexpr int LDS_PARAMS = LDS_MISC + 128;
__device__ __forceinline__ Ctx make_ctx(Params& p, int wv) {
    extern __shared__ __attribute__((aligned(16))) unsigned char lds_raw[];
    Ctx c;
    asm volatile("" ::: "memory");
    c.lds = (LAS unsigned char*)lds_raw;
    int ln; asm volatile("v_mbcnt_lo_u32_b32 %0, -1, 0\n\tv_mbcnt_hi_u32_b32 %0, -1, %0" : "=v"(ln));
    int wz = wv; asm volatile("" : "+s"(wz));
    int gz = gridDim.x; asm volatile("" : "+s"(gz));
    int bz = blockIdx.x; asm volatile("" : "+s"(bz));
    c.lane = ln; c.wave = wz; c.tid = (wz << 6) | ln;
    c.G = gz; c.bid = bz;
    {
        const LAS unsigned long long* q = (const LAS unsigned long long*)(c.lds + LDS_PARAMS);
#define LDP(i) ((unsigned long long)(unsigned)__builtin_amdgcn_readfirstlane((int)(unsigned)q[i]) | ((unsigned long long)(unsigned)__builtin_amdgcn_readfirstlane((int)(unsigned)(q[i] >> 32)) << 32))
        p.x = (const float*)LDP(0); p.rel_bias = (const float*)LDP(1); p.attn_norm = (const float*)LDP(2); p.w_in = (const float*)LDP(3); p.diff_lambda = (const float*)LDP(4); p.diff_subln = (const float*)LDP(5);
        p.cmp_pos = (const float*)LDP(6); p.cmp_w = (const float*)LDP(7); p.w_out = (const float*)LDP(8); p.ffn_norm = (const float*)LDP(9); p.peer_wq = (const float*)LDP(10); p.peer_subkeys = (const float*)LDP(11);
        p.peer_u = (const float*)LDP(12); p.peer_v = (const float*)LDP(13); p.final_norm = (const float*)LDP(14); p.out = (float*)LDP(15); p.ws = (unsigned char*)LDP(16);
#undef LDP
    }
    c.ctl = (unsigned*)(p.ws + WS_CTL);
    return c;
}
__device__ __forceinline__ void ph_barrier(int wv) {
    Params p; Ctx c = make_ctx(p, wv);
    XcdBarrier bar; bar.bar = c.ctl + CW_BAR; bar.x = xb_xcc_id(); bar.st = (volatile LAS unsigned*)(c.lds + LDS_MISC);
    xcd_barrier(bar, c.tid);
#ifdef EXP_BAR2
    xcd_barrier(bar, c.tid);
#endif
}
__device__ __forceinline__ void ph_prologue(int wv) {
    Params p; Ctx c = make_ctx(p, wv);
    phase_prologue(c, p);
    phase_rmsnorm_bf16(c, p.x, p.attn_norm, (bf16_t*)(p.ws + WS_HN));
}
__device__ __forceinline__ void ph_gemm_in(int wv, int l) {
    Params p; Ctx c = make_ctx(p, wv);
    unsigned char* ws = p.ws;
    {
        pg8::Gemm g{(const bf16_t*)(ws + WS_HN), (const bf16_t*)(ws + WS_WT1) + (size_t)l * N1 * DM, T_TOK, N1, DM};
        pg8::StaticOrder S; S.init(T_TOK, N1, c.G, c.bid);
        pg8::EpiBf16<0> E{(bf16_t*)(ws + WS_PROJ), N1, nullptr, 0, 0};
        pg8::gemm_phase<pg8::EpiBf16<0>, pg8::StaticOrder, false>(c.lds, g, S, E, nullptr, c.tid);
    }
}
__device__ __forceinline__ void ph_gemm_vt(int wv, int l) {
    Params p; Ctx c = make_ctx(p, wv);
    unsigned char* ws = p.ws;
    {
        pg8::Gemm g{(const bf16_t*)(ws + WS_WTV) + (size_t)l * NV * DM, (const bf16_t*)(ws + WS_HN), NV, T_TOK, DM};
        pg8::StaticOrder S; S.init(NV, T_TOK, c.G, c.G - 1 - c.bid);
        pg8::EpiBf16<0> E{(bf16_t*)(ws + WS_VT), T_TOK, nullptr, 0, 0};
        pg8::gemm_phase<pg8::EpiBf16<0>, pg8::StaticOrder, false>(c.lds, g, S, E, nullptr, c.tid);
    }
}
__device__ __forceinline__ void ph_gemm_out(int wv, int l) {
    Params p; Ctx c = make_ctx(p, wv);
    unsigned char* ws = p.ws;
    float* XW = (float*)(ws + WS_XW);
    pg8::Gemm g{(const bf16_t*)(ws + WS_OMIX), (const bf16_t*)(ws + WS_WTO) + (size_t)l * DM * DM, T_TOK, DM, DM};
    pg8::StaticOrder S; S.init(T_TOK, DM, c.G, c.bid);
    pg8::EpiResF32 E{XW, l == 0 ? p.x : (const float*)XW, DM};
    pg8::gemm_phase<pg8::EpiResF32, pg8::StaticOrder, false>(c.lds, g, S, E, nullptr, c.tid);
}
__device__ __forceinline__ void ph_gemm_q(int wv, int l) {
    Params p; Ctx c = make_ctx(p, wv);
    unsigned char* ws = p.ws;
    pg8::Gemm g{(const bf16_t*)(ws + WS_HN), (const bf16_t*)(ws + WS_WTQ) + (size_t)l * DM * DM, T_TOK, DM, DM};
    pg8::StaticOrder S; S.init(T_TOK, DM, c.G, c.bid);
    pg8::EpiBf16<0> E{(bf16_t*)(ws + WS_PROJ), DM, nullptr, 0, 0};
    pg8::gemm_phase<pg8::EpiBf16<0>, pg8::StaticOrder, false>(c.lds, g, S, E, nullptr, c.tid);
}
__device__ __forceinline__ void ph_prep(int wv, int l) { Params p; Ctx c = make_ctx(p, wv); phase_prep(c, p, l); }
template <int XM = 0>
__device__ __forceinline__ void ph_diff(int wv, int l, int qo = 0) {
    Params p; Ctx c = make_ctx(p, wv);
    for (;;) { const int idx = next_item(c, l * 8 + 0 + qo); if (idx >= 512) break; item_diff<XM>(c, p, l, (idx & 15) >> 2, idx & 3, 31 - (idx >> 4)); }
}
__device__ __forceinline__ void ph_moba(int wv, int l, int qo = 0) {
    Params p; Ctx c = make_ctx(p, wv);
    for (;;) { const int idx = next_item(c, l * 8 + 1 + qo); if (idx >= 256) break; item_moba(c, p, (idx & 15) >> 2, idx & 3, 15 - (idx >> 4)); }
}
__device__ __forceinline__ void ph_cmp(int wv, int l, int qo = 0) {
    Params p; Ctx c = make_ctx(p, wv);
    for (;;) { const int idx = next_item(c, l * 8 + 2 + qo); if (idx >= 512) break; item_nsa_cmp(c, p, (idx & 7) >> 1, idx & 1, 63 - (idx >> 3)); }
}
__device__ __forceinline__ void ph_win(int wv, int l, int qo = 0) {
    Params p; Ctx c = make_ctx(p, wv);
    for (;;) { const int idx = next_item(c, l * 8 + 3 + qo); if (idx >= 512) break; item_nsa_win(c, p, (idx & 7) >> 1, idx & 1, 63 - (idx >> 3)); }
}
__device__ __forceinline__ void ph_sel(int wv, int l, int qo = 0) {
    Params p; Ctx c = make_ctx(p, wv);
    for (;;) { const int idx = next_item(c, l * 8 + 4 + qo); if (idx >= 512) break; item_nsa_sel(c, p, (idx & 7) >> 1, idx & 1, 63 - (idx >> 3)); }
}
__device__ __forceinline__ void ph_norm2(int wv, int l) {
    Params p; Ctx c = make_ctx(p, wv);
    phase_rmsnorm_bf16(c, (const float*)(p.ws + WS_XW), p.ffn_norm + (size_t)l * DM, (bf16_t*)(p.ws + WS_HN));
}
__device__ __forceinline__ void ph_topk(int wv, int l) { Params p; Ctx c = make_ctx(p, wv); phase_peer_topk(c, p, l); }
__device__ __forceinline__ void ph_gather(int wv, int l) { Params p; Ctx c = make_ctx(p, wv); phase_peer_gather<false>(c, p, l); }
__device__ __forceinline__ void ph_peer_u(int wv, int l) { Params p; Ctx c = make_ctx(p, wv); phase_peer_u<0>(c, p, l); }
template <int XU> __device__ __forceinline__ void ph_peer_ux(int wv, int l) { Params p; Ctx c = make_ctx(p, wv); phase_peer_u<XU>(c, p, l); }
__device__ __forceinline__ void ph_peer_v(int wv, int l) { Params p; Ctx c = make_ctx(p, wv); phase_peer_v<0>(c, p, l); }
__device__ __forceinline__ void ph_peer_a(int wv, int l) { Params p; Ctx c = make_ctx(p, wv); phase_peer_a(c, p, l); }
template <int XV> __device__ __forceinline__ void ph_peer_vx(int wv, int l) { Params p; Ctx c = make_ctx(p, wv); phase_peer_v<XV>(c, p, l); }
__device__ __forceinline__ void ph_norm_next(int wv, int l) {
    Params p; Ctx c = make_ctx(p, wv);
    if (l + 1 < DEPTH) phase_rmsnorm_bf16(c, (const float*)(p.ws + WS_XW), p.attn_norm + (size_t)(l + 1) * DM, (bf16_t*)(p.ws + WS_HN));
    else phase_rmsnorm_f32(c, (const float*)(p.ws + WS_XW), p.final_norm, p.out);
}
__device__ __forceinline__ void ph_gather_dry(int wv, int l) { Params p; Ctx c = make_ctx(p, wv); phase_peer_gather<true>(c, p, l); }

template <int L>
__device__ __forceinline__ void layer_body(int wv) {
    constexpr int l = L;
    ph_gemm_in(wv, l); ph_gemm_vt(wv, l);
#ifdef EXP_GEMM2
    ph_barrier(wv); ph_gemm_in(wv, l); ph_gemm_vt(wv, l);
#endif
    ph_barrier(wv);
    ph_prep(wv, l);
    ph_barrier(wv);
#ifdef EXP_PREP2
    ph_prep(wv, l);
    ph_barrier(wv);
#endif
    if (wv >= 4) __builtin_amdgcn_s_setprio(1);
    ph_diff(wv, l); ph_moba(wv, l); ph_cmp(wv, l); ph_win(wv, l);
    ph_barrier(wv);
    ph_sel(wv, l);
    __builtin_amdgcn_s_setprio(0);
    ph_barrier(wv);
#ifdef EXP_ATTN2
    ph_diff(wv, l, 32); ph_moba(wv, l, 32); ph_cmp(wv, l, 32); ph_win(wv, l, 32);
    ph_barrier(wv);
    ph_sel(wv, l, 32);
    ph_barrier(wv);
#endif
#ifdef EXP_DIFFX
    ph_diff<EXP_DIFFX>(wv, l, 32);
    ph_barrier(wv);
#endif
#ifdef EXP_SEL2
    ph_sel(wv, l, 32);
    ph_barrier(wv);
#endif
    ph_gemm_out(wv, l);
    ph_barrier(wv);
    ph_norm2(wv, l);
    ph_barrier(wv);
    ph_gemm_q(wv, l);
#ifdef EXP_GEMM2
    ph_barrier(wv); ph_gemm_q(wv, l);
#endif
    ph_barrier(wv);
    ph_topk(wv, l);
#ifdef EXP_TOPK2
    ph_barrier(wv); ph_topk(wv, l);
#endif
    ph_barrier(wv);
#ifdef EXP_GATHER2
    ph_gather_dry(wv, l);
    ph_barrier(wv);
#endif
#ifdef PEER_WHOLE_ROWS
    ph_gather(wv, l);
    ph_barrier(wv);
#else
    ph_peer_u(wv, l);
    ph_barrier(wv);
#ifdef EXP_PUX
    ph_peer_ux<EXP_PUX>(wv, l);
    ph_barrier(wv);
#endif
    ph_peer_a(wv, l);
    ph_barrier(wv);
#ifdef EXP_PVX
    ph_peer_vx<EXP_PVX>(wv, l);
    ph_barrier(wv);
#endif
    ph_peer_v(wv, l);
    ph_barrier(wv);
    ph_norm_next(wv, l);
    ph_barrier(wv);
#endif
}

__global__ void __launch_bounds__(512, 2) hybrid_fwd(Params pk) {
    extern __shared__ __attribute__((aligned(16))) unsigned char lds_raw[];
    const int wv = __builtin_amdgcn_readfirstlane((int)threadIdx.x >> 6);
    {
        LAS unsigned char* lds = (LAS unsigned char*)lds_raw;
        volatile LAS unsigned* misc = (volatile LAS unsigned*)(lds + LDS_MISC);
        for (int u = threadIdx.x; u < 32; u += 512) misc[u] = 0u;
        if (threadIdx.x == 0) {
            LAS unsigned long long* q = (LAS unsigned long long*)(lds + LDS_PARAMS);
            q[0] = (unsigned long long)pk.x; q[1] = (unsigned long long)pk.rel_bias; q[2] = (unsigned long long)pk.attn_norm; q[3] = (unsigned long long)pk.w_in; q[4] = (unsigned long long)pk.diff_lambda;
            q[5] = (unsigned long long)pk.diff_subln; q[6] = (unsigned long long)pk.cmp_pos; q[7] = (unsigned long long)pk.cmp_w; q[8] = (unsigned long long)pk.w_out; q[9] = (unsigned long long)pk.ffn_norm;
            q[10] = (unsigned long long)pk.peer_wq; q[11] = (unsigned long long)pk.peer_subkeys; q[12] = (unsigned long long)pk.peer_u; q[13] = (unsigned long long)pk.peer_v; q[14] = (unsigned long long)pk.final_norm;
            q[15] = (unsigned long long)pk.out; q[16] = (unsigned long long)pk.ws;
        }
        __syncthreads();
        (void)xcd_barrier_post((unsigned*)(pk.ws + WS_CTL) + CW_BAR, misc);
    }
    ph_prologue(wv);
    ph_barrier(wv);
#ifdef EXP_PRO2
    ph_prologue(wv);
    ph_barrier(wv);
#endif
    layer_body<0>(wv);
    layer_body<1>(wv);
}

extern "C" void kernel_launch(void* const* d_in, const int* in_sizes, int n_in, void* d_out, int out_size, void* d_ws, size_t ws_size, hipStream_t stream) {
    static int grid = 0;
    if (!grid) {
        int dev = 0, cus = 0;
        if (n_in != 15 || out_size != T_TOK * DM || ws_size < WS_END) { fprintf(stderr, "kernel_launch: unexpected shapes (n_in %d, out %d, ws %zu < %zu)\n", n_in, out_size, ws_size, (size_t)WS_END); grid = -1; return; }
        if (hipGetDevice(&dev) != hipSuccess || hipDeviceGetAttribute(&cus, hipDeviceAttributeMultiprocessorCount, dev) != hipSuccess || cus < 8) { grid = -1; return; }
        if (hipFuncSetAttribute((const void*)hybrid_fwd, hipFuncAttributeMaxDynamicSharedMemorySize, LDS_BYTES) != hipSuccess) { fprintf(stderr, "kernel_launch: hipFuncSetAttribute failed\n"); grid = -1; return; }
        grid = cus;
    }
    if (grid < 0) return;
    (void)hipMemsetAsync((char*)d_ws + WS_CTL, 0, CTL_BYTES, stream);
    Params p;
    memset(&p, 0, sizeof(p));
    p.x = (const float*)d_in[0]; p.rel_bias = (const float*)d_in[1]; p.attn_norm = (const float*)d_in[2]; p.w_in = (const float*)d_in[3];
    p.diff_lambda = (const float*)d_in[4]; p.diff_subln = (const float*)d_in[5]; p.cmp_pos = (const float*)d_in[6]; p.cmp_w = (const float*)d_in[7];
    p.w_out = (const float*)d_in[8]; p.ffn_norm = (const float*)d_in[9]; p.peer_wq = (const float*)d_in[10]; p.peer_subkeys = (const float*)d_in[11];
    p.peer_u = (const float*)d_in[12]; p.peer_v = (const float*)d_in[13]; p.final_norm = (const float*)d_in[14];
    p.out = (float*)d_out; p.ws = (unsigned char*)d_ws;
    hipLaunchKernelGGL(hybrid_fwd, dim3(grid), dim3(512), LDS_BYTES, stream, p);
}
```
